# Optimizing an MI355X kernel written in HIP

```python
import math
import jax, jax.numpy as jnp
from jax import lax
import numpy as np

D_MODEL = 1024
BATCH = 8
SEQ = 8192
DEPTH = 2
DEC_BATCH = 16
DEC_SEQ = 64
PAST_LEN = 1024

CHUNK = 64
Q_BLOCK = 128
EPS = 1e-6
NEG_BIG = -1e30

A_HEADS = 8
A_DQK = 64
A_DV = 2 * A_DQK
A_ROT = A_DQK // 4
ROPE_THETA = 500000.0
A_QK_W = A_HEADS * 2 * A_DQK
A_WIDTH = A_HEADS * A_DV

B_HEADS = 8
B_DK = 128
B_DV = 128
B_QK_W = B_HEADS * B_DK
B_WIDTH = B_HEADS * B_DV

C_HEADS = 16
C_DH = 64
C_WIDTH = C_HEADS * C_DH
C_DECAY_RANK = 64
C_A_RANK = 64
C_VRES_RANK = 32
C_GN_EPS = 64e-5
C_SIZES = (C_WIDTH, C_DECAY_RANK, C_WIDTH, C_WIDTH, C_A_RANK)
C_SHIFT_W = 3 * C_WIDTH + C_DECAY_RANK + C_A_RANK

IN_SIZES = (A_QK_W, A_QK_W, A_WIDTH, A_WIDTH,
            B_QK_W, B_QK_W, B_WIDTH, B_WIDTH,
            C_SHIFT_W, C_WIDTH,
            D_MODEL, D_MODEL, D_MODEL)
IN_COLS = 2 * A_QK_W + 2 * A_WIDTH + 2 * B_QK_W + 2 * B_WIDTH + C_SHIFT_W + C_WIDTH + 3 * D_MODEL

kernel_name = "hybrid_stream_diffattn_hgrn2_rwkv7_step"


def rms_norm(x, g):
    xf = x.astype(jnp.float32)
    y = xf * lax.rsqrt(jnp.mean(xf * xf, axis=-1, keepdims=True) + EPS)
    return y.astype(x.dtype) * g


def split_cols(p, sizes):
    idx = [int(s) for s in np.cumsum(sizes)[:-1]]
    return jnp.split(p, idx, axis=-1)


def partial_rope(x, pos):
    half = A_ROT // 2
    inv_freq = ROPE_THETA ** (-(jnp.arange(half, dtype=jnp.float32) * (2.0 / A_ROT)))
    ang = pos.astype(jnp.float32)[:, None] * inv_freq[None, :]
    shp = (pos.shape[0],) + (1,) * (x.ndim - 3) + (half,)
    cos = jnp.cos(ang).reshape(shp)
    sin = jnp.sin(ang).reshape(shp)
    x1 = x[..., :half].astype(jnp.float32)
    x2 = x[..., half:A_ROT].astype(jnp.float32)
    rot = jnp.concatenate([x1 * cos - x2 * sin, x2 * cos + x1 * sin], axis=-1).astype(x.dtype)
    return jnp.concatenate([rot, x[..., A_ROT:]], axis=-1)


def diff_attn_block(q, k, v, q_pos, k_pos, lam):
    s = jnp.einsum("bqhnd,bkhnd->bhnqk", q, k, preferred_element_type=jnp.float32) * (A_DQK ** -0.5)
    visible = (k_pos[None, :] // CHUNK) <= (q_pos[:, None] // CHUNK)
    s = jnp.where(visible, s, NEG_BIG)
    p = jax.nn.softmax(s, axis=-1)
    w = p[:, :, 0] - lam * p[:, :, 1]
    return jnp.einsum("bhqk,bkhd->bqhd", w.astype(v.dtype), v)


def mixer_diff_attn(a_q, a_k, a_v, pos, past_k, past_v, qn_g, kn_g, lam_p, subln_g, l):
    Bsz, T, _ = a_q.shape
    q = partial_rope(rms_norm(a_q.reshape(Bsz, T, A_HEADS, 2, A_DQK), qn_g), pos)
    k = partial_rope(rms_norm(a_k.reshape(Bsz, T, A_HEADS, 2, A_DQK), kn_g), pos)
    v = a_v.reshape(Bsz, T, A_HEADS, A_DV)
    if past_k is None:
        k_all, v_all, k_pos = k, v, pos
    else:
        p_len = past_k.shape[1]
        k_all = jnp.concatenate([past_k.reshape(Bsz, p_len, A_HEADS, 2, A_DQK).astype(k.dtype), k], axis=1)
        v_all = jnp.concatenate([past_v.astype(v.dtype), v], axis=1)
        k_pos = jnp.concatenate([jnp.arange(p_len, dtype=jnp.int32), pos])
    lam_init = 0.8 - 0.6 * math.exp(-0.3 * l)
    lp = lam_p.astype(jnp.float32)
    lam = jnp.exp(jnp.sum(lp[0] * lp[1])) - jnp.exp(jnp.sum(lp[2] * lp[3])) + lam_init
    if T > Q_BLOCK and T % Q_BLOCK == 0:
        nb = T // Q_BLOCK
        qb = q.reshape(Bsz, nb, Q_BLOCK, A_HEADS, 2, A_DQK).transpose(1, 0, 2, 3, 4, 5)
        pb = pos.reshape(nb, Q_BLOCK)
        o = lax.map(lambda blk: diff_attn_block(blk[0], k_all, v_all, blk[1], k_pos, lam), (qb, pb))
        o = o.transpose(1, 0, 2, 3, 4).reshape(Bsz, T, A_HEADS, A_DV)
    else:
        o = diff_attn_block(q, k_all, v_all, pos, k_pos, lam)
    o = rms_norm(o, subln_g) * (1.0 - lam_init)
    return o.reshape(Bsz, T, A_WIDTH), k.reshape(Bsz, T, A_HEADS, 2 * A_DQK), v


def mixer_hgrn2(b_q, b_f, b_i, s0, lb, norm_g):
    f32 = jnp.float32
    Bsz, T, _ = b_q.shape
    z = b_f.astype(f32)
    lb = lb.astype(f32)
    log_f = jnp.log(lb + (1.0 - lb) * jax.nn.sigmoid(z))
    k_in = (1.0 - lb) * jax.nn.sigmoid(-z)
    q = jax.nn.silu(b_q.astype(f32))
    i = b_i.astype(f32)
    pad = (-T) % CHUNK
    nc = (T + pad) // CHUNK

    def blocks(t, d):
        t = jnp.pad(t.reshape(Bsz, T, B_HEADS, d), ((0, 0), (0, pad), (0, 0), (0, 0)))
        return t.reshape(Bsz, nc, CHUNK, B_HEADS, d).transpose(1, 0, 3, 2, 4)

    causal = jnp.tril(jnp.ones((CHUNK, CHUNK), dtype=bool))

    def step(S, inp):
        qc, lfc, kc, ic = inp
        cum = jnp.cumsum(lfc, axis=2)
        rel = cum[:, :, :, None, :] - cum[:, :, None, :, :]
        dec = jnp.where(causal[None, None, :, :, None], jnp.exp(jnp.minimum(rel, 0.0)), 0.0)
        scores = jnp.einsum("bhtk,bhtsk,bhsk->bhts", qc, dec, kc)
        o = (jnp.einsum("bhts,bhsv->bhtv", scores, ic)
             + jnp.einsum("bhtk,bhkv->bhtv", qc * jnp.exp(cum), S))
        tail = jnp.exp(cum[:, :, -1:, :] - cum)
        S = jnp.exp(cum[:, :, -1, :])[..., None] * S + jnp.einsum("bhsk,bhsv->bhkv", kc * tail, ic)
        return S, o

    s_fin, o = lax.scan(step, s0.astype(f32),
                        (blocks(q, B_DK), blocks(log_f, B_DK), blocks(k_in, B_DK), blocks(i, B_DV)))
    o = o.transpose(1, 0, 3, 2, 4).reshape(Bsz, nc * CHUNK, B_HEADS, B_DV)[:, :T]
    o = rms_norm(o, norm_g)
    return o.reshape(Bsz, T, B_WIDTH).astype(b_q.dtype), s_fin


def rwkv7_scan(s0, r, w, k, v, a, b):
    def step(S, inp):
        r_t, w_t, k_t, v_t, a_t, b_t = inp
        sa = jnp.einsum("bhij,bhj->bhi", S, a_t)
        S = S * w_t[:, :, None, :] + sa[..., None] * b_t[:, :, None, :] + v_t[..., None] * k_t[:, :, None, :]
        return S, jnp.einsum("bhij,bhj->bhi", S, r_t)
    xs = tuple(jnp.moveaxis(t, 1, 0) for t in (r, w, k, v, a, b))
    s_fin, y = lax.scan(step, s0, xs)
    return s_fin, jnp.moveaxis(y, 0, 1)


def mixer_rwkv7(c_p, shift_prev, s0, h, v_first, l, P):
    f32 = jnp.float32
    Bsz, T, _ = c_p.shape
    prev = jnp.concatenate([shift_prev[:, None, :].astype(c_p.dtype), c_p[:, :-1]], axis=1)
    cs = c_p + (prev - c_p) * P["c_shift_mu"][l]
    r, w_lo, k, v, a_lo = split_cols(cs.astype(f32), C_SIZES)
    w_log = -jax.nn.softplus(-(P["c_w0"][l] + jnp.tanh(w_lo) @ P["c_w2"][l])) - 0.5
    decay = jnp.exp(-jnp.exp(w_log))
    a = jax.nn.sigmoid(P["c_a0"][l] + a_lo @ P["c_a2"][l])
    if l > 0:
        v_mix = jax.nn.sigmoid(P["c_v0"][l - 1] + (h @ P["c_vres_w1"][l - 1]) @ P["c_vres_w2"][l - 1])
        v = v + (v_first - v) * v_mix.astype(f32)
    heads = lambda t: t.reshape(Bsz, T, C_HEADS, C_DH)
    hp = lambda t: t.reshape(C_HEADS, C_DH)
    r, k, vh, decay, a = heads(r), heads(k), heads(v), heads(decay), heads(a)
    kk = k * hp(P["c_k_k"][l])
    kk = kk / jnp.maximum(jnp.sqrt(jnp.sum(kk * kk, axis=-1, keepdims=True)), 1e-12)
    k = k * (1.0 + (a - 1.0) * hp(P["c_k_a"][l]))
    s_fin, y = rwkv7_scan(s0.astype(f32), r, decay, k, vh, -kk, kk * a)
    mu = jnp.mean(y, axis=-1, keepdims=True)
    var = jnp.mean(jnp.square(y - mu), axis=-1, keepdims=True)
    y = (y - mu) * lax.rsqrt(var + C_GN_EPS) * hp(P["c_ln_w"][l]) + hp(P["c_ln_b"][l])
    y = y + jnp.sum(r * k * P["c_r_k"][l], axis=-1, keepdims=True) * vh
    return y.reshape(Bsz, T, C_WIDTH).astype(h.dtype), s_fin, c_p[:, -1], v


def trunk_layer(l, x, pos, P, lb, past_k, past_v, s_hgrn, s_rwkv, shift_prev, v_first):
    h = rms_norm(x, P["norm_g"][l])
    proj = jnp.einsum("btd,dc->btc", h, P["w_in"][l])
    a_q, a_k, a_v, a_g, b_q, b_f, b_i, b_g, c_p, c_g, m_a, m_b, m_c = split_cols(proj, IN_SIZES)
    o_a, k_rows, v_rows = mixer_diff_attn(a_q, a_k, a_v, pos, past_k, past_v,
                                          P["a_qnorm_g"][l], P["a_knorm_g"][l],
                                          P["a_lambda"][l], P["a_subln_g"][l], l)
    o_b, s_hgrn_new = mixer_hgrn2(b_q, b_f, b_i, s_hgrn, lb[l], P["b_norm_g"][l])
    o_c, s_rwkv_new, shift_new, v_c = mixer_rwkv7(c_p, shift_prev, s_rwkv, h, v_first, l, P)

    def branch(o, gate, w):
        return jnp.einsum("btc,cd->btd", o * jax.nn.silu(gate), w)

    merged = (jax.nn.sigmoid(m_a) * branch(o_a, a_g, P["w_out_a"][l])
              + jax.nn.sigmoid(m_b) * branch(o_b, b_g, P["w_out_b"][l])
              + jax.nn.sigmoid(m_c) * branch(o_c, c_g, P["w_out_c"][l]))
    y = x + jnp.einsum("btd,de->bte", merged, P["w_o"][l])
    return y, (k_rows, v_rows, s_hgrn_new, s_rwkv_new, shift_new), v_c


def run_trunk(x, pos, P, lb, past):
    Bsz = x.shape[0]
    outs = ([], [], [], [], [])
    v_first = None
    for l in range(DEPTH):
        if past is None:
            pk, pv = None, None
            s_h = jnp.zeros((Bsz, B_HEADS, B_DK, B_DV), jnp.float32)
            s_r = jnp.zeros((Bsz, C_HEADS, C_DH, C_DH), jnp.float32)
            s_sh = jnp.zeros((Bsz, C_SHIFT_W), x.dtype)
        else:
            pk, pv, s_h, s_r, s_sh = (t[l] for t in past)
        x, entries, v_c = trunk_layer(l, x, pos, P, lb, pk, pv, s_h, s_r, s_sh, v_first)
        if l == 0:
            v_first = v_c
        for lst, e in zip(outs, entries):
            lst.append(e)
    return x, [jnp.stack(lst) for lst in outs]


def setup_inputs(seed: int = 0) -> dict:
    key = jax.random.key(seed)
    ks = iter(jax.random.split(key, 40))
    nrm = lambda shape, scale: jax.random.normal(next(ks), shape, jnp.float32) * scale
    gain = lambda shape: 1.0 + 0.05 * jax.random.normal(next(ks), shape, jnp.float32)
    unif = lambda shape, lo, hi: jax.random.uniform(next(ks), shape, jnp.float32, lo, hi)
    L = DEPTH
    return {
        "x_prompt": nrm((BATCH, SEQ, D_MODEL), 1.0),
        "x_sample": nrm((DEC_BATCH, DEC_SEQ, D_MODEL), 1.0),
        "cache_attn_k": nrm((L, DEC_BATCH, PAST_LEN, A_HEADS, 2 * A_DQK), 1.0),
        "cache_attn_v": nrm((L, DEC_BATCH, PAST_LEN, A_HEADS, A_DV), 1.0),
        "state_hgrn": nrm((L, DEC_BATCH, B_HEADS, B_DK, B_DV), 0.5),
        "state_rwkv": nrm((L, DEC_BATCH, C_HEADS, C_DH, C_DH), 0.3),
        "state_rwkv_shift": nrm((L, DEC_BATCH, C_SHIFT_W), 1.0),
        "norm_g": gain((L, D_MODEL)),
        "w_in": nrm((L, D_MODEL, IN_COLS), D_MODEL ** -0.5),
        "a_qnorm_g": gain((L, A_DQK)),
        "a_knorm_g": gain((L, A_DQK)),
        "a_lambda": nrm((L, 4, A_DQK), 0.1),
        "a_subln_g": gain((L, A_DV)),
        "b_lower": nrm((L, B_QK_W), 1.0),
        "b_norm_g": gain((L, B_DV)),
        "c_shift_mu": unif((L, C_SHIFT_W), 0.0, 1.0),
        "c_w0": unif((L, C_WIDTH), -4.0, 1.0),
        "c_w2": nrm((L, C_DECAY_RANK, C_WIDTH), 0.1),
        "c_a0": nrm((L, C_WIDTH), 0.5),
        "c_a2": nrm((L, C_A_RANK, C_WIDTH), 0.1),
        "c_k_k": 0.85 + nrm((L, C_WIDTH), 0.05),
        "c_k_a": gain((L, C_WIDTH)),
        "c_r_k": nrm((L, C_HEADS, C_DH), 0.3),
        "c_ln_w": gain((L, C_WIDTH)),
        "c_ln_b": nrm((L, C_WIDTH), 0.02),
        "c_vres_w1": nrm((L - 1, D_MODEL, C_VRES_RANK), D_MODEL ** -0.5),
        "c_vres_w2": nrm((L - 1, C_VRES_RANK, C_WIDTH), 0.1),
        "c_v0": nrm((L - 1, C_WIDTH), 0.5),
        "w_out_a": nrm((L, A_WIDTH, D_MODEL), A_WIDTH ** -0.5),
        "w_out_b": nrm((L, B_WIDTH, D_MODEL), B_WIDTH ** -0.5),
        "w_out_c": nrm((L, C_WIDTH, D_MODEL), C_WIDTH ** -0.5),
        "w_o": nrm((L, D_MODEL, D_MODEL), D_MODEL ** -0.5),
    }


def reference(x_prompt, x_sample, cache_attn_k, cache_attn_v, state_hgrn, state_rwkv, state_rwkv_shift,
              norm_g, w_in, a_qnorm_g, a_knorm_g, a_lambda, a_subln_g, b_lower, b_norm_g,
              c_shift_mu, c_w0, c_w2, c_a0, c_a2, c_k_k, c_k_a, c_r_k, c_ln_w, c_ln_b,
              c_vres_w1, c_vres_w2, c_v0, w_out_a, w_out_b, w_out_c, w_o):
    P = {"norm_g": norm_g, "w_in": w_in, "a_qnorm_g": a_qnorm_g, "a_knorm_g": a_knorm_g,
         "a_lambda": a_lambda, "a_subln_g": a_subln_g, "b_norm_g": b_norm_g,
         "c_shift_mu": c_shift_mu, "c_w0": c_w0, "c_w2": c_w2, "c_a0": c_a0, "c_a2": c_a2,
         "c_k_k": c_k_k, "c_k_a": c_k_a, "c_r_k": c_r_k, "c_ln_w": c_ln_w, "c_ln_b": c_ln_b,
         "c_vres_w1": c_vres_w1, "c_vres_w2": c_vres_w2, "c_v0": c_v0,
         "w_out_a": w_out_a, "w_out_b": w_out_b, "w_out_c": w_out_c, "w_o": w_o}
    sm = jax.nn.softmax(b_lower.astype(jnp.float32), axis=0)
    lb = jnp.cumsum(sm, axis=0) - sm[0:1]
    pos_p = jnp.arange(x_prompt.shape[1], dtype=jnp.int32)
    past_len = cache_attn_k.shape[2]
    pos_s = past_len + jnp.arange(x_sample.shape[1], dtype=jnp.int32)
    y_prompt, (k_p, v_p, hg_p, rw_p, sh_p) = run_trunk(x_prompt, pos_p, P, lb, None)
    y_sample, (k_s, v_s, hg_s, rw_s, sh_s) = run_trunk(
        x_sample, pos_s, P, lb, (cache_attn_k, cache_attn_v, state_hgrn, state_rwkv, state_rwkv_shift))
    return (y_prompt, y_sample, k_p, v_p, hg_p, rw_p, sh_p, k_s, v_s, hg_s, rw_s, sh_s)
```

```cpp
#ifdef EMU
#include "emu.h"
#define MFMA32(a, b, c) emu_mfma32(a, b, c)
#else
#include <hip/hip_runtime.h>
#include <hip/hip_cooperative_groups.h>
#include <cstdio>
namespace cg = cooperative_groups;
typedef short bf16x8 __attribute__((ext_vector_type(8)));
typedef float f32x16 __attribute__((ext_vector_type(16)));
#define MFMA32(a, b, c) __builtin_amdgcn_mfma_f32_32x32x16_bf16(a, b, c, 0, 0, 0)
#endif

#ifdef EMU
#define TID() ((int)threadIdx.x)
#define BID() ((int)blockIdx.x)
#else
static __device__ __forceinline__ int TID() { int t = threadIdx.x; asm volatile("" : "+v"(t)); return t; }
static __device__ __forceinline__ int BID() { int t = blockIdx.x; asm volatile("" : "+s"(t)); return t; }
#endif
#define DI __device__ __forceinline__
#ifdef EMU
#define SCHED_BARRIER()
#else
#define SCHED_BARRIER() __builtin_amdgcn_sched_barrier(0)
#endif
typedef unsigned short bf16;

#ifdef SMALL
constexpr int D = 128, NB = 2, T = 256, NSB = 2, TS = 64, PAST = 128, AH = 2, BH = 1, CH = 2;
#else
constexpr int D = 1024, NB = 8, T = 8192, NSB = 16, TS = 64, PAST = 1024, AH = 8, BH = 8, CH = 16;
#endif
constexpr int DEPTH = 2;
constexpr int AQK = AH * 128, AW = AH * 128, BQK = BH * 128, BW = BH * 128, CW = CH * 64;
constexpr int CSH = 3 * CW + 128;
constexpr int O_AQ = 0, O_AK = AQK, O_AV = 2 * AQK, O_AG = O_AV + AW, O_BQ = O_AG + AW, O_BF = O_BQ + BQK, O_BI = O_BF + BQK,
              O_BG = O_BI + BW, O_CP = O_BG + BW, O_CG = O_CP + CSH, O_MA = O_CG + CW, O_MB = O_MA + D, O_MC = O_MB + D, NC = O_MC + D;
constexpr int CP_R = 0, CP_WLO = CW, CP_K = CW + 64, CP_V = 2 * CW + 64, CP_ALO = 3 * CW + 64;
constexpr int MP = NB * T, MS = NSB * TS, M = MP + MS, NSEQ = NB + NSB, KS = PAST + TS;
constexpr int NCHK = M / 64, PCH = T / 64, SCH = TS / 64;
constexpr int MAXPOS = (T > KS ? T : KS);
constexpr float EPS = 1e-6f;

constexpr size_t OO_Y = 0;
constexpr size_t OO_KP = (size_t)M * D;
constexpr size_t OO_VP = OO_KP + (size_t)DEPTH * MP * AQK;
constexpr size_t OO_HP = OO_VP + (size_t)DEPTH * MP * AW;
constexpr size_t OO_RP = OO_HP + (size_t)DEPTH * NB * BH * 16384;
constexpr size_t OO_SP = OO_RP + (size_t)DEPTH * NB * CH * 4096;
constexpr size_t OO_KS = OO_SP + (size_t)DEPTH * NB * CSH;
constexpr size_t OO_VS = OO_KS + (size_t)DEPTH * MS * AQK;
constexpr size_t OO_HS = OO_VS + (size_t)DEPTH * MS * AW;
constexpr size_t OO_RS = OO_HS + (size_t)DEPTH * NSB * BH * 16384;
constexpr size_t OO_SS = OO_RS + (size_t)DEPTH * NSB * CH * 4096;
constexpr size_t OUT_TOTAL = OO_SS + (size_t)DEPTH * NSB * CSH;

constexpr size_t al256(size_t x) { return (x + 255) & ~(size_t)255; }
constexpr size_t W_PROJ = 0;
constexpr size_t W_HN = al256(W_PROJ + (size_t)M * NC * 2);
constexpr size_t W_HGX = al256(W_HN + (size_t)M * D * 2);
constexpr size_t W_DL = al256(W_HGX + (size_t)NCHK * BH * 2 * 8192 * 2);
constexpr size_t W_RWW = al256(W_DL + (size_t)NCHK * BH * 128 * 4);
constexpr size_t W_RWR = al256(W_RWW + (size_t)M * CW * 4);
constexpr size_t W_RWK = al256(W_RWR + (size_t)M * CW * 2);
constexpr size_t W_RWA = al256(W_RWK + (size_t)M * CW * 2);
constexpr size_t W_RWB = al256(W_RWA + (size_t)M * CW * 2);
constexpr size_t W_RWV0 = al256(W_RWB + (size_t)M * CW * 2);
constexpr size_t W_RWV1 = al256(W_RWV0 + (size_t)M * CW * 2);
constexpr size_t W_VTP = al256(W_RWV1 + (size_t)M * CW * 2);
constexpr size_t W_KBS = al256(W_VTP + (size_t)NB * AH * 128 * T * 2);
constexpr size_t W_VTS = al256(W_KBS + (size_t)NSB * AH * KS * 128 * 2);
constexpr size_t W_WT = al256(W_VTS + (size_t)NSB * AH * 128 * KS * 2);
constexpr size_t WT_IN = 0, WT_OA = (size_t)NC * D, WT_OB = WT_OA + (size_t)D * AW, WT_OC = WT_OB + (size_t)D * BW, WT_OO = WT_OC + (size_t)D * CW,
                 WT_LAYER = WT_OO + (size_t)D * D;
constexpr size_t W_ROPE = al256(W_WT + (size_t)DEPTH * WT_LAYER * 2);
constexpr size_t W_CNT = al256(W_ROPE + (size_t)MAXPOS * 16 * 4);
constexpr size_t WS_TOTAL = W_CNT + 256;

struct Params { const float* in[32]; float* out; char* ws; };

enum { I_XP, I_XS, I_CK, I_CV, I_SH, I_SR, I_SS, I_NG, I_WIN, I_QNG, I_KNG, I_LAM, I_SUBG, I_BLOW, I_BNG, I_MU, I_W0, I_W2, I_A0, I_A2,
       I_KK, I_KA, I_RK, I_LNW, I_LNB, I_VW1, I_VW2, I_V0, I_WOA, I_WOB, I_WOC, I_WO };

DI bf16 f2bf(float x) { unsigned u = __float_as_uint(x); u += 0x7fffu + ((u >> 16) & 1u); return (bf16)(u >> 16); }
DI float bf2f(bf16 s) { return __uint_as_float(((unsigned)s) << 16); }
DI float sigm(float x) { return 1.0f / (1.0f + __expf(-x)); }
DI float siluf(float x) { return x / (1.0f + __expf(-x)); }
union V8 { bf16x8 v; uint4 u; uint2 h[2]; bf16 s[8]; };
union V4 { uint2 u; bf16 s[4]; };
DI void ld8(const bf16* p, float* o) { V8 t; t.u = *(const uint4*)p;
#pragma unroll
  for (int i = 0; i < 8; i++) o[i] = bf2f(t.s[i]); }
DI void ld4(const bf16* p, float* o) { V4 t; t.u = *(const uint2*)p;
#pragma unroll
  for (int i = 0; i < 4; i++) o[i] = bf2f(t.s[i]); }
DI bf16x8 ldfrag16(const bf16* p) { V8 t; t.u = *(const uint4*)p; return t.v; }
DI bf16x8 ldfrag8x2(const bf16* p0, const bf16* p1) { V8 t; t.h[0] = *(const uint2*)p0; t.h[1] = *(const uint2*)p1; return t.v; }
DI bf16x8 pack8(const f32x16& x, int s) { V8 t;
#pragma unroll
  for (int j = 0; j < 8; j++) t.s[j] = f2bf(x[8 * s + j]); return t.v; }
DI f32x16 zero16() { f32x16 z;
#pragma unroll
  for (int i = 0; i < 16; i++) z[i] = 0.f; return z; }
DI int crow(int reg, int h) { return (reg & 3) + 8 * (reg >> 2) + 4 * h; }

struct ChunkInfo { int seq, lc, tok0, pos0; };
DI ChunkInfo chunk_info(int gc) { ChunkInfo c; c.tok0 = gc * 64;
  if (gc < NB * PCH) { c.seq = gc / PCH; c.lc = gc % PCH; c.pos0 = c.lc * 64; }
  else { int r = gc - NB * PCH; c.seq = NB + r / SCH; c.lc = r % SCH; c.pos0 = PAST + c.lc * 64; }
  return c; }
DI int seq_tok0(int seq) { return seq < NB ? seq * T : MP + (seq - NB) * TS; }
DI int seq_len(int seq) { return seq < NB ? T : TS; }

__device__ void transpose_w(const float* src, bf16* dst, int K, int N, float* tile  ) {
  const int tid = TID(); const int nkt = K / 64, nnt = N / 64;
  for (int t = BID(); t < nkt * nnt; t += gridDim.x) {
    const int k0 = (t / nnt) * 64, n0 = (t % nnt) * 64;
    for (int i = 0; i < 16; i++) { int r = i * 4 + tid / 64, c = tid % 64; tile[r * 65 + c] = src[(size_t)(k0 + r) * N + n0 + c]; }
    __syncthreads();
    for (int i = 0; i < 16; i++) { int n = i * 4 + tid / 64, k = tid % 64; dst[(size_t)(n0 + n) * K + k0 + k] = f2bf(tile[k * 65 + n]); }
    __syncthreads();
  }
}
__device__ void phase_wprep(const Params& p, char* smem) {
  float* tile = (float*)smem;
  for (int l = 0; l < DEPTH; l++) {
    bf16* wt = (bf16*)(p.ws + W_WT) + (size_t)l * WT_LAYER;
    transpose_w(p.in[I_WIN] + (size_t)l * D * NC, wt + WT_IN, D, NC, tile);
    transpose_w(p.in[I_WOA] + (size_t)l * AW * D, wt + WT_OA, AW, D, tile);
    transpose_w(p.in[I_WOB] + (size_t)l * BW * D, wt + WT_OB, BW, D, tile);
    transpose_w(p.in[I_WOC] + (size_t)l * CW * D, wt + WT_OC, CW, D, tile);
    transpose_w(p.in[I_WO] + (size_t)l * D * D, wt + WT_OO, D, D, tile);
  }
  float* rope = (float*)(p.ws + W_ROPE);
  for (int i = BID() * blockDim.x + TID(); i < MAXPOS * 8; i += gridDim.x * blockDim.x) {
    int pos = i / 8, j = i % 8;
    double inv = pow(500000.0, -(double)j / 8.0);
    double ang = (double)pos * inv;
    rope[pos * 16 + j] = (float)cos(ang); rope[pos * 16 + 8 + j] = (float)sin(ang);
  }
}

DI const float* x_row(const Params& p, int l, int m) {
  if (l == 0) return m < MP ? p.in[I_XP] + (size_t)m * D : p.in[I_XS] + (size_t)(m - MP) * D;
  return p.out + OO_Y + (size_t)m * D;
}
__device__ void phase_rmsnorm(const Params& p, int l) {
  const int lane = TID() % 64, w = TID() / 64;
  bf16* hn = (bf16*)(p.ws + W_HN);
  const float* g = p.in[I_NG] + (size_t)l * D;
  for (int m = BID() * 4 + w; m < M; m += gridDim.x * 4) {
    const float* x = x_row(p, l, m);
    float ss = 0.f;
    for (int c = lane * 4; c < D; c += 256) { float4 v = *(const float4*)(x + c); ss += v.x * v.x + v.y * v.y + v.z * v.z + v.w * v.w; }
    for (int o = 32; o >= 1; o >>= 1) ss += __shfl_xor(ss, o);
    const float rs = rsqrtf(ss / D + EPS);
    for (int c = lane * 4; c < D; c += 256) { float4 v = *(const float4*)(x + c); float4 gg = *(const float4*)(g + c);
      V4 o; o.s[0] = f2bf(v.x * rs * gg.x); o.s[1] = f2bf(v.y * rs * gg.y); o.s[2] = f2bf(v.z * rs * gg.z); o.s[3] = f2bf(v.w * rs * gg.w);
      *(uint2*)(hn + (size_t)m * D + c) = o.u; }
  }
}

constexpr int GLD = 40;
template <int NJ> DI void gemm_mainloop(const bf16* A, size_t lda, const bf16* Bt, size_t ldb, int K, int m0, int n0, bf16* lds, f32x16 acc[2][NJ]) {
  const int tid = TID(), lane = tid % 64, w = tid / 64, wm = w / 2, wn = w % 2, lr = lane % 32, lh = lane / 32;
  const int nk = K / 32;
  uint4 ra[2], rb[2];
  const int r0 = tid / 4, kc = (tid % 4) * 8;
#pragma unroll
  for (int i = 0; i < 2; i++) { ra[i] = *(const uint4*)(A + (size_t)(m0 + r0 + 64 * i) * lda + kc); if (i < NJ) rb[i] = *(const uint4*)(Bt + (size_t)(n0 + r0 + 64 * i) * ldb + kc); }
#pragma unroll
  for (int i = 0; i < 2; i++) { *(uint4*)(lds + (r0 + 64 * i) * GLD + kc) = ra[i]; if (i < NJ) *(uint4*)(lds + 128 * GLD + (r0 + 64 * i) * GLD + kc) = rb[i]; }
  __syncthreads();
  for (int kt = 0; kt < nk; kt++) {
    const int cur = kt & 1;
    const bf16* sAc = lds + cur * (2 * 128 * GLD); const bf16* sBc = sAc + 128 * GLD;
    bf16* sAn = lds + (cur ^ 1) * (2 * 128 * GLD); bf16* sBn = sAn + 128 * GLD;
    if (kt + 1 < nk) {
#pragma unroll
      for (int i = 0; i < 2; i++) { ra[i] = *(const uint4*)(A + (size_t)(m0 + r0 + 64 * i) * lda + (kt + 1) * 32 + kc);
                                    if (i < NJ) rb[i] = *(const uint4*)(Bt + (size_t)(n0 + r0 + 64 * i) * ldb + (kt + 1) * 32 + kc); }
    }
#pragma unroll
    for (int ks = 0; ks < 2; ks++) {
      bf16x8 fa[2], fb[NJ];
#pragma unroll
      for (int i = 0; i < 2; i++) { fa[i] = ldfrag16(sAc + (wm * 64 + i * 32 + lr) * GLD + ks * 16 + lh * 8);
                                    if (i < NJ) fb[i] = ldfrag16(sBc + (wn * 32 * NJ + i * 32 + lr) * GLD + ks * 16 + lh * 8); }
#pragma unroll
      for (int i = 0; i < 2; i++)
#pragma unroll
        for (int j = 0; j < NJ; j++) acc[i][j] = MFMA32(fa[i], fb[j], acc[i][j]);
    }
    if (kt + 1 < nk) {
#pragma unroll
      for (int i = 0; i < 2; i++) { *(uint4*)(sAn + (r0 + 64 * i) * GLD + kc) = ra[i]; if (i < NJ) *(uint4*)(sBn + (r0 + 64 * i) * GLD + kc) = rb[i]; }
    }
    __syncthreads();
  }
}

__device__ void phase_proj(const Params& p, int l, char* smem) {
  const bf16* hn = (const bf16*)(p.ws + W_HN);
  const bf16* wt = (const bf16*)(p.ws + W_WT) + (size_t)l * WT_LAYER + WT_IN;
  bf16* proj = (bf16*)(p.ws + W_PROJ);
  const int lane = TID() % 64, w = TID() / 64, wm = w / 2, wn = w % 2, lr = lane % 32, lh = lane / 32;
  constexpr int NT = NC / 128, MT = M / 128;
  for (int t = BID(); t < MT * NT; t += gridDim.x) {
    const int m0 = (t / NT) * 128, n0 = (t % NT) * 128;
    f32x16 acc[2][2];
#pragma unroll
    for (int i = 0; i < 2; i++)
#pragma unroll
      for (int j = 0; j < 2; j++) acc[i][j] = zero16();
    gemm_mainloop<2>(hn, D, wt, D, D, m0, n0, (bf16*)smem, acc);
#pragma unroll
    for (int i = 0; i < 2; i++)
#pragma unroll
      for (int j = 0; j < 2; j++)
#pragma unroll
        for (int r = 0; r < 16; r++) {
          const int row = m0 + wm * 64 + i * 32 + crow(r, lh), col = n0 + wn * 64 + j * 32 + lr;
          proj[(size_t)row * NC + col] = f2bf(acc[i][j][r]);
        }
  }
}

__device__ void phase_merge(const Params& p, int l, char* smem) {
  const bf16* proj = (const bf16*)(p.ws + W_PROJ);
  const bf16* wt = (const bf16*)(p.ws + W_WT) + (size_t)l * WT_LAYER;
  bf16* mrg = (bf16*)(p.ws + W_HN);
  const int lane = TID() % 64, w = TID() / 64, wm = w / 2, wn = w % 2, lr = lane % 32, lh = lane / 32;
  constexpr int NT = D / 64, MT = M / 128;
  for (int t = BID(); t < MT * NT; t += gridDim.x) {
    const int m0 = (t / NT) * 128, n0 = (t % NT) * 64;
    f32x16 tot[2];
    tot[0] = zero16(); tot[1] = zero16();
#pragma unroll 1
    for (int mx = 0; mx < 3; mx++) {
      f32x16 acc[2][1];
      acc[0][0] = zero16(); acc[1][0] = zero16();
      const int acol = mx == 0 ? O_AQ : (mx == 1 ? O_BQ : O_CP);
      const int Kx = mx == 0 ? AW : (mx == 1 ? BW : CW);
      const size_t woff = mx == 0 ? WT_OA : (mx == 1 ? WT_OB : WT_OC);
      const int gcol = O_MA + mx * D;
      gemm_mainloop<1>(proj + acol, NC, wt + woff, Kx, Kx, m0, n0, (bf16*)smem, acc);
#pragma unroll
      for (int i = 0; i < 2; i++)
#pragma unroll
        for (int r = 0; r < 16; r++) {
          const int row = m0 + wm * 64 + i * 32 + crow(r, lh), col = n0 + wn * 32 + lr;
          tot[i][r] += sigm(bf2f(proj[(size_t)row * NC + gcol + col])) * acc[i][0][r];
        }
    }
#pragma unroll
    for (int i = 0; i < 2; i++)
#pragma unroll
      for (int r = 0; r < 16; r++) {
        const int row = m0 + wm * 64 + i * 32 + crow(r, lh), col = n0 + wn * 32 + lr;
        mrg[(size_t)row * D + col] = f2bf(tot[i][r]);
      }
  }
}

__device__ void phase_yout(const Params& p, int l, char* smem) {
  const bf16* mrg = (const bf16*)(p.ws + W_HN);
  const bf16* wt = (const bf16*)(p.ws + W_WT) + (size_t)l * WT_LAYER + WT_OO;
  const int lane = TID() % 64, w = TID() / 64, wm = w / 2, wn = w % 2, lr = lane % 32, lh = lane / 32;
  constexpr int NT = D / 128, MT = M / 128;
  for (int t = BID(); t < MT * NT; t += gridDim.x) {
    const int m0 = (t / NT) * 128, n0 = (t % NT) * 128;
    f32x16 acc[2][2];
#pragma unroll
    for (int i = 0; i < 2; i++)
#pragma unroll
      for (int j = 0; j < 2; j++) acc[i][j] = zero16();
    gemm_mainloop<2>(mrg, D, wt, D, D, m0, n0, (bf16*)smem, acc);
#pragma unroll
    for (int i = 0; i < 2; i++)
#pragma unroll
      for (int j = 0; j < 2; j++)
#pragma unroll
        for (int r = 0; r < 16; r++) {
          const int row = m0 + wm * 64 + i * 32 + crow(r, lh), col = n0 + wn * 64 + j * 32 + lr;
          const float xv = x_row(p, l, row)[col];
          p.out[OO_Y + (size_t)row * D + col] = xv + acc[i][j][r];
        }
  }
}

__device__ void prep_attn_chunk(const Params& p, int l, int gc, char* smem) {
  const int tid = TID();
  const ChunkInfo ci = chunk_info(gc);
  bf16* proj = (bf16*)(p.ws + W_PROJ);
  const float* rope = (const float*)(p.ws + W_ROPE);
  const float* qg = p.in[I_QNG] + l * 64; const float* kg = p.in[I_KNG] + l * 64;
  const bool samp = ci.seq >= NB; const int sb = ci.seq - NB;
  const int sub = tid % 8;
  constexpr int NVEC = 64 * 2 * AH * 2;
  for (int v0 = 0; v0 < NVEC; v0 += 32) {
    const int vi = v0 + tid / 8;
    const int t = vi / (4 * AH), rem = vi % (4 * AH), isk = rem / (2 * AH), hn2 = rem % (2 * AH);
    const int tok = ci.tok0 + t, pos = ci.pos0 + t;
    bf16* src = proj + (size_t)tok * NC + (isk ? O_AK : O_AQ) + hn2 * 64 + sub * 8;
    float x[8]; ld8(src, x);
    float ss = 0.f;
#pragma unroll
    for (int i = 0; i < 8; i++) ss += x[i] * x[i];
    ss += __shfl_xor(ss, 1); ss += __shfl_xor(ss, 2); ss += __shfl_xor(ss, 4);
    const float rs = rsqrtf(ss / 64.f + EPS);
    const float* g = isk ? kg : qg;
#pragma unroll
    for (int i = 0; i < 8; i++) x[i] = x[i] * rs * g[sub * 8 + i];
    float y[8];
#pragma unroll
    for (int i = 0; i < 8; i++) { float o = __shfl_xor(x[i], 1); y[i] = o; }
    if (sub < 2) {
#pragma unroll
      for (int i = 0; i < 8; i++) { const float c = rope[pos * 16 + i], s = rope[pos * 16 + 8 + i];
        x[i] = (sub == 0) ? (x[i] * c - y[i] * s) : (x[i] * c + y[i] * s); }
    }
    if (isk) {
      float* ko = p.out + (samp ? OO_KS + ((size_t)l * MS + (tok - MP)) * AQK : OO_KP + ((size_t)l * MP + tok) * AQK) + hn2 * 64 + sub * 8;
      *(float4*)ko = make_float4(x[0], x[1], x[2], x[3]); *(float4*)(ko + 4) = make_float4(x[4], x[5], x[6], x[7]);
      V8 o;
#pragma unroll
      for (int i = 0; i < 8; i++) o.s[i] = f2bf(x[i]);
      if (samp) { bf16* kb = (bf16*)(p.ws + W_KBS) + ((size_t)(sb * AH + hn2 / 2) * KS + PAST + ci.lc * 64 + t) * 128 + (hn2 % 2) * 64 + sub * 8; *(uint4*)kb = o.u; }
      else *(uint4*)src = o.u;
    } else {
      V8 o;
#pragma unroll
      for (int i = 0; i < 8; i++) o.s[i] = f2bf(x[i] * 0.125f);
      *(uint4*)src = o.u;
    }
  }
  bf16* tile = (bf16*)smem;
  for (int h = 0; h < AH; h++) {
    __syncthreads();
    for (int i = 0; i < 4; i++) { const int c = tid + i * 256, t = c / 16, d8 = (c % 16) * 8; const int tok = ci.tok0 + t;
      const bf16* src = proj + (size_t)tok * NC + O_AV + h * 128 + d8;
      V8 u; u.u = *(const uint4*)src;
      *(uint4*)(tile + t * 136 + d8) = u.u;
      float* vo = p.out + (samp ? OO_VS + ((size_t)l * MS + (tok - MP)) * AW : OO_VP + ((size_t)l * MP + tok) * AW) + h * 128 + d8;
      *(float4*)vo = make_float4(bf2f(u.s[0]), bf2f(u.s[1]), bf2f(u.s[2]), bf2f(u.s[3]));
      *(float4*)(vo + 4) = make_float4(bf2f(u.s[4]), bf2f(u.s[5]), bf2f(u.s[6]), bf2f(u.s[7])); }
    __syncthreads();
    { const int dv = tid / 2, th = tid % 2;
      bf16* dst = samp ? (bf16*)(p.ws + W_VTS) + ((size_t)(sb * AH + h) * 128 + dv) * KS + PAST + ci.lc * 64 + th * 32
                       : (bf16*)(p.ws + W_VTP) + ((size_t)(ci.seq * AH + h) * 128 + dv) * T + ci.lc * 64 + th * 32;
#pragma unroll
      for (int q = 0; q < 4; q++) { V8 o;
#pragma unroll
        for (int i = 0; i < 8; i++) o.s[i] = tile[(th * 32 + q * 8 + i) * 136 + dv];
        *(uint4*)(dst + q * 8) = o.u; } }
  }
  __syncthreads();
}
__device__ void prep_past_tile(const Params& p, int l, int item, char* smem) {
  const int tid = TID();
  constexpr int NKT = PAST / 64;
  const int kt = item % NKT, h = (item / NKT) % AH, sb = item / (NKT * AH);
  const float* ck = p.in[I_CK] + (((size_t)l * NSB + sb) * PAST + kt * 64) * AQK + h * 128;
  const float* cv = p.in[I_CV] + (((size_t)l * NSB + sb) * PAST + kt * 64) * AW + h * 128;
  bf16* kb = (bf16*)(p.ws + W_KBS) + ((size_t)(sb * AH + h) * KS + kt * 64) * 128;
  bf16* tile = (bf16*)smem;
  __syncthreads();
  for (int i = 0; i < 4; i++) { const int c = tid + i * 256, t = c / 16, d8 = (c % 16) * 8;
    float4 a = *(const float4*)(ck + (size_t)t * AQK + d8), b = *(const float4*)(ck + (size_t)t * AQK + d8 + 4);
    V8 o; o.s[0] = f2bf(a.x); o.s[1] = f2bf(a.y); o.s[2] = f2bf(a.z); o.s[3] = f2bf(a.w); o.s[4] = f2bf(b.x); o.s[5] = f2bf(b.y); o.s[6] = f2bf(b.z); o.s[7] = f2bf(b.w);
    *(uint4*)(kb + (size_t)t * 128 + d8) = o.u;
    a = *(const float4*)(cv + (size_t)t * AW + d8); b = *(const float4*)(cv + (size_t)t * AW + d8 + 4);
    o.s[0] = f2bf(a.x); o.s[1] = f2bf(a.y); o.s[2] = f2bf(a.z); o.s[3] = f2bf(a.w); o.s[4] = f2bf(b.x); o.s[5] = f2bf(b.y); o.s[6] = f2bf(b.z); o.s[7] = f2bf(b.w);
    *(uint4*)(tile + t * 136 + d8) = o.u; }
  __syncthreads();
  { const int dv = tid / 2, th = tid % 2;
    bf16* dst = (bf16*)(p.ws + W_VTS) + ((size_t)(sb * AH + h) * 128 + dv) * KS + kt * 64 + th * 32;
#pragma unroll
    for (int q = 0; q < 4; q++) { V8 o;
#pragma unroll
      for (int i = 0; i < 8; i++) o.s[i] = tile[(th * 32 + q * 8 + i) * 136 + dv];
      *(uint4*)(dst + q * 8) = o.u; } }
  __syncthreads();
}
__device__ void prep_hgrn(const Params& p, int l, int item, char* smem) {
  const int tid = TID(), k = tid % 128, th = tid / 128;
  const int gc = item / BH, h = item % BH;
  const ChunkInfo ci = chunk_info(gc);
  bf16* proj = (bf16*)(p.ws + W_PROJ);
  float* tot = (float*)smem;
  float lb = 0.f;
  if (l == 1) { const float b0 = p.in[I_BLOW][h * 128 + k], b1 = p.in[I_BLOW][BQK + h * 128 + k]; lb = 1.f / (1.f + __expf(b0 - b1)); }
  float zs[32], cs[32];
  bf16* base = proj + (size_t)(ci.tok0 + th * 32) * NC + h * 128 + k;
  float run = 0.f;
#pragma unroll
  for (int i = 0; i < 32; i++) { const float z = bf2f(base[(size_t)i * NC + O_BF]); zs[i] = z; const float f = lb + (1.f - lb) * sigm(z); run += __logf(f); cs[i] = run; }
  __syncthreads();
  tot[th * 128 + k] = run;
  __syncthreads();
  const float t0 = tot[k], t1 = tot[128 + k];
  const float ref = t0, last = t0 + t1, off = th ? t0 : 0.f;
  V8 kt8[4], it8[4];
#pragma unroll
  for (int i = 0; i < 32; i++) {
    const float cum = cs[i] + off, z = zs[i];
    const float kin = (1.f - lb) * sigm(-z);
    const float qv = siluf(bf2f(base[(size_t)i * NC + O_BQ]));
    const bf16 iv = base[(size_t)i * NC + O_BI];
    base[(size_t)i * NC + O_BQ] = f2bf(qv * __expf(fminf(cum - ref, 80.f)));
    base[(size_t)i * NC + O_BF] = f2bf(kin * __expf(fminf(ref - cum, 80.f)));
    base[(size_t)i * NC + O_BI] = f2bf(qv * __expf(cum));
    kt8[i / 8].s[i % 8] = f2bf(kin * __expf(last - cum));
    it8[i / 8].s[i % 8] = iv;
  }
  bf16* hgx = (bf16*)(p.ws + W_HGX) + (size_t)item * 2 * 8192;
#pragma unroll
  for (int q = 0; q < 4; q++) { *(uint4*)(hgx + k * 64 + th * 32 + q * 8) = kt8[q].u; *(uint4*)(hgx + 8192 + k * 64 + th * 32 + q * 8) = it8[q].u; }
  if (th == 0) ((float*)(p.ws + W_DL))[(size_t)item * 128 + k] = __expf(last);
  __syncthreads();
}
__device__ void prep_rwkv(const Params& p, int l, int ti, char* smem) {
  const int tid = TID();
  const int tok0 = ti * 32;
  const ChunkInfo ci = chunk_info(tok0 / 64);
  const int seqt0 = seq_tok0(ci.seq);
  const bf16* proj = (const bf16*)(p.ws + W_PROJ);
  const bf16* hn = (const bf16*)(p.ws + W_HN);
  const float* mu = p.in[I_MU] + (size_t)l * CSH;
  const float* shp = (ci.seq >= NB) ? p.in[I_SS] + ((size_t)l * NSB + (ci.seq - NB)) * CSH : nullptr;
  float* tw = (float*)smem;
  float* al = tw + 32 * 64;
  float* hv = al + 32 * 64;
  auto cs = [&](int t, int col) -> float {
    const int tok = tok0 + t;
    const float cur = bf2f(proj[(size_t)tok * NC + O_CP + col]);
    float prev;
    if (tok == seqt0) prev = shp ? shp[col] : 0.f; else prev = bf2f(proj[(size_t)(tok - 1) * NC + O_CP + col]);
    return cur + (prev - cur) * mu[col];
  };
  __syncthreads();
  for (int i = 0; i < 8; i++) { const int e = tid + i * 256, t = e / 64, j = e % 64;
    tw[e] = tanhf(cs(t, CP_WLO + j)); al[e] = cs(t, CP_ALO + j); }
  if (l > 0) {
    const int t = tid / 8, jg = (tid % 8) * 4;
    const float* w1 = p.in[I_VW1] + (size_t)(l - 1) * D * 32;
    float a0 = 0, a1 = 0, a2 = 0, a3 = 0;
    const bf16* hr = hn + (size_t)(tok0 + t) * D;
#pragma unroll 4
    for (int d = 0; d < D; d++) { const float hvv = bf2f(hr[d]); const float4 wv = *(const float4*)(w1 + (size_t)d * 32 + jg);
      a0 += hvv * wv.x; a1 += hvv * wv.y; a2 += hvv * wv.z; a3 += hvv * wv.w; }
    hv[t * 32 + jg] = a0; hv[t * 32 + jg + 1] = a1; hv[t * 32 + jg + 2] = a2; hv[t * 32 + jg + 3] = a3;
  }
  __syncthreads();
  const bool act = tid * 4 < CW;
  const int c4 = act ? tid * 4 : 0;
  const float* w2 = p.in[I_W2] + (size_t)l * 64 * CW; const float* a2p = p.in[I_A2] + (size_t)l * 64 * CW;
  float* rww = (float*)(p.ws + W_RWW);
  bf16* rwr = (bf16*)(p.ws + W_RWR); bf16* rwk = (bf16*)(p.ws + W_RWK); bf16* rwa = (bf16*)(p.ws + W_RWA); bf16* rwb = (bf16*)(p.ws + W_RWB);
  bf16* rwv = (bf16*)(p.ws + (l == 0 ? W_RWV0 : W_RWV1)); const bf16* vfirst = (const bf16*)(p.ws + W_RWV0);
  float* accs = hv + 32 * 32;
  for (int tg = 0; tg < 8; tg++) {
    {
      float aw[4][4], aa[4][4];
#pragma unroll
      for (int t = 0; t < 4; t++)
#pragma unroll
        for (int c = 0; c < 4; c++) { aw[t][c] = 0.f; aa[t][c] = 0.f; }
#pragma unroll 2
      for (int j = 0; j < 64; j++) {
        const float4 wv = *(const float4*)(w2 + (size_t)j * CW + c4), av = *(const float4*)(a2p + (size_t)j * CW + c4);
#pragma unroll
        for (int t = 0; t < 4; t++) { const float x = tw[(tg * 4 + t) * 64 + j], y = al[(tg * 4 + t) * 64 + j];
          aw[t][0] += x * wv.x; aw[t][1] += x * wv.y; aw[t][2] += x * wv.z; aw[t][3] += x * wv.w;
          aa[t][0] += y * av.x; aa[t][1] += y * av.y; aa[t][2] += y * av.z; aa[t][3] += y * av.w; }
      }
#pragma unroll
      for (int t = 0; t < 4; t++) { *(float4*)(accs + (t * 2) * 1024 + tid * 4) = make_float4(aw[t][0], aw[t][1], aw[t][2], aw[t][3]);
                                    *(float4*)(accs + (t * 2 + 1) * 1024 + tid * 4) = make_float4(aa[t][0], aa[t][1], aa[t][2], aa[t][3]); }
    }
#pragma unroll 1
    for (int t = 0; t < 4; t++) {
      const int tt = tg * 4 + t, tok = tok0 + tt;
      const float4 awv = *(const float4*)(accs + (t * 2) * 1024 + tid * 4), aav = *(const float4*)(accs + (t * 2 + 1) * 1024 + tid * 4);
      const float awt[4] = {awv.x, awv.y, awv.z, awv.w}, aat[4] = {aav.x, aav.y, aav.z, aav.w};
      float rr[4], kk[4], vv[4], ww[4], a[4], kt[4], bb[4];
      float ss = 0.f;
      float vm[4] = {0.f, 0.f, 0.f, 0.f};
      if (l > 0) {
        const float* vw2 = p.in[I_VW2] + (size_t)(l - 1) * 32 * CW + c4;
#pragma unroll 4
        for (int j = 0; j < 32; j++) { const float hj = hv[tt * 32 + j]; const float4 wv = *(const float4*)(vw2 + (size_t)j * CW);
          vm[0] += hj * wv.x; vm[1] += hj * wv.y; vm[2] += hj * wv.z; vm[3] += hj * wv.w; }
      }
#pragma unroll
      for (int c = 0; c < 4; c++) {
        const int ch = c4 + c;
        rr[c] = cs(tt, CP_R + ch); const float kx = cs(tt, CP_K + ch); float vx = cs(tt, CP_V + ch);
        const float u = p.in[I_W0][(size_t)l * CW + ch] + awt[c];
        const float sp = fmaxf(-u, 0.f) + log1pf(__expf(-fabsf(u)));
        const float wlog = -sp - 0.5f;
        ww[c] = __expf(-__expf(wlog));
        a[c] = sigm(p.in[I_A0][(size_t)l * CW + ch] + aat[c]);
        if (l > 0) {
          const float s = p.in[I_V0][(size_t)(l - 1) * CW + ch] + vm[c];
          const float vf = bf2f(vfirst[(size_t)tok * CW + ch]);
          vx = vx + (vf - vx) * sigm(s);
        }
        vv[c] = vx;
        kk[c] = kx * p.in[I_KK][(size_t)l * CW + ch];
        ss += kk[c] * kk[c];
        kt[c] = kx * (1.f + (a[c] - 1.f) * p.in[I_KA][(size_t)l * CW + ch]);
      }
      ss += __shfl_xor(ss, 1); ss += __shfl_xor(ss, 2); ss += __shfl_xor(ss, 4); ss += __shfl_xor(ss, 8);
      const float inv = 1.f / fmaxf(sqrtf(ss), 1e-12f);
#pragma unroll
      for (int c = 0; c < 4; c++) { kk[c] *= inv; bb[c] = kk[c] * a[c]; kk[c] = -kk[c]; }
      if (act) {
        *(float4*)(rww + (size_t)tok * CW + c4) = make_float4(ww[0], ww[1], ww[2], ww[3]);
        V4 o;
#pragma unroll
        for (int c = 0; c < 4; c++) o.s[c] = f2bf(rr[c]);
        *(uint2*)(rwr + (size_t)tok * CW + c4) = o.u;
#pragma unroll
        for (int c = 0; c < 4; c++) o.s[c] = f2bf(kt[c]);
        *(uint2*)(rwk + (size_t)tok * CW + c4) = o.u;
#pragma unroll
        for (int c = 0; c < 4; c++) o.s[c] = f2bf(vv[c]);
        *(uint2*)(rwv + (size_t)tok * CW + c4) = o.u;
#pragma unroll
        for (int c = 0; c < 4; c++) o.s[c] = f2bf(kk[c]);
        *(uint2*)(rwa + (size_t)tok * CW + c4) = o.u;
#pragma unroll
        for (int c = 0; c < 4; c++) o.s[c] = f2bf(bb[c]);
        *(uint2*)(rwb + (size_t)tok * CW + c4) = o.u;
      }
    }
  }
  __syncthreads();
}
__device__ void phase_prep(const Params& p, int l, char* smem) {
#ifndef SUBMASK
#define SUBMASK 15
#endif
  if (SUBMASK & 1) for (int gc = BID(); gc < NCHK; gc += gridDim.x) prep_attn_chunk(p, l, gc, smem);
  if (SUBMASK & 2) for (int it = BID(); it < NSB * AH * (PAST / 64); it += gridDim.x) prep_past_tile(p, l, it, smem);
  if (SUBMASK & 4) for (int it = BID(); it < NCHK * BH; it += gridDim.x) prep_hgrn(p, l, it, smem);
  if (SUBMASK & 8) for (int ti = BID(); ti < M / 32; ti += gridDim.x) prep_rwkv(p, l, ti, smem);
  const bf16* proj = (const bf16*)(p.ws + W_PROJ);
  for (int i = BID() * blockDim.x + TID(); i < NSEQ * CSH; i += gridDim.x * blockDim.x) {
    const int seq = i / CSH, c = i % CSH; const int tok = seq_tok0(seq) + seq_len(seq) - 1;
    const float v = bf2f(proj[(size_t)tok * NC + O_CP + c]);
    if (seq < NB) p.out[OO_SP + ((size_t)l * NB + seq) * CSH + c] = v; else p.out[OO_SS + ((size_t)l * NSB + (seq - NB)) * CSH + c] = v;
  }
}

constexpr int KLD = 136, VLD = 72;
__device__ void attn_item(const Params& p, int l, int gc, int h, float lam, float lam_init, char* smem) {
  const int tid = TID(), lane = tid % 64, w = tid / 64, rh = w / 2, n = w % 2, lr = lane % 32, lh = lane / 32;
  const ChunkInfo ci = chunk_info(gc);
  bf16* proj = (bf16*)(p.ws + W_PROJ);
  const bool samp = ci.seq >= NB; const int sb = ci.seq - NB;
  const bf16* Kg; size_t ldk; const bf16* Vg; size_t ldv; int ntiles;
  if (!samp) { Kg = proj + (size_t)(ci.seq * T) * NC + O_AK + h * 128; ldk = NC; Vg = (const bf16*)(p.ws + W_VTP) + (size_t)(ci.seq * AH + h) * 128 * T; ldv = T; ntiles = ci.lc + 1; }
  else { Kg = (const bf16*)(p.ws + W_KBS) + (size_t)(sb * AH + h) * KS * 128; ldk = 128; Vg = (const bf16*)(p.ws + W_VTS) + (size_t)(sb * AH + h) * 128 * KS; ldv = KS; ntiles = PAST / 64 + ci.lc + 1; }
  bf16* sK = (bf16*)smem;
  bf16* sV = sK + 64 * KLD;
  bf16x8 qf[4];
  { const bf16* qp = proj + (size_t)(ci.tok0 + rh * 32 + lr) * NC + O_AQ + h * 128 + n * 64 + lh * 8;
#pragma unroll
    for (int ks = 0; ks < 4; ks++) qf[ks] = ldfrag16(qp + ks * 16); }
  f32x16 o[4];
#pragma unroll
  for (int i = 0; i < 4; i++) o[i] = zero16();
  float mrun = -1e30f, lrun = 0.f;
  for (int j = 0; j < ntiles; j++) {
    __syncthreads();
    for (int i = 0; i < 4; i++) { const int c = tid + i * 256;
      { const int r = c / 16, c8 = (c % 16) * 8; *(uint4*)(sK + r * KLD + c8) = *(const uint4*)(Kg + (size_t)(j * 64 + r) * ldk + c8); }
      { const int r = c / 8, c8 = (c % 8) * 8; *(uint4*)(sV + r * VLD + c8) = *(const uint4*)(Vg + (size_t)r * ldv + j * 64 + c8); } }
    __syncthreads();
    f32x16 s[2];
#pragma unroll
    for (int mt = 0; mt < 2; mt++) { s[mt] = zero16();
#pragma unroll
      for (int ks = 0; ks < 4; ks++) s[mt] = MFMA32(ldfrag16(sK + (mt * 32 + lr) * KLD + n * 64 + ks * 16 + lh * 8), qf[ks], s[mt]); }
    float mx = -1e30f;
#pragma unroll
    for (int mt = 0; mt < 2; mt++)
#pragma unroll
      for (int r = 0; r < 16; r++) mx = fmaxf(mx, s[mt][r]);
    mx = fmaxf(mx, __shfl_xor(mx, 32));
    const float mnew = fmaxf(mrun, mx);
    const float alpha = __expf(mrun - mnew);
    float rs = 0.f;
#pragma unroll
    for (int mt = 0; mt < 2; mt++)
#pragma unroll
      for (int r = 0; r < 16; r++) { const float e = __expf(s[mt][r] - mnew); s[mt][r] = e; rs += e; }
    rs += __shfl_xor(rs, 32);
    lrun = lrun * alpha + rs; mrun = mnew;
#pragma unroll
    for (int i = 0; i < 4; i++)
#pragma unroll
      for (int r = 0; r < 16; r++) o[i][r] *= alpha;
#pragma unroll
    for (int mt = 0; mt < 2; mt++)
#pragma unroll
      for (int s2 = 0; s2 < 2; s2++) {
        const bf16x8 pf = pack8(s[mt], s2);
#pragma unroll
        for (int dt = 0; dt < 4; dt++) {
          const bf16* vp = sV + (dt * 32 + lr) * VLD + mt * 32 + 16 * s2 + 4 * lh;
          o[dt] = MFMA32(ldfrag8x2(vp, vp + 8), pf, o[dt]);
        }
      }
  }
  __syncthreads();
  float* comb = (float*)smem;
  const float invl = 1.f / lrun;
  if (n == 1) {
#pragma unroll
    for (int dt = 0; dt < 4; dt++)
#pragma unroll
      for (int r = 0; r < 16; r++) comb[(rh * 32 + lr) * 129 + dt * 32 + crow(r, lh)] = o[dt][r] * invl;
  }
  __syncthreads();
  if (n == 0) {
    float ss = 0.f;
#pragma unroll
    for (int dt = 0; dt < 4; dt++)
#pragma unroll
      for (int r = 0; r < 16; r++) { const float v = o[dt][r] * invl - lam * comb[(rh * 32 + lr) * 129 + dt * 32 + crow(r, lh)]; o[dt][r] = v; ss += v * v; }
    ss += __shfl_xor(ss, 32);
    const float rstd = rsqrtf(ss / 128.f + EPS) * (1.f - lam_init);
    const float* sg = p.in[I_SUBG] + l * 128;
    const int tok = ci.tok0 + rh * 32 + lr;
#pragma unroll
    for (int dt = 0; dt < 4; dt++)
#pragma unroll
      for (int g = 0; g < 4; g++) {
        const int dv = dt * 32 + 8 * g + 4 * lh;
        float gate[4]; ld4(proj + (size_t)tok * NC + O_AG + h * 128 + dv, gate);
        V4 ov;
#pragma unroll
        for (int r = 0; r < 4; r++) ov.s[r] = f2bf(o[dt][4 * g + r] * rstd * sg[dv + r] * siluf(gate[r]));
        *(uint2*)(proj + (size_t)tok * NC + O_AQ + h * 128 + dv) = ov.u;
      }
  }
  __syncthreads();
}

constexpr int HLD = 136, TLD = 72;
__device__ void hgrn_item(const Params& p, int l, int seq, int h, char* smem) {
  const int tid = TID(), lane = tid % 64, w = tid / 64, lr = lane % 32, lh = lane / 32;
  bf16* proj = (bf16*)(p.ws + W_PROJ);
  const int nch = seq < NB ? PCH : SCH;
  const int gc0 = seq < NB ? seq * PCH : NB * PCH + (seq - NB) * SCH;
  bf16* X0 = (bf16*)smem;
  bf16* X1 = X0 + 9216;
  float* red = (float*)(X1 + 9216);
  f32x16 S[4];
  if (seq < NB) {
#pragma unroll
    for (int kt = 0; kt < 4; kt++) S[kt] = zero16();
  } else {
    const float* s0 = p.in[I_SH] + (((size_t)l * NSB + (seq - NB)) * BH + h) * 16384;
#pragma unroll
    for (int kt = 0; kt < 4; kt++) {
      const float* sp = s0 + (size_t)(kt * 32 + 4 * lh) * 128 + w * 32 + lr;
#pragma unroll
      for (int r = 0; r < 16; r++) S[kt][r] = sp[((r & 3) + 8 * (r >> 2)) * 128];
      SCHED_BARRIER();
    }
  }
  const float* ng = p.in[I_BNG] + l * 128;
  for (int c = 0; c < nch; c++) {
    const int gc = gc0 + c, tok0 = gc * 64;
    const size_t item = (size_t)gc * BH + h;
    const bf16* hgx = (const bf16*)(p.ws + W_HGX) + item * 2 * 8192;
    const float* dl = (const float*)(p.ws + W_DL) + item * 128;
    __syncthreads();
    for (int i = 0; i < 4; i++) { const int cc = tid + i * 256, r = cc / 16, c8 = (cc % 16) * 8;
      *(uint4*)(X0 + r * HLD + c8) = *(const uint4*)(proj + (size_t)(tok0 + r) * NC + O_BF + h * 128 + c8);
      *(uint4*)(X1 + r * HLD + c8) = *(const uint4*)(proj + (size_t)(tok0 + r) * NC + O_BQ + h * 128 + c8); }
    __syncthreads();
    f32x16 x00 = zero16(), x01 = zero16(), x11 = zero16();
#pragma unroll
    for (int ks = 0; ks < 8; ks++) {
      const bf16x8 b0 = ldfrag16(X0 + (lr) * HLD + ks * 16 + lh * 8), b1 = ldfrag16(X0 + (32 + lr) * HLD + ks * 16 + lh * 8);
      const bf16x8 a0 = ldfrag16(X1 + (lr) * HLD + ks * 16 + lh * 8), a1 = ldfrag16(X1 + (32 + lr) * HLD + ks * 16 + lh * 8);
      x00 = MFMA32(b0, a0, x00); x01 = MFMA32(b0, a1, x01); x11 = MFMA32(b1, a1, x11);
      if (ks & 1) SCHED_BARRIER();
    }
#pragma unroll
    for (int r = 0; r < 16; r++) { if (crow(r, lh) > lr) { x00[r] = 0.f; x11[r] = 0.f; } }
    bf16x8 xp00[2], xp01[2], xp11[2];
#pragma unroll
    for (int s2 = 0; s2 < 2; s2++) { xp00[s2] = pack8(x00, s2); xp01[s2] = pack8(x01, s2); xp11[s2] = pack8(x11, s2); }
    SCHED_BARRIER();
    bf16x8 itf[2][2];
#pragma unroll
    for (int st = 0; st < 2; st++)
#pragma unroll
      for (int s2 = 0; s2 < 2; s2++) { const bf16* ip = hgx + 8192 + (size_t)(w * 32 + lr) * 64 + st * 32 + 16 * s2 + 4 * lh; itf[st][s2] = ldfrag8x2(ip, ip + 8); }
    __syncthreads();
    for (int i = 0; i < 4; i++) { const int cc = tid + i * 256;
      { const int r = cc / 16, c8 = (cc % 16) * 8; *(uint4*)(X0 + r * HLD + c8) = *(const uint4*)(proj + (size_t)(tok0 + r) * NC + O_BI + h * 128 + c8); }
      { const int r = cc / 8, c8 = (cc % 8) * 8; *(uint4*)(X1 + r * TLD + c8) = *(const uint4*)(hgx + (size_t)r * 64 + c8); } }
    __syncthreads();
    f32x16 o0 = zero16(), o1 = zero16();
#pragma unroll
    for (int s2 = 0; s2 < 2; s2++) {
      o0 = MFMA32(itf[0][s2], xp00[s2], o0);
      o1 = MFMA32(itf[0][s2], xp01[s2], o1);
      o1 = MFMA32(itf[1][s2], xp11[s2], o1);
    }
    SCHED_BARRIER();
#pragma unroll
    for (int kt = 0; kt < 4; kt++)
#pragma unroll
      for (int s2 = 0; s2 < 2; s2++) {
        const bf16x8 sp = pack8(S[kt], s2);
        const bf16* q0 = X0 + (lr) * HLD + kt * 32 + 16 * s2 + 4 * lh; const bf16* q1 = X0 + (32 + lr) * HLD + kt * 32 + 16 * s2 + 4 * lh;
        o0 = MFMA32(sp, ldfrag8x2(q0, q0 + 8), o0);
        o1 = MFMA32(sp, ldfrag8x2(q1, q1 + 8), o1);
        if (s2) SCHED_BARRIER();
      }
    SCHED_BARRIER();
#pragma unroll
    for (int kt = 0; kt < 4; kt++) {
      SCHED_BARRIER();
#pragma unroll
      for (int g = 0; g < 4; g++) { const float4 dv = *(const float4*)(dl + kt * 32 + 8 * g + 4 * lh);
        S[kt][4 * g] *= dv.x; S[kt][4 * g + 1] *= dv.y; S[kt][4 * g + 2] *= dv.z; S[kt][4 * g + 3] *= dv.w; }
#pragma unroll
      for (int st = 0; st < 2; st++)
#pragma unroll
        for (int s2 = 0; s2 < 2; s2++) { const bf16* kp = X1 + (kt * 32 + lr) * TLD + st * 32 + 16 * s2 + 4 * lh;
          S[kt] = MFMA32(ldfrag8x2(kp, kp + 8), itf[st][s2], S[kt]); }
    }
    SCHED_BARRIER();
    float ss0 = 0.f, ss1 = 0.f;
#pragma unroll
    for (int r = 0; r < 16; r++) { ss0 += o0[r] * o0[r]; ss1 += o1[r] * o1[r]; }
    ss0 += __shfl_xor(ss0, 32); ss1 += __shfl_xor(ss1, 32);
    if (lh == 0) { red[w * 64 + lr] = ss0; red[w * 64 + 32 + lr] = ss1; }
    __syncthreads();
#pragma unroll
    for (int tt = 0; tt < 2; tt++) {
      const int t = tt * 32 + lr;
      const float tot = red[t] + red[64 + t] + red[128 + t] + red[192 + t];
      const float rstd = rsqrtf(tot / 128.f + EPS);
      const int tok = tok0 + t;
#pragma unroll
      for (int g = 0; g < 4; g++) {
        const int v = w * 32 + 8 * g + 4 * lh;
        float gate[4]; ld4(proj + (size_t)tok * NC + O_BG + h * 128 + v, gate);
        V4 ov;
#pragma unroll
        for (int r = 0; r < 4; r++) { const float ovv = (tt == 0 ? o0[4 * g + r] : o1[4 * g + r]); ov.s[r] = f2bf(ovv * rstd * ng[v + r] * siluf(gate[r])); }
        *(uint2*)(proj + (size_t)tok * NC + O_BQ + h * 128 + v) = ov.u;
      }
    }
  }
  float* so = p.out + (seq < NB ? OO_HP + (((size_t)l * NB + seq) * BH + h) * 16384 : OO_HS + (((size_t)l * NSB + (seq - NB)) * BH + h) * 16384);
#pragma unroll
  for (int kt = 0; kt < 4; kt++) {
    float* sp = so + (size_t)(kt * 32 + 4 * lh) * 128 + w * 32 + lr;
#pragma unroll
    for (int r = 0; r < 16; r++) sp[((r & 3) + 8 * (r >> 2)) * 128] = S[kt][r];
    SCHED_BARRIER();
  }
  __syncthreads();
}

__device__ void rwkv_item(const Params& p, int l, int seq, int h, char* smem) {
  const int tid = TID(), ri = tid / 4, sub = tid % 4;
  bf16* proj = (bf16*)(p.ws + W_PROJ);
  const float* rww = (const float*)(p.ws + W_RWW);
  const bf16* rwr = (const bf16*)(p.ws + W_RWR); const bf16* rwk = (const bf16*)(p.ws + W_RWK); const bf16* rwa = (const bf16*)(p.ws + W_RWA);
  const bf16* rwb = (const bf16*)(p.ws + W_RWB); const bf16* rwv = (const bf16*)(p.ws + (l == 0 ? W_RWV0 : W_RWV1));
  float* sw = (float*)smem; float* sr = sw + 2048; float* sk = sr + 2048; float* sv = sk + 2048; float* sa = sv + 2048; float* sbb = sa + 2048; float* sy = sbb + 2048;
  const int len = seq_len(seq), t0 = seq_tok0(seq);
  float S[16];
  if (seq < NB) {
#pragma unroll
    for (int j = 0; j < 16; j++) S[j] = 0.f;
  } else {
    const float* s0 = p.in[I_SR] + ((((size_t)l * NSB + (seq - NB)) * CH + h) * 64 + ri) * 64 + sub * 16;
#pragma unroll
    for (int j = 0; j < 16; j++) S[j] = s0[j];
  }
  const float* lnw = p.in[I_LNW] + (size_t)l * CW + h * 64; const float* lnb = p.in[I_LNB] + (size_t)l * CW + h * 64;
  const float* rk = p.in[I_RK] + (size_t)l * CW + h * 64;
  for (int tb = 0; tb < len; tb += 32) {
    __syncthreads();
    {
      const int t = tid / 8, c8 = (tid % 8) * 8; const size_t g = (size_t)(t0 + tb + t) * CW + h * 64 + c8;
      *(float4*)(sw + t * 64 + c8) = *(const float4*)(rww + g); *(float4*)(sw + t * 64 + c8 + 4) = *(const float4*)(rww + g + 4);
      float x[8];
      ld8(rwr + g, x);
#pragma unroll
      for (int i = 0; i < 8; i++) sr[t * 64 + c8 + i] = x[i];
      ld8(rwk + g, x);
#pragma unroll
      for (int i = 0; i < 8; i++) sk[t * 64 + c8 + i] = x[i];
      ld8(rwv + g, x);
#pragma unroll
      for (int i = 0; i < 8; i++) sv[t * 64 + c8 + i] = x[i];
      ld8(rwa + g, x);
#pragma unroll
      for (int i = 0; i < 8; i++) sa[t * 64 + c8 + i] = x[i];
      ld8(rwb + g, x);
#pragma unroll
      for (int i = 0; i < 8; i++) sbb[t * 64 + c8 + i] = x[i];
    }
    __syncthreads();
    for (int t = 0; t < 32; t++) {
      const float* pa = sa + t * 64 + sub * 16; const float* pw = sw + t * 64 + sub * 16; const float* pb = sbb + t * 64 + sub * 16;
      const float* pk = sk + t * 64 + sub * 16; const float* pr = sr + t * 64 + sub * 16;
      float dot = 0.f;
#pragma unroll
      for (int j = 0; j < 16; j++) dot += S[j] * pa[j];
      dot += __shfl_xor(dot, 1); dot += __shfl_xor(dot, 2);
      const float vi = sv[t * 64 + ri];
      float y = 0.f;
#pragma unroll
      for (int j = 0; j < 16; j++) { S[j] = S[j] * pw[j] + dot * pb[j] + vi * pk[j]; y += S[j] * pr[j]; }
      y += __shfl_xor(y, 1); y += __shfl_xor(y, 2);
      if (sub == 0) sy[t * 64 + ri] = y;
    }
    __syncthreads();
    {
      const int t = tid / 8, c8 = (tid % 8) * 8; const int tok = t0 + tb + t;
      float y[8]; float s1 = 0.f, bon = 0.f;
#pragma unroll
      for (int i = 0; i < 8; i++) { y[i] = sy[t * 64 + c8 + i]; s1 += y[i]; bon += sr[t * 64 + c8 + i] * sk[t * 64 + c8 + i] * rk[c8 + i]; }
      s1 += __shfl_xor(s1, 1); s1 += __shfl_xor(s1, 2); s1 += __shfl_xor(s1, 4);
      bon += __shfl_xor(bon, 1); bon += __shfl_xor(bon, 2); bon += __shfl_xor(bon, 4);
      const float mu = s1 / 64.f; float s2 = 0.f;
#pragma unroll
      for (int i = 0; i < 8; i++) { const float d = y[i] - mu; s2 += d * d; }
      s2 += __shfl_xor(s2, 1); s2 += __shfl_xor(s2, 2); s2 += __shfl_xor(s2, 4);
      const float rstd = rsqrtf(s2 / 64.f + 64e-5f);
      float gate[8]; ld8(proj + (size_t)tok * NC + O_CG + h * 64 + c8, gate);
      V8 ov;
#pragma unroll
      for (int i = 0; i < 8; i++) { const float o = (y[i] - mu) * rstd * lnw[c8 + i] + lnb[c8 + i] + bon * sv[t * 64 + c8 + i]; ov.s[i] = f2bf(o * siluf(gate[i])); }
      *(uint4*)(proj + (size_t)tok * NC + O_CP + h * 64 + c8) = ov.u;
    }
  }
  float* so = p.out + (seq < NB ? OO_RP + ((((size_t)l * NB + seq) * CH + h) * 64 + ri) * 64 : OO_RS + ((((size_t)l * NSB + (seq - NB)) * CH + h) * 64 + ri) * 64) + sub * 16;
#pragma unroll
  for (int j = 0; j < 16; j++) so[j] = S[j];
  __syncthreads();
}

__device__ void phase_mixers(const Params& p, int l, char* smem) {
  __shared__ int s_item;
  int* cnt = (int*)(p.ws + W_CNT) + l;
  const float* lp = p.in[I_LAM] + (size_t)l * 256;
  float d1 = 0.f, d2 = 0.f;
  for (int i = 0; i < 64; i++) { d1 += lp[i] * lp[64 + i]; d2 += lp[128 + i] * lp[192 + i]; }
  const float lam_init = 0.8f - 0.6f * expf(-0.3f * (float)l);
  const float lam = expf(d1) - expf(d2) + lam_init;
  constexpr int N_RWP = NB * CH, N_HGP = NB * BH, N_ATP = NB * PCH * AH, N_RWS = NSB * CH, N_HGS = NSB * BH, N_ATS = NSB * SCH * AH;
  constexpr int NTOT = N_RWP + N_HGP + N_ATP + N_RWS + N_HGS + N_ATS;
  for (;;) {
    __syncthreads();
    if (TID() == 0) s_item = atomicAdd(cnt, 1);
    __syncthreads();
    int it = s_item;
    if (it >= NTOT) break;
    if (it < N_RWP) { if (SUBMASK & 1) rwkv_item(p, l, it / CH, it % CH, smem); continue; }
    it -= N_RWP;
    if (it < N_HGP) { if (SUBMASK & 2) hgrn_item(p, l, it / BH, it % BH, smem); continue; }
    it -= N_HGP;
    if (it < N_ATP) {
      const int lc = PCH - 1 - it / (NB * AH), r = it % (NB * AH); if (SUBMASK & 4) attn_item(p, l, (r / AH) * PCH + lc, r % AH, lam, lam_init, smem); continue; }
    it -= N_ATP;
    if (it < N_RWS) { if (SUBMASK & 1) rwkv_item(p, l, NB + it / CH, it % CH, smem); continue; }
    it -= N_RWS;
    if (it < N_HGS) { if (SUBMASK & 2) hgrn_item(p, l, NB + it / BH, it % BH, smem); continue; }
    it -= N_HGS;
    { const int gc = NB * PCH + it / AH; if (SUBMASK & 4) attn_item(p, l, gc, it % AH, lam, lam_init, smem); }
  }
}

constexpr int SMEM_BYTES = 61440;
#ifdef EMU
__device__ void run_phase(const Params& p, int ph, char* smem) {
  const int l = ph / 6, s = ph % 6;
  switch (s) {
#ifndef PHMASK
#define PHMASK 63
#endif
    case 0: if (PHMASK & 1) { if (l == 0) phase_wprep(p, smem); phase_rmsnorm(p, l); } break;
    case 1: if (PHMASK & 2) phase_proj(p, l, smem); break;
    case 2: if (PHMASK & 4) phase_prep(p, l, smem); break;
    case 3: if (PHMASK & 8) phase_mixers(p, l, smem); break;
    case 4: if (PHMASK & 16) phase_merge(p, l, smem); break;
    case 5: if (PHMASK & 32) phase_yout(p, l, smem); break;
  }
}
#endif
#ifndef EMU
__global__ void __launch_bounds__(256, 2) mega(Params p) {
  __shared__ __attribute__((aligned(16))) char smem[SMEM_BYTES];
  cg::grid_group grid = cg::this_grid();
  phase_wprep(p, smem);
#pragma unroll 1
  for (int l = 0; l < DEPTH; l++) {
    phase_rmsnorm(p, l); grid.sync();
    phase_proj(p, l, smem); grid.sync();
    phase_prep(p, l, smem); grid.sync();
    phase_mixers(p, l, smem); grid.sync();
    phase_merge(p, l, smem); grid.sync();
    phase_yout(p, l, smem); grid.sync();
  }
}
extern "C" void kernel_launch(void* const* d_in, const int* in_sizes, int n_in, void* d_out, int out_size, void* d_ws, size_t ws_size, hipStream_t stream) {
  Params p{};
  for (int i = 0; i < 32; i++) p.in[i] = (const float*)d_in[i];
  p.out = (float*)d_out; p.ws = (char*)d_ws;
  if (ws_size < WS_TOTAL) { fprintf(stderr, "workspace too small: %zu < %zu\n", ws_size, (size_t)WS_TOTAL); return; }
  hipMemsetAsync((char*)d_ws + W_CNT, 0, 256, stream);
  static int grid_blocks = 0;
  if (!grid_blocks) {
    int dev = 0, cus = 0, per_cu = 0;
    hipGetDevice(&dev);
    hipDeviceGetAttribute(&cus, hipDeviceAttributeMultiprocessorCount, dev);
    hipOccupancyMaxActiveBlocksPerMultiprocessor(&per_cu, mega, 256, 0);
    if (per_cu > 2) per_cu = 2;
    grid_blocks = cus * per_cu;
  }
  void* args[] = { &p };
  hipError_t e = hipLaunchCooperativeKernel((void*)mega, dim3(grid_blocks), dim3(256), args, 0, stream);
  if (e != hipSuccess) fprintf(stderr, "cooperative launch failed: %s (grid %d)\n", hipGetErrorString(e), grid_blocks);
}
#endif
```

```cpp
#ifdef EMU
#include "emu.h"
#define MFMA32(a, b, c) emu_mfma32(a, b, c)
#else
#include <hip/hip_runtime.h>
#include <hip/hip_cooperative_groups.h>
#include <cstdio>
namespace cg = cooperative_groups;
typedef short bf16x8 __attribute__((ext_vector_type(8)));
typedef float f32x16 __attribute__((ext_vector_type(16)));
#define MFMA32(a, b, c) __builtin_amdgcn_mfma_f32_32x32x16_bf16(a, b, c, 0, 0, 0)
#endif

#ifdef EMU
#define TID() ((int)threadIdx.x)
#define BID() ((int)blockIdx.x)
#else
static __device__ __forceinline__ int TID() { int t = threadIdx.x; asm volatile("" : "+v"(t)); return t; }
static __device__ __forceinline__ int BID() { int t = blockIdx.x; asm volatile("" : "+s"(t)); return t; }
#endif
#define DI __device__ __forceinline__
#ifdef EMU
#define DPP_XOR1(x) emu_lane_perm(x, 0)
#define DPP_XOR2(x) emu_lane_perm(x, 1)
#define DPP_HMIR(x) emu_lane_perm(x, 2)
#define DPP_RMIR(x) emu_lane_perm(x, 3)
#else
#define DPP_F(x, c) __builtin_bit_cast(float, __builtin_amdgcn_update_dpp(0, __builtin_bit_cast(int, (float)(x)), c, 0xF, 0xF, true))
#define DPP_XOR1(x) DPP_F(x, 0xB1)
#define DPP_XOR2(x) DPP_F(x, 0x4E)
#define DPP_HMIR(x) DPP_F(x, 0x141)
#define DPP_RMIR(x) DPP_F(x, 0x140)
#endif
#ifdef EMU
#define EXP2(x) exp2f(x)
#else
#define EXP2(x) __builtin_amdgcn_exp2f(x)
#endif
#ifdef EMU
#define SCHED_BARRIER()
#else
#define SCHED_BARRIER() __builtin_amdgcn_sched_barrier(0)
#endif
typedef unsigned short bf16;

#ifdef SMALL
constexpr int D = 128, NB = 2, T = 256, NSB = 2, TS = 64, PAST = 128, AH = 2, BH = 1, CH = 2;
#else
constexpr int D = 1024, NB = 8, T = 8192, NSB = 16, TS = 64, PAST = 1024, AH = 8, BH = 8, CH = 16;
#endif
constexpr int DEPTH = 2;
constexpr int AQK = AH * 128, AW = AH * 128, BQK = BH * 128, BW = BH * 128, CW = CH * 64;
constexpr int CSH = 3 * CW + 128;
constexpr int O_AQ = 0, O_AK = AQK, O_AV = 2 * AQK, O_AG = O_AV + AW, O_BQ = O_AG + AW, O_BF = O_BQ + BQK, O_BI = O_BF + BQK,
              O_BG = O_BI + BW, O_CP = O_BG + BW, O_CG = O_CP + CSH, O_MA = O_CG + CW, O_MB = O_MA + D, O_MC = O_MB + D, NC = O_MC + D;
constexpr int CP_R = 0, CP_WLO = CW, CP_K = CW + 64, CP_V = 2 * CW + 64, CP_ALO = 3 * CW + 64;
constexpr int MP = NB * T, MS = NSB * TS, M = MP + MS, NSEQ = NB + NSB, KS = PAST + TS;
constexpr int NCHK = M / 64, PCH = T / 64, SCH = TS / 64;
constexpr int MAXPOS = (T > KS ? T : KS);
constexpr float EPS = 1e-6f;

constexpr size_t OO_Y = 0;
constexpr size_t OO_KP = (size_t)M * D;
constexpr size_t OO_VP = OO_KP + (size_t)DEPTH * MP * AQK;
constexpr size_t OO_HP = OO_VP + (size_t)DEPTH * MP * AW;
constexpr size_t OO_RP = OO_HP + (size_t)DEPTH * NB * BH * 16384;
constexpr size_t OO_SP = OO_RP + (size_t)DEPTH * NB * CH * 4096;
constexpr size_t OO_KS = OO_SP + (size_t)DEPTH * NB * CSH;
constexpr size_t OO_VS = OO_KS + (size_t)DEPTH * MS * AQK;
constexpr size_t OO_HS = OO_VS + (size_t)DEPTH * MS * AW;
constexpr size_t OO_RS = OO_HS + (size_t)DEPTH * NSB * BH * 16384;
constexpr size_t OO_SS = OO_RS + (size_t)DEPTH * NSB * CH * 4096;
constexpr size_t OUT_TOTAL = OO_SS + (size_t)DEPTH * NSB * CSH;

constexpr size_t al256(size_t x) { return (x + 255) & ~(size_t)255; }
constexpr size_t W_PROJ = 0;
constexpr size_t W_HN = al256(W_PROJ + (size_t)M * NC * 2);
constexpr size_t W_HGX = al256(W_HN + (size_t)M * D * 2);
constexpr size_t W_DL = al256(W_HGX + (size_t)NCHK * BH * 2 * 8192 * 2);
constexpr size_t W_RWW = al256(W_DL + (size_t)NCHK * BH * 128 * 4);
constexpr size_t W_RWR = al256(W_RWW + (size_t)M * CW * 4);
constexpr size_t W_RWK = al256(W_RWR + (size_t)M * CW * 2);
constexpr size_t W_RWA = al256(W_RWK + (size_t)M * CW * 2);
constexpr size_t W_RWB = al256(W_RWA + (size_t)M * CW * 2);
constexpr size_t W_RWV0 = al256(W_RWB + (size_t)M * CW * 2);
constexpr size_t W_RWV1 = al256(W_RWV0 + (size_t)M * CW * 2);
constexpr size_t W_VTP = al256(W_RWV1 + (size_t)M * CW * 2);
constexpr size_t W_KBS = al256(W_VTP + (size_t)NB * AH * 128 * T * 2);
constexpr size_t W_VTS = al256(W_KBS + (size_t)NSB * AH * KS * 128 * 2);
constexpr size_t W_WT = al256(W_VTS + (size_t)NSB * AH * 128 * KS * 2);
constexpr size_t WT_IN = 0, WT_OA = (size_t)NC * D, WT_OB = WT_OA + (size_t)D * AW, WT_OC = WT_OB + (size_t)D * BW, WT_OO = WT_OC + (size_t)D * CW,
                 WT_LAYER = WT_OO + (size_t)D * D;
constexpr size_t W_ROPE = al256(W_WT + (size_t)DEPTH * WT_LAYER * 2);
constexpr size_t W_CNT = al256(W_ROPE + (size_t)MAXPOS * 16 * 4);
constexpr size_t WS_TOTAL = W_CNT + 256;

struct Params { const float* in[32]; float* out; char* ws; long long percu; };

enum { I_XP, I_XS, I_CK, I_CV, I_SH, I_SR, I_SS, I_NG, I_WIN, I_QNG, I_KNG, I_LAM, I_SUBG, I_BLOW, I_BNG, I_MU, I_W0, I_W2, I_A0, I_A2,
       I_KK, I_KA, I_RK, I_LNW, I_LNB, I_VW1, I_VW2, I_V0, I_WOA, I_WOB, I_WOC, I_WO };

DI bf16 f2bf(float x) { unsigned u = __float_as_uint(x); u += 0x7fffu + ((u >> 16) & 1u); return (bf16)(u >> 16); }
DI float bf2f(bf16 s) { return __uint_as_float(((unsigned)s) << 16); }
DI float sigm(float x) { return 1.0f / (1.0f + __expf(-x)); }
DI float siluf(float x) { return x / (1.0f + __expf(-x)); }
union V8 { bf16x8 v; uint4 u; uint2 h[2]; bf16 s[8]; };
union V4 { uint2 u; bf16 s[4]; };
DI void ld8(const bf16* p, float* o) { V8 t; t.u = *(const uint4*)p;
#pragma unroll
  for (int i = 0; i < 8; i++) o[i] = bf2f(t.s[i]); }
DI void ld4(const bf16* p, float* o) { V4 t; t.u = *(const uint2*)p;
#pragma unroll
  for (int i = 0; i < 4; i++) o[i] = bf2f(t.s[i]); }
DI bf16x8 ldfrag16(const bf16* p) { V8 t; t.u = *(const uint4*)p; return t.v; }
DI bf16x8 ldfrag8x2(const bf16* p0, const bf16* p1) { V8 t; t.h[0] = *(const uint2*)p0; t.h[1] = *(const uint2*)p1; return t.v; }
DI bf16x8 pack8(const f32x16& x, int s) { V8 t;
#pragma unroll
  for (int j = 0; j < 8; j++) t.s[j] = f2bf(x[8 * s + j]); return t.v; }
DI f32x16 zero16() { f32x16 z;
#pragma unroll
  for (int i = 0; i < 16; i++) z[i] = 0.f; return z; }
DI float red4(float x) { x += DPP_XOR1(x); x += DPP_XOR2(x); return x; }
DI float red8(float x) { x = red4(x); x += DPP_HMIR(x); return x; }
DI float red16(float x) { x = red8(x); x += DPP_RMIR(x); return x; }
DI int crow(int reg, int h) { return (reg & 3) + 8 * (reg >> 2) + 4 * h; }

struct ChunkInfo { int seq, lc, tok0, pos0; };
DI ChunkInfo chunk_info(int gc) { ChunkInfo c; c.tok0 = gc * 64;
  if (gc < NB * PCH) { c.seq = gc / PCH; c.lc = gc % PCH; c.pos0 = c.lc * 64; }
  else { int r = gc - NB * PCH; c.seq = NB + r / SCH; c.lc = r % SCH; c.pos0 = PAST + c.lc * 64; }
  return c; }
DI int seq_tok0(int seq) { return seq < NB ? seq * T : MP + (seq - NB) * TS; }
DI int seq_len(int seq) { return seq < NB ? T : TS; }

__device__ void transpose_w(const float* src, bf16* dst, int K, int N, float* tile  ) {
  const int tid = TID(); const int nkt = K / 64, nnt = N / 64;
  for (int t = BID(); t < nkt * nnt; t += gridDim.x) {
    const int k0 = (t / nnt) * 64, n0 = (t % nnt) * 64;
    for (int i = 0; i < 16; i++) { int r = i * 4 + tid / 64, c = tid % 64; tile[r * 65 + c] = src[(size_t)(k0 + r) * N + n0 + c]; }
    __syncthreads();
    for (int i = 0; i < 16; i++) { int n = i * 4 + tid / 64, k = tid % 64; dst[(size_t)(n0 + n) * K + k0 + k] = f2bf(tile[k * 65 + n]); }
    __syncthreads();
  }
}
__device__ void phase_wprep(const Params& p, char* smem) {
  float* tile = (float*)smem;
  for (int l = 0; l < DEPTH; l++) {
    bf16* wt = (bf16*)(p.ws + W_WT) + (size_t)l * WT_LAYER;
    transpose_w(p.in[I_WIN] + (size_t)l * D * NC, wt + WT_IN, D, NC, tile);
    transpose_w(p.in[I_WOA] + (size_t)l * AW * D, wt + WT_OA, AW, D, tile);
    transpose_w(p.in[I_WOB] + (size_t)l * BW * D, wt + WT_OB, BW, D, tile);
    transpose_w(p.in[I_WOC] + (size_t)l * CW * D, wt + WT_OC, CW, D, tile);
    transpose_w(p.in[I_WO] + (size_t)l * D * D, wt + WT_OO, D, D, tile);
  }
  float* rope = (float*)(p.ws + W_ROPE);
  for (int i = BID() * blockDim.x + TID(); i < MAXPOS * 8; i += gridDim.x * blockDim.x) {
    int pos = i / 8, j = i % 8;
    double inv = pow(500000.0, -(double)j / 8.0);
    double ang = (double)pos * inv;
    rope[pos * 16 + j] = (float)cos(ang); rope[pos * 16 + 8 + j] = (float)sin(ang);
  }
}

DI const float* x_row(const Params& p, int l, int m) {
  if (l == 0) return m < MP ? p.in[I_XP] + (size_t)m * D : p.in[I_XS] + (size_t)(m - MP) * D;
  return p.out + OO_Y + (size_t)m * D;
}
__device__ void phase_rmsnorm(const Params& p, int l) {
  const int lane = TID() % 64, w = TID() / 64;
  bf16* hn = (bf16*)(p.ws + W_HN);
  const float* g = p.in[I_NG] + (size_t)l * D;
  for (int m = BID() * 4 + w; m < M; m += gridDim.x * 4) {
    const float* x = x_row(p, l, m);
    float ss = 0.f;
    for (int c = lane * 4; c < D; c += 256) { float4 v = *(const float4*)(x + c); ss += v.x * v.x + v.y * v.y + v.z * v.z + v.w * v.w; }
    for (int o = 32; o >= 1; o >>= 1) ss += __shfl_xor(ss, o);
    const float rs = rsqrtf(ss / D + EPS);
    for (int c = lane * 4; c < D; c += 256) { float4 v = *(const float4*)(x + c); float4 gg = *(const float4*)(g + c);
      V4 o; o.s[0] = f2bf(v.x * rs * gg.x); o.s[1] = f2bf(v.y * rs * gg.y); o.s[2] = f2bf(v.z * rs * gg.z); o.s[3] = f2bf(v.w * rs * gg.w);
      *(uint2*)(hn + (size_t)m * D + c) = o.u; }
  }
}

constexpr int GLD = 72;
constexpr int GSTAGE = 2 * 128 * GLD;
template <int NJ> DI void gemm_mainloop(const bf16* A, size_t lda, const bf16* Bt, size_t ldb, int K, int m0, int n0, bf16* lds, f32x16 acc[2][NJ]) {
  const int tid = TID(), lane = tid % 64, w = tid / 64, wm = w / 2, wn = w % 2, lr = lane % 32, lh = lane / 32;
  const int nk = K / 64;
  uint4 ra[4], rb[2 * NJ];
  const int r0 = tid / 8, kc = (tid % 8) * 8;
  const bf16* Ap = A + (size_t)(m0 + r0) * lda + kc;
  const bf16* Bp = Bt + (size_t)(n0 + r0) * ldb + kc;
#pragma unroll
  for (int i = 0; i < 4; i++) ra[i] = *(const uint4*)(Ap + (size_t)(32 * i) * lda);
#pragma unroll
  for (int i = 0; i < 2 * NJ; i++) rb[i] = *(const uint4*)(Bp + (size_t)(32 * i) * ldb);
#pragma unroll
  for (int i = 0; i < 4; i++) *(uint4*)(lds + (r0 + 32 * i) * GLD + kc) = ra[i];
#pragma unroll
  for (int i = 0; i < 2 * NJ; i++) *(uint4*)(lds + 128 * GLD + (r0 + 32 * i) * GLD + kc) = rb[i];
  __syncthreads();
  for (int kt = 0; kt < nk; kt++) {
    const int cur = kt & 1;
    const bf16* sAc = lds + cur * GSTAGE; const bf16* sBc = sAc + 128 * GLD;
    bf16* sAn = lds + (cur ^ 1) * GSTAGE; bf16* sBn = sAn + 128 * GLD;
    if (kt + 1 < nk) {
#pragma unroll
      for (int i = 0; i < 4; i++) ra[i] = *(const uint4*)(Ap + (size_t)(32 * i) * lda + (kt + 1) * 64);
#pragma unroll
      for (int i = 0; i < 2 * NJ; i++) rb[i] = *(const uint4*)(Bp + (size_t)(32 * i) * ldb + (kt + 1) * 64);
    }
#pragma unroll
    for (int ks = 0; ks < 4; ks++) {
      bf16x8 fa[2], fb[NJ];
#pragma unroll
      for (int i = 0; i < 2; i++) { fa[i] = ldfrag16(sAc + (wm * 64 + i * 32 + lr) * GLD + ks * 16 + lh * 8);
                                    if (i < NJ) fb[i] = ldfrag16(sBc + (wn * 32 * NJ + i * 32 + lr) * GLD + ks * 16 + lh * 8); }
#pragma unroll
      for (int i = 0; i < 2; i++)
#pragma unroll
        for (int j = 0; j < NJ; j++) acc[i][j] = MFMA32(fa[i], fb[j], acc[i][j]);
    }
    if (kt + 1 < nk) {
#pragma unroll
      for (int i = 0; i < 4; i++) *(uint4*)(sAn + (r0 + 32 * i) * GLD + kc) = ra[i];
#pragma unroll
      for (int i = 0; i < 2 * NJ; i++) *(uint4*)(sBn + (r0 + 32 * i) * GLD + kc) = rb[i];
    }
    __syncthreads();
  }
}

__device__ void phase_proj(const Params& p, int l, char* smem) {
  const bf16* hn = (const bf16*)(p.ws + W_HN);
  const bf16* wt = (const bf16*)(p.ws + W_WT) + (size_t)l * WT_LAYER + WT_IN;
  bf16* proj = (bf16*)(p.ws + W_PROJ);
  const int lane = TID() % 64, w = TID() / 64, wm = w / 2, wn = w % 2, lr = lane % 32, lh = lane / 32;
  constexpr int NT = NC / 128, MT = M / 128;
  constexpr int MG = 4, NGRP = (MT + MG - 1) / MG;
  const int bid = BID(), xcd = bid % 8, lb = bid / 8, nlb = ((int)gridDim.x + 7 - xcd) / 8;
  const int ngx = (NGRP - xcd + 7) / 8;
  for (int it = lb; it < ngx * NT * MG; it += nlb) {
    const int g = xcd + 8 * (it / (NT * MG)), r = it % (NT * MG);
    const int mt = g * MG + r % MG, nt = r / MG;
    if (mt >= MT) continue;
    const int m0 = mt * 128, n0 = nt * 128;
    f32x16 acc[2][2];
#pragma unroll
    for (int i = 0; i < 2; i++)
#pragma unroll
      for (int j = 0; j < 2; j++) acc[i][j] = zero16();
    gemm_mainloop<2>(hn, D, wt, D, D, m0, n0, (bf16*)smem, acc);
#pragma unroll
    for (int i = 0; i < 2; i++)
#pragma unroll
      for (int j = 0; j < 2; j++)
#pragma unroll
        for (int r = 0; r < 16; r++) {
          const int row = m0 + wm * 64 + i * 32 + crow(r, lh), col = n0 + wn * 64 + j * 32 + lr;
          proj[(size_t)row * NC + col] = f2bf(acc[i][j][r]);
        }
  }
}

__device__ void phase_merge(const Params& p, int l, char* smem) {
  const bf16* proj = (const bf16*)(p.ws + W_PROJ);
  const bf16* wt = (const bf16*)(p.ws + W_WT) + (size_t)l * WT_LAYER;
  bf16* mrg = (bf16*)(p.ws + W_HN);
  const int lane = TID() % 64, w = TID() / 64, wm = w / 2, wn = w % 2, lr = lane % 32, lh = lane / 32;
  constexpr int NT = D / 64, MT = M / 128;
  for (int t = BID(); t < MT * NT; t += gridDim.x) {
    const int m0 = (t / NT) * 128, n0 = (t % NT) * 64;
    f32x16 tot[2];
    tot[0] = zero16(); tot[1] = zero16();
#pragma unroll 1
    for (int mx = 0; mx < 3; mx++) {
      f32x16 acc[2][1];
      acc[0][0] = zero16(); acc[1][0] = zero16();
      const int acol = mx == 0 ? O_AQ : (mx == 1 ? O_BQ : O_CP);
      const int Kx = mx == 0 ? AW : (mx == 1 ? BW : CW);
      const size_t woff = mx == 0 ? WT_OA : (mx == 1 ? WT_OB : WT_OC);
      const int gcol = O_MA + mx * D;
      gemm_mainloop<1>(proj + acol, NC, wt + woff, Kx, Kx, m0, n0, (bf16*)smem, acc);
#pragma unroll
      for (int i = 0; i < 2; i++)
#pragma unroll
        for (int r = 0; r < 16; r++) {
          const int row = m0 + wm * 64 + i * 32 + crow(r, lh), col = n0 + wn * 32 + lr;
          tot[i][r] += sigm(bf2f(proj[(size_t)row * NC + gcol + col])) * acc[i][0][r];
        }
    }
#pragma unroll
    for (int i = 0; i < 2; i++)
#pragma unroll
      for (int r = 0; r < 16; r++) {
        const int row = m0 + wm * 64 + i * 32 + crow(r, lh), col = n0 + wn * 32 + lr;
        mrg[(size_t)row * D + col] = f2bf(tot[i][r]);
      }
  }
}

__device__ void phase_yout(const Params& p, int l, char* smem) {
  const bf16* mrg = (const bf16*)(p.ws + W_HN);
  const bf16* wt = (const bf16*)(p.ws + W_WT) + (size_t)l * WT_LAYER + WT_OO;
  const int lane = TID() % 64, w = TID() / 64, wm = w / 2, wn = w % 2, lr = lane % 32, lh = lane / 32;
  constexpr int NT = D / 128, MT = M / 128;
  for (int t = BID(); t < MT * NT; t += gridDim.x) {
    const int m0 = (t / NT) * 128, n0 = (t % NT) * 128;
    f32x16 acc[2][2];
#pragma unroll
    for (int i = 0; i < 2; i++)
#pragma unroll
      for (int j = 0; j < 2; j++) acc[i][j] = zero16();
    gemm_mainloop<2>(mrg, D, wt, D, D, m0, n0, (bf16*)smem, acc);
#pragma unroll
    for (int i = 0; i < 2; i++)
#pragma unroll
      for (int j = 0; j < 2; j++)
#pragma unroll
        for (int r = 0; r < 16; r++) {
          const int row = m0 + wm * 64 + i * 32 + crow(r, lh), col = n0 + wn * 64 + j * 32 + lr;
          const float xv = x_row(p, l, row)[col];
          p.out[OO_Y + (size_t)row * D + col] = xv + acc[i][j][r];
        }
  }
}

__device__ void prep_attn_chunk(const Params& p, int l, int gc, char* smem) {
  const int tid = TID();
  const ChunkInfo ci = chunk_info(gc);
  bf16* proj = (bf16*)(p.ws + W_PROJ);
  const float* rope = (const float*)(p.ws + W_ROPE);
  const float* qg = p.in[I_QNG] + l * 64; const float* kg = p.in[I_KNG] + l * 64;
  const bool samp = ci.seq >= NB; const int sb = ci.seq - NB;
  const int sub = tid % 8;
  constexpr int NVEC = 64 * 2 * AH * 2;
  for (int v0 = 0; v0 < NVEC; v0 += 128) {
    float xx[4][8];
#pragma unroll
    for (int u = 0; u < 4; u++) {
      const int vi = v0 + u * 32 + tid / 8;
      const int t = vi / (4 * AH), rem = vi % (4 * AH), isk = rem / (2 * AH), hn2 = rem % (2 * AH);
      ld8(proj + (size_t)(ci.tok0 + t) * NC + (isk ? O_AK : O_AQ) + hn2 * 64 + sub * 8, xx[u]);
    }
#pragma unroll
    for (int u = 0; u < 4; u++) {
      const int vi = v0 + u * 32 + tid / 8;
      const int t = vi / (4 * AH), rem = vi % (4 * AH), isk = rem / (2 * AH), hn2 = rem % (2 * AH);
      const int tok = ci.tok0 + t, pos = ci.pos0 + t;
      bf16* src = proj + (size_t)tok * NC + (isk ? O_AK : O_AQ) + hn2 * 64 + sub * 8;
      float* x = xx[u];
      float ss = 0.f;
#pragma unroll
      for (int i = 0; i < 8; i++) ss += x[i] * x[i];
      ss = red8(ss);
      const float rs = rsqrtf(ss / 64.f + EPS);
      const float* g = isk ? kg : qg;
#pragma unroll
      for (int i = 0; i < 8; i++) x[i] = x[i] * rs * g[sub * 8 + i];
      float y[8];
#pragma unroll
      for (int i = 0; i < 8; i++) y[i] = DPP_XOR1(x[i]);
      if (sub < 2) {
#pragma unroll
        for (int i = 0; i < 8; i++) { const float c = rope[pos * 16 + i], sn = rope[pos * 16 + 8 + i];
          x[i] = (sub == 0) ? (x[i] * c - y[i] * sn) : (x[i] * c + y[i] * sn); }
      }
      if (isk) {
        float* ko = p.out + (samp ? OO_KS + ((size_t)l * MS + (tok - MP)) * AQK : OO_KP + ((size_t)l * MP + tok) * AQK) + hn2 * 64 + sub * 8;
        *(float4*)ko = make_float4(x[0], x[1], x[2], x[3]); *(float4*)(ko + 4) = make_float4(x[4], x[5], x[6], x[7]);
        V8 o;
#pragma unroll
        for (int i = 0; i < 8; i++) o.s[i] = f2bf(x[i]);
        if (samp) { bf16* kb = (bf16*)(p.ws + W_KBS) + ((size_t)(sb * AH + hn2 / 2) * KS + PAST + ci.lc * 64 + t) * 128 + (hn2 % 2) * 64 + sub * 8; *(uint4*)kb = o.u; }
        else *(uint4*)src = o.u;
      } else {
        V8 o;
#pragma unroll
        for (int i = 0; i < 8; i++) o.s[i] = f2bf(x[i] * (0.125f * 1.44269504088896f));
        *(uint4*)src = o.u;
      }
    }
  }
  bf16* tile = (bf16*)smem;
  for (int h = 0; h < AH; h++) {
    __syncthreads();
    for (int i = 0; i < 4; i++) { const int c = tid + i * 256, t = c / 16, d8 = (c % 16) * 8; const int tok = ci.tok0 + t;
      const bf16* src = proj + (size_t)tok * NC + O_AV + h * 128 + d8;
      V8 u; u.u = *(const uint4*)src;
      *(uint4*)(tile + t * 136 + d8) = u.u;
      float* vo = p.out + (samp ? OO_VS + ((size_t)l * MS + (tok - MP)) * AW : OO_VP + ((size_t)l * MP + tok) * AW) + h * 128 + d8;
      *(float4*)vo = make_float4(bf2f(u.s[0]), bf2f(u.s[1]), bf2f(u.s[2]), bf2f(u.s[3]));
      *(float4*)(vo + 4) = make_float4(bf2f(u.s[4]), bf2f(u.s[5]), bf2f(u.s[6]), bf2f(u.s[7])); }
    __syncthreads();
    { const int dv = tid / 2, th = tid % 2;
      bf16* dst = samp ? (bf16*)(p.ws + W_VTS) + ((size_t)(sb * AH + h) * 128 + dv) * KS + PAST + ci.lc * 64 + th * 32
                       : (bf16*)(p.ws + W_VTP) + ((size_t)(ci.seq * AH + h) * 128 + dv) * T + ci.lc * 64 + th * 32;
#pragma unroll
      for (int q = 0; q < 4; q++) { V8 o;
#pragma unroll
        for (int i = 0; i < 8; i++) o.s[i] = tile[(th * 32 + q * 8 + i) * 136 + dv];
        *(uint4*)(dst + q * 8) = o.u; } }
  }
  __syncthreads();
}
__device__ void prep_past_tile(const Params& p, int l, int item, char* smem) {
  const int tid = TID();
  constexpr int NKT = PAST / 64;
  const int kt = item % NKT, h = (item / NKT) % AH, sb = item / (NKT * AH);
  const float* ck = p.in[I_CK] + (((size_t)l * NSB + sb) * PAST + kt * 64) * AQK + h * 128;
  const float* cv = p.in[I_CV] + (((size_t)l * NSB + sb) * PAST + kt * 64) * AW + h * 128;
  bf16* kb = (bf16*)(p.ws + W_KBS) + ((size_t)(sb * AH + h) * KS + kt * 64) * 128;
  bf16* tile = (bf16*)smem;
  __syncthreads();
  for (int i = 0; i < 4; i++) { const int c = tid + i * 256, t = c / 16, d8 = (c % 16) * 8;
    float4 a = *(const float4*)(ck + (size_t)t * AQK + d8), b = *(const float4*)(ck + (size_t)t * AQK + d8 + 4);
    V8 o; o.s[0] = f2bf(a.x); o.s[1] = f2bf(a.y); o.s[2] = f2bf(a.z); o.s[3] = f2bf(a.w); o.s[4] = f2bf(b.x); o.s[5] = f2bf(b.y); o.s[6] = f2bf(b.z); o.s[7] = f2bf(b.w);
    *(uint4*)(kb + (size_t)t * 128 + d8) = o.u;
    a = *(const float4*)(cv + (size_t)t * AW + d8); b = *(const float4*)(cv + (size_t)t * AW + d8 + 4);
    o.s[0] = f2bf(a.x); o.s[1] = f2bf(a.y); o.s[2] = f2bf(a.z); o.s[3] = f2bf(a.w); o.s[4] = f2bf(b.x); o.s[5] = f2bf(b.y); o.s[6] = f2bf(b.z); o.s[7] = f2bf(b.w);
    *(uint4*)(tile + t * 136 + d8) = o.u; }
  __syncthreads();
  { const int dv = tid / 2, th = tid % 2;
    bf16* dst = (bf16*)(p.ws + W_VTS) + ((size_t)(sb * AH + h) * 128 + dv) * KS + kt * 64 + th * 32;
#pragma unroll
    for (int q = 0; q < 4; q++) { V8 o;
#pragma unroll
      for (int i = 0; i < 8; i++) o.s[i] = tile[(th * 32 + q * 8 + i) * 136 + dv];
      *(uint4*)(dst + q * 8) = o.u; } }
  __syncthreads();
}
__device__ void prep_hgrn(const Params& p, int l, int item, char* smem) {
  const int tid = TID(), k = tid % 128, th = tid / 128;
  const int gc = item / BH, h = item % BH;
  const ChunkInfo ci = chunk_info(gc);
  bf16* proj = (bf16*)(p.ws + W_PROJ);
  float* tot = (float*)smem;
  float lb = 0.f;
  if (l == 1) { const float b0 = p.in[I_BLOW][h * 128 + k], b1 = p.in[I_BLOW][BQK + h * 128 + k]; lb = 1.f / (1.f + __expf(b0 - b1)); }
  float zs[32], cs[32];
  bf16* base = proj + (size_t)(ci.tok0 + th * 32) * NC + h * 128 + k;
  float run = 0.f;
#pragma unroll
  for (int i = 0; i < 32; i++) { const float z = bf2f(base[(size_t)i * NC + O_BF]); zs[i] = z; const float f = lb + (1.f - lb) * sigm(z); run += __logf(f); cs[i] = run; }
  __syncthreads();
  tot[th * 128 + k] = run;
  __syncthreads();
  const float t0 = tot[k], t1 = tot[128 + k];
  const float ref = t0, last = t0 + t1, off = th ? t0 : 0.f;
  V8 kt8[4], it8[4];
#pragma unroll
  for (int i = 0; i < 32; i++) {
    const float cum = cs[i] + off, z = zs[i];
    const float kin = (1.f - lb) * sigm(-z);
    const float qv = siluf(bf2f(base[(size_t)i * NC + O_BQ]));
    const bf16 iv = base[(size_t)i * NC + O_BI];
    base[(size_t)i * NC + O_BQ] = f2bf(qv * __expf(fminf(cum - ref, 80.f)));
    base[(size_t)i * NC + O_BF] = f2bf(kin * __expf(fminf(ref - cum, 80.f)));
    base[(size_t)i * NC + O_BI] = f2bf(qv * __expf(cum));
    kt8[i / 8].s[i % 8] = f2bf(kin * __expf(last - cum));
    it8[i / 8].s[i % 8] = iv;
  }
  bf16* hgx = (bf16*)(p.ws + W_HGX) + (size_t)item * 2 * 8192;
#pragma unroll
  for (int q = 0; q < 4; q++) { *(uint4*)(hgx + k * 64 + th * 32 + q * 8) = kt8[q].u; *(uint4*)(hgx + 8192 + k * 64 + th * 32 + q * 8) = it8[q].u; }
  if (th == 0) ((float*)(p.ws + W_DL))[(size_t)item * 128 + k] = __expf(last);
  __syncthreads();
}
__device__ void prep_rwkv(const Params& p, int l, int ti, char* smem) {
  const int tid = TID();
  const int tok0 = ti * 32;
  const ChunkInfo ci = chunk_info(tok0 / 64);
  const int seqt0 = seq_tok0(ci.seq);
  const bf16* proj = (const bf16*)(p.ws + W_PROJ);
  const bf16* hn = (const bf16*)(p.ws + W_HN);
  const float* mu = p.in[I_MU] + (size_t)l * CSH;
  const float* shp = (ci.seq >= NB) ? p.in[I_SS] + ((size_t)l * NSB + (ci.seq - NB)) * CSH : nullptr;
  float* tw = (float*)smem;
  float* al = tw + 32 * 64;
  float* hv = al + 32 * 64;
  auto cs = [&](int t, int col) -> float {
    const int tok = tok0 + t;
    const float cur = bf2f(proj[(size_t)tok * NC + O_CP + col]);
    float prev;
    if (tok == seqt0) prev = shp ? shp[col] : 0.f; else prev = bf2f(proj[(size_t)(tok - 1) * NC + O_CP + col]);
    return cur + (prev - cur) * mu[col];
  };
  __syncthreads();
#pragma unroll
  for (int i = 0; i < 8; i++) { const int e = tid + i * 256, t = e / 64, j = e % 64;
    tw[e] = tanhf(cs(t, CP_WLO + j)); al[e] = cs(t, CP_ALO + j); }
  if (l > 0) {
    const int t = tid / 8, jg = (tid % 8) * 4;
    const float* w1 = p.in[I_VW1] + (size_t)(l - 1) * D * 32;
    float a0 = 0, a1 = 0, a2 = 0, a3 = 0;
    const bf16* hr = hn + (size_t)(tok0 + t) * D;
#pragma unroll 8
    for (int d = 0; d < D; d++) { const float hvv = bf2f(hr[d]); const float4 wv = *(const float4*)(w1 + (size_t)d * 32 + jg);
      a0 += hvv * wv.x; a1 += hvv * wv.y; a2 += hvv * wv.z; a3 += hvv * wv.w; }
    hv[t * 32 + jg] = a0; hv[t * 32 + jg + 1] = a1; hv[t * 32 + jg + 2] = a2; hv[t * 32 + jg + 3] = a3;
  }
  __syncthreads();
  const bool act = tid * 4 < CW;
  const int c4 = act ? tid * 4 : 0;
  const float* w2 = p.in[I_W2] + (size_t)l * 64 * CW + c4; const float* a2p = p.in[I_A2] + (size_t)l * 64 * CW + c4;
  const float* vw2 = p.in[I_VW2] + (size_t)(l > 0 ? l - 1 : 0) * 32 * CW + c4;
  float* rww = (float*)(p.ws + W_RWW);
  bf16* rwr = (bf16*)(p.ws + W_RWR); bf16* rwk = (bf16*)(p.ws + W_RWK); bf16* rwa = (bf16*)(p.ws + W_RWA); bf16* rwb = (bf16*)(p.ws + W_RWB);
  bf16* rwv = (bf16*)(p.ws + (l == 0 ? W_RWV0 : W_RWV1)); const bf16* vfirst = (const bf16*)(p.ws + W_RWV0);
  const float4 w0v = *(const float4*)(p.in[I_W0] + (size_t)l * CW + c4), a0v = *(const float4*)(p.in[I_A0] + (size_t)l * CW + c4);
  const float4 kkv = *(const float4*)(p.in[I_KK] + (size_t)l * CW + c4), kav = *(const float4*)(p.in[I_KA] + (size_t)l * CW + c4);
  float4 v0v = make_float4(0.f, 0.f, 0.f, 0.f);
  if (l > 0) v0v = *(const float4*)(p.in[I_V0] + (size_t)(l - 1) * CW + c4);
  const float w0a[4] = {w0v.x, w0v.y, w0v.z, w0v.w}, a0a[4] = {a0v.x, a0v.y, a0v.z, a0v.w}, kka[4] = {kkv.x, kkv.y, kkv.z, kkv.w},
              kaa[4] = {kav.x, kav.y, kav.z, kav.w}, v0a[4] = {v0v.x, v0v.y, v0v.z, v0v.w};
  float mur[4], muk[4], muv[4];
#pragma unroll
  for (int c = 0; c < 4; c++) { mur[c] = mu[CP_R + c4 + c]; muk[c] = mu[CP_K + c4 + c]; muv[c] = mu[CP_V + c4 + c]; }
#pragma unroll 1
  for (int tg = 0; tg < 8; tg++) {
    float aw[4][4], aa[4][4], vm[4][4];
#pragma unroll
    for (int t = 0; t < 4; t++)
#pragma unroll
      for (int c = 0; c < 4; c++) { aw[t][c] = 0.f; aa[t][c] = 0.f; vm[t][c] = 0.f; }
#pragma unroll 4
    for (int j = 0; j < 64; j++) {
      const float4 wv = *(const float4*)(w2 + (size_t)j * CW), av = *(const float4*)(a2p + (size_t)j * CW);
#pragma unroll
      for (int t = 0; t < 4; t++) { const float x = tw[(tg * 4 + t) * 64 + j], y = al[(tg * 4 + t) * 64 + j];
        aw[t][0] += x * wv.x; aw[t][1] += x * wv.y; aw[t][2] += x * wv.z; aw[t][3] += x * wv.w;
        aa[t][0] += y * av.x; aa[t][1] += y * av.y; aa[t][2] += y * av.z; aa[t][3] += y * av.w; }
    }
    if (l > 0) {
#pragma unroll 4
      for (int j = 0; j < 32; j++) { const float4 wv = *(const float4*)(vw2 + (size_t)j * CW);
#pragma unroll
        for (int t = 0; t < 4; t++) { const float hj = hv[(tg * 4 + t) * 32 + j];
          vm[t][0] += hj * wv.x; vm[t][1] += hj * wv.y; vm[t][2] += hj * wv.z; vm[t][3] += hj * wv.w; } }
    }
    float cr[4][4], ck[4][4], cv[4][4], pr[4][4], pk[4][4], pv[4][4], vf[4][4];
#pragma unroll
    for (int t = 0; t < 4; t++) {
      const int tok = tok0 + tg * 4 + t;
      const bf16* cp = proj + (size_t)tok * NC + O_CP + c4;
      ld4(cp + CP_R, cr[t]); ld4(cp + CP_K, ck[t]); ld4(cp + CP_V, cv[t]);
      if (tok == seqt0) {
#pragma unroll
        for (int c = 0; c < 4; c++) { pr[t][c] = shp ? shp[CP_R + c4 + c] : 0.f; pk[t][c] = shp ? shp[CP_K + c4 + c] : 0.f; pv[t][c] = shp ? shp[CP_V + c4 + c] : 0.f; }
      } else { ld4(cp - NC + CP_R, pr[t]); ld4(cp - NC + CP_K, pk[t]); ld4(cp - NC + CP_V, pv[t]); }
      if (l > 0) ld4(vfirst + (size_t)tok * CW + c4, vf[t]);
    }
#pragma unroll
    for (int t = 0; t < 4; t++) {
      const int tok = tok0 + tg * 4 + t;
      float rr[4], kk[4], vv[4], ww[4], a[4], kt[4], bb[4];
      float ss = 0.f;
#pragma unroll
      for (int c = 0; c < 4; c++) {
        rr[c] = cr[t][c] + (pr[t][c] - cr[t][c]) * mur[c];
        const float kx = ck[t][c] + (pk[t][c] - ck[t][c]) * muk[c];
        float vx = cv[t][c] + (pv[t][c] - cv[t][c]) * muv[c];
        const float u = w0a[c] + aw[t][c];
        const float sp = fmaxf(-u, 0.f) + log1pf(__expf(-fabsf(u)));
        ww[c] = __expf(-__expf(-sp - 0.5f));
        a[c] = sigm(a0a[c] + aa[t][c]);
        if (l > 0) vx = vx + (vf[t][c] - vx) * sigm(v0a[c] + vm[t][c]);
        vv[c] = vx;
        kk[c] = kx * kka[c];
        ss += kk[c] * kk[c];
        kt[c] = kx * (1.f + (a[c] - 1.f) * kaa[c]);
      }
      ss = red16(ss);
      const float inv = 1.f / fmaxf(sqrtf(ss), 1e-12f);
#pragma unroll
      for (int c = 0; c < 4; c++) { kk[c] *= inv; bb[c] = kk[c] * a[c]; kk[c] = -kk[c]; }
      if (act) {
        *(float4*)(rww + (size_t)tok * CW + c4) = make_float4(ww[0], ww[1], ww[2], ww[3]);
        V4 o;
#pragma unroll
        for (int c = 0; c < 4; c++) o.s[c] = f2bf(rr[c]);
        *(uint2*)(rwr + (size_t)tok * CW + c4) = o.u;
#pragma unroll
        for (int c = 0; c < 4; c++) o.s[c] = f2bf(kt[c]);
        *(uint2*)(rwk + (size_t)tok * CW + c4) = o.u;
#pragma unroll
        for (int c = 0; c < 4; c++) o.s[c] = f2bf(vv[c]);
        *(uint2*)(rwv + (size_t)tok * CW + c4) = o.u;
#pragma unroll
        for (int c = 0; c < 4; c++) o.s[c] = f2bf(kk[c]);
        *(uint2*)(rwa + (size_t)tok * CW + c4) = o.u;
#pragma unroll
        for (int c = 0; c < 4; c++) o.s[c] = f2bf(bb[c]);
        *(uint2*)(rwb + (size_t)tok * CW + c4) = o.u;
      }
    }
  }
  __syncthreads();
}
__device__ void phase_prep(const Params& p, int l, char* smem) {
#ifndef SUBMASK
#define SUBMASK 15
#endif
  if (SUBMASK & 1) for (int gc = BID(); gc < NCHK; gc += gridDim.x) prep_attn_chunk(p, l, gc, smem);
  if (SUBMASK & 2) for (int it = BID(); it < NSB * AH * (PAST / 64); it += gridDim.x) prep_past_tile(p, l, it, smem);
  if (SUBMASK & 4) for (int it = BID(); it < NCHK * BH; it += gridDim.x) prep_hgrn(p, l, it, smem);
  if (SUBMASK & 8) for (int ti = BID(); ti < M / 32; ti += gridDim.x) prep_rwkv(p, l, ti, smem);
  const bf16* proj = (const bf16*)(p.ws + W_PROJ);
  for (int i = BID() * blockDim.x + TID(); i < NSEQ * CSH; i += gridDim.x * blockDim.x) {
    const int seq = i / CSH, c = i % CSH; const int tok = seq_tok0(seq) + seq_len(seq) - 1;
    const float v = bf2f(proj[(size_t)tok * NC + O_CP + c]);
    if (seq < NB) p.out[OO_SP + ((size_t)l * NB + seq) * CSH + c] = v; else p.out[OO_SS + ((size_t)l * NSB + (seq - NB)) * CSH + c] = v;
  }
}

constexpr int KLD = 136, VLD = 72;
__device__ void attn_item(const Params& p, int l, int gc, int h, float lam, float lam_init, char* smem) {
  const int tid = TID(), lane = tid % 64, w = tid / 64, rh = w / 2, n = w % 2, lr = lane % 32, lh = lane / 32;
  const ChunkInfo ci = chunk_info(gc);
  bf16* proj = (bf16*)(p.ws + W_PROJ);
  const bool samp = ci.seq >= NB; const int sb = ci.seq - NB;
  const bf16* Kg; size_t ldk; const bf16* Vg; size_t ldv; int ntiles;
  if (!samp) { Kg = proj + (size_t)(ci.seq * T) * NC + O_AK + h * 128; ldk = NC; Vg = (const bf16*)(p.ws + W_VTP) + (size_t)(ci.seq * AH + h) * 128 * T; ldv = T; ntiles = ci.lc + 1; }
  else { Kg = (const bf16*)(p.ws + W_KBS) + (size_t)(sb * AH + h) * KS * 128; ldk = 128; Vg = (const bf16*)(p.ws + W_VTS) + (size_t)(sb * AH + h) * 128 * KS; ldv = KS; ntiles = PAST / 64 + ci.lc + 1; }
  constexpr int ASTAGE = 64 * KLD + 128 * VLD;
  bf16* sbase = (bf16*)smem;
  bf16x8 qf[4];
  { const bf16* qp = proj + (size_t)(ci.tok0 + rh * 32 + lr) * NC + O_AQ + h * 128 + n * 64 + lh * 8;
#pragma unroll
    for (int ks = 0; ks < 4; ks++) qf[ks] = ldfrag16(qp + ks * 16); }
  f32x16 o[4];
#pragma unroll
  for (int i = 0; i < 4; i++) o[i] = zero16();
  float mrun = -1e30f, lrun = 0.f;
  const int kr0 = tid / 16, kc8 = (tid % 16) * 8, vr0 = tid / 8, vc8 = (tid % 8) * 8;
  const bf16* Kp = Kg + (size_t)kr0 * ldk + kc8;
  const bf16* Vp = Vg + (size_t)vr0 * ldv + vc8;
  typedef unsigned int u32x4 __attribute__((ext_vector_type(4)));
  u32x4 rk0, rk1, rk2, rk3, rv0, rv1, rv2, rv3;
  __syncthreads();
  rk0 = *(const u32x4*)(Kp); rk1 = *(const u32x4*)(Kp + (size_t)16 * ldk); rk2 = *(const u32x4*)(Kp + (size_t)32 * ldk); rk3 = *(const u32x4*)(Kp + (size_t)48 * ldk);
  rv0 = *(const u32x4*)(Vp); rv1 = *(const u32x4*)(Vp + (size_t)32 * ldv); rv2 = *(const u32x4*)(Vp + (size_t)64 * ldv); rv3 = *(const u32x4*)(Vp + (size_t)96 * ldv);
  *(u32x4*)(sbase + (kr0) * KLD + kc8) = rk0; *(u32x4*)(sbase + (kr0 + 16) * KLD + kc8) = rk1; *(u32x4*)(sbase + (kr0 + 32) * KLD + kc8) = rk2; *(u32x4*)(sbase + (kr0 + 48) * KLD + kc8) = rk3;
  *(u32x4*)(sbase + 64 * KLD + (vr0) * VLD + vc8) = rv0; *(u32x4*)(sbase + 64 * KLD + (vr0 + 32) * VLD + vc8) = rv1;
  *(u32x4*)(sbase + 64 * KLD + (vr0 + 64) * VLD + vc8) = rv2; *(u32x4*)(sbase + 64 * KLD + (vr0 + 96) * VLD + vc8) = rv3;
  __syncthreads();
  for (int j = 0; j < ntiles; j++) {
    const bf16* sK = sbase + (j & 1) * ASTAGE; const bf16* sV = sK + 64 * KLD;
    bf16* nK = sbase + ((j & 1) ^ 1) * ASTAGE; bf16* nV = nK + 64 * KLD;
    const bool more = j + 1 < ntiles;
    if (more) {
      const bf16* kq = Kp + (size_t)((j + 1) * 64) * ldk;
      rk0 = *(const u32x4*)(kq); rk1 = *(const u32x4*)(kq + (size_t)16 * ldk); rk2 = *(const u32x4*)(kq + (size_t)32 * ldk); rk3 = *(const u32x4*)(kq + (size_t)48 * ldk);
    }
    f32x16 s[2];
#pragma unroll
    for (int mt = 0; mt < 2; mt++) { s[mt] = zero16();
#pragma unroll
      for (int ks = 0; ks < 4; ks++) s[mt] = MFMA32(ldfrag16(sK + (mt * 32 + lr) * KLD + n * 64 + ks * 16 + lh * 8), qf[ks], s[mt]); }
    SCHED_BARRIER();
    if (more) {
      *(u32x4*)(nK + (kr0) * KLD + kc8) = rk0; *(u32x4*)(nK + (kr0 + 16) * KLD + kc8) = rk1; *(u32x4*)(nK + (kr0 + 32) * KLD + kc8) = rk2; *(u32x4*)(nK + (kr0 + 48) * KLD + kc8) = rk3;
      const bf16* vq = Vp + (j + 1) * 64;
      rv0 = *(const u32x4*)(vq); rv1 = *(const u32x4*)(vq + (size_t)32 * ldv); rv2 = *(const u32x4*)(vq + (size_t)64 * ldv); rv3 = *(const u32x4*)(vq + (size_t)96 * ldv);
    }
    float mx = -1e30f;
#pragma unroll
    for (int mt = 0; mt < 2; mt++)
#pragma unroll
      for (int r = 0; r < 16; r++) mx = fmaxf(mx, s[mt][r]);
    mx = fmaxf(mx, __shfl_xor(mx, 32));
    const float mnew = fmaxf(mrun, mx);
    const float alpha = EXP2(mrun - mnew);
    float rs = 0.f;
#pragma unroll
    for (int mt = 0; mt < 2; mt++)
#pragma unroll
      for (int r = 0; r < 16; r++) { const float e = EXP2(s[mt][r] - mnew); s[mt][r] = e; rs += e; }
    rs += __shfl_xor(rs, 32);
    lrun = lrun * alpha + rs; mrun = mnew;
    if (__any(alpha != 1.0f)) {
#pragma unroll
      for (int i = 0; i < 4; i++)
#pragma unroll
        for (int r = 0; r < 16; r++) o[i][r] *= alpha;
    }
    bf16x8 pf[2][2];
#pragma unroll
    for (int mt = 0; mt < 2; mt++)
#pragma unroll
      for (int s2 = 0; s2 < 2; s2++) pf[mt][s2] = pack8(s[mt], s2);
    SCHED_BARRIER();
#pragma unroll
    for (int mt = 0; mt < 2; mt++)
#pragma unroll
      for (int s2 = 0; s2 < 2; s2++) {
#pragma unroll
        for (int dt = 0; dt < 4; dt++) {
          const bf16* vp = sV + (dt * 32 + lr) * VLD + mt * 32 + 16 * s2 + 4 * lh;
          o[dt] = MFMA32(ldfrag8x2(vp, vp + 8), pf[mt][s2], o[dt]);
        }
      }
    SCHED_BARRIER();
    if (more) {
      *(u32x4*)(nV + (vr0) * VLD + vc8) = rv0; *(u32x4*)(nV + (vr0 + 32) * VLD + vc8) = rv1; *(u32x4*)(nV + (vr0 + 64) * VLD + vc8) = rv2; *(u32x4*)(nV + (vr0 + 96) * VLD + vc8) = rv3;
    }
    __syncthreads();
  }
  __syncthreads();
  float* comb = (float*)smem;
  const float invl = 1.f / lrun;
  if (n == 1) {
#pragma unroll
    for (int dt = 0; dt < 4; dt++)
#pragma unroll
      for (int r = 0; r < 16; r++) comb[(rh * 32 + lr) * 129 + dt * 32 + crow(r, lh)] = o[dt][r] * invl;
  }
  __syncthreads();
  if (n == 0) {
    float ss = 0.f;
#pragma unroll
    for (int dt = 0; dt < 4; dt++)
#pragma unroll
      for (int r = 0; r < 16; r++) { const float v = o[dt][r] * invl - lam * comb[(rh * 32 + lr) * 129 + dt * 32 + crow(r, lh)]; o[dt][r] = v; ss += v * v; }
    ss += __shfl_xor(ss, 32);
    const float rstd = rsqrtf(ss / 128.f + EPS) * (1.f - lam_init);
    const float* sg = p.in[I_SUBG] + l * 128;
    const int tok = ci.tok0 + rh * 32 + lr;
#pragma unroll
    for (int dt = 0; dt < 4; dt++)
#pragma unroll
      for (int g = 0; g < 4; g++) {
        const int dv = dt * 32 + 8 * g + 4 * lh;
        float gate[4]; ld4(proj + (size_t)tok * NC + O_AG + h * 128 + dv, gate);
        V4 ov;
#pragma unroll
        for (int r = 0; r < 4; r++) ov.s[r] = f2bf(o[dt][4 * g + r] * rstd * sg[dv + r] * siluf(gate[r]));
        *(uint2*)(proj + (size_t)tok * NC + O_AQ + h * 128 + dv) = ov.u;
      }
  }
  __syncthreads();
}

constexpr int HLD = 136, TLD = 72;
__device__ void hgrn_item(const Params& p, int l, int seq, int h, char* smem) {
  const int tid = TID(), lane = tid % 64, w = tid / 64, lr = lane % 32, lh = lane / 32;
  bf16* proj = (bf16*)(p.ws + W_PROJ);
  const int nch = seq < NB ? PCH : SCH;
  const int gc0 = seq < NB ? seq * PCH : NB * PCH + (seq - NB) * SCH;
  bf16* X0 = (bf16*)smem;
  bf16* X1 = X0 + 9216;
  float* red = (float*)(X1 + 9216);
  f32x16 S[4];
  if (seq < NB) {
#pragma unroll
    for (int kt = 0; kt < 4; kt++) S[kt] = zero16();
  } else {
    const float* s0 = p.in[I_SH] + (((size_t)l * NSB + (seq - NB)) * BH + h) * 16384;
#pragma unroll
    for (int kt = 0; kt < 4; kt++) {
      const float* sp = s0 + (size_t)(kt * 32 + 4 * lh) * 128 + w * 32 + lr;
#pragma unroll
      for (int r = 0; r < 16; r++) S[kt][r] = sp[((r & 3) + 8 * (r >> 2)) * 128];
      SCHED_BARRIER();
    }
  }
  const float* ng = p.in[I_BNG] + l * 128;
  for (int c = 0; c < nch; c++) {
    const int gc = gc0 + c, tok0 = gc * 64;
    const size_t item = (size_t)gc * BH + h;
    const bf16* hgx = (const bf16*)(p.ws + W_HGX) + item * 2 * 8192;
    const float* dl = (const float*)(p.ws + W_DL) + item * 128;
    __syncthreads();
    for (int i = 0; i < 4; i++) { const int cc = tid + i * 256, r = cc / 16, c8 = (cc % 16) * 8;
      *(uint4*)(X0 + r * HLD + c8) = *(const uint4*)(proj + (size_t)(tok0 + r) * NC + O_BF + h * 128 + c8);
      *(uint4*)(X1 + r * HLD + c8) = *(const uint4*)(proj + (size_t)(tok0 + r) * NC + O_BQ + h * 128 + c8); }
    __syncthreads();
    f32x16 x00 = zero16(), x01 = zero16(), x11 = zero16();
#pragma unroll
    for (int ks = 0; ks < 8; ks++) {
      const bf16x8 b0 = ldfrag16(X0 + (lr) * HLD + ks * 16 + lh * 8), b1 = ldfrag16(X0 + (32 + lr) * HLD + ks * 16 + lh * 8);
      const bf16x8 a0 = ldfrag16(X1 + (lr) * HLD + ks * 16 + lh * 8), a1 = ldfrag16(X1 + (32 + lr) * HLD + ks * 16 + lh * 8);
      x00 = MFMA32(b0, a0, x00); x01 = MFMA32(b0, a1, x01); x11 = MFMA32(b1, a1, x11);
      if (ks & 1) SCHED_BARRIER();
    }
#pragma unroll
    for (int r = 0; r < 16; r++) { if (crow(r, lh) > lr) { x00[r] = 0.f; x11[r] = 0.f; } }
    bf16x8 xp00[2], xp01[2], xp11[2];
#pragma unroll
    for (int s2 = 0; s2 < 2; s2++) { xp00[s2] = pack8(x00, s2); xp01[s2] = pack8(x01, s2); xp11[s2] = pack8(x11, s2); }
    SCHED_BARRIER();
    bf16x8 itf[2][2];
#pragma unroll
    for (int st = 0; st < 2; st++)
#pragma unroll
      for (int s2 = 0; s2 < 2; s2++) { const bf16* ip = hgx + 8192 + (size_t)(w * 32 + lr) * 64 + st * 32 + 16 * s2 + 4 * lh; itf[st][s2] = ldfrag8x2(ip, ip + 8); }
    __syncthreads();
    for (int i = 0; i < 4; i++) { const int cc = tid + i * 256;
      { const int r = cc / 16, c8 = (cc % 16) * 8; *(uint4*)(X0 + r * HLD + c8) = *(const uint4*)(proj + (size_t)(tok0 + r) * NC + O_BI + h * 128 + c8); }
      { const int r = cc / 8, c8 = (cc % 8) * 8; *(uint4*)(X1 + r * TLD + c8) = *(const uint4*)(hgx + (size_t)r * 64 + c8); } }
    __syncthreads();
    f32x16 o0 = zero16(), o1 = zero16();
#pragma unroll
    for (int s2 = 0; s2 < 2; s2++) {
      o0 = MFMA32(itf[0][s2], xp00[s2], o0);
      o1 = MFMA32(itf[0][s2], xp01[s2], o1);
      o1 = MFMA32(itf[1][s2], xp11[s2], o1);
    }
    SCHED_BARRIER();
#pragma unroll
    for (int kt = 0; kt < 4; kt++)
#pragma unroll
      for (int s2 = 0; s2 < 2; s2++) {
        const bf16x8 sp = pack8(S[kt], s2);
        const bf16* q0 = X0 + (lr) * HLD + kt * 32 + 16 * s2 + 4 * lh; const bf16* q1 = X0 + (32 + lr) * HLD + kt * 32 + 16 * s2 + 4 * lh;
        o0 = MFMA32(sp, ldfrag8x2(q0, q0 + 8), o0);
        o1 = MFMA32(sp, ldfrag8x2(q1, q1 + 8), o1);
        if (s2) SCHED_BARRIER();
      }
    SCHED_BARRIER();
#pragma unroll
    for (int kt = 0; kt < 4; kt++) {
      SCHED_BARRIER();
#pragma unroll
      for (int g = 0; g < 4; g++) { const float4 dv = *(const float4*)(dl + kt * 32 + 8 * g + 4 * lh);
        S[kt][4 * g] *= dv.x; S[kt][4 * g + 1] *= dv.y; S[kt][4 * g + 2] *= dv.z; S[kt][4 * g + 3] *= dv.w; }
#pragma unroll
      for (int st = 0; st < 2; st++)
#pragma unroll
        for (int s2 = 0; s2 < 2; s2++) { const bf16* kp = X1 + (kt * 32 + lr) * TLD + st * 32 + 16 * s2 + 4 * lh;
          S[kt] = MFMA32(ldfrag8x2(kp, kp + 8), itf[st][s2], S[kt]); }
    }
    SCHED_BARRIER();
    float ss0 = 0.f, ss1 = 0.f;
#pragma unroll
    for (int r = 0; r < 16; r++) { ss0 += o0[r] * o0[r]; ss1 += o1[r] * o1[r]; }
    ss0 += __shfl_xor(ss0, 32); ss1 += __shfl_xor(ss1, 32);
    if (lh == 0) { red[w * 64 + lr] = ss0; red[w * 64 + 32 + lr] = ss1; }
    __syncthreads();
#pragma unroll
    for (int tt = 0; tt < 2; tt++) {
      const int t = tt * 32 + lr;
      const float tot = red[t] + red[64 + t] + red[128 + t] + red[192 + t];
      const float rstd = rsqrtf(tot / 128.f + EPS);
      const int tok = tok0 + t;
#pragma unroll
      for (int g = 0; g < 4; g++) {
        const int v = w * 32 + 8 * g + 4 * lh;
        float gate[4]; ld4(proj + (size_t)tok * NC + O_BG + h * 128 + v, gate);
        V4 ov;
#pragma unroll
        for (int r = 0; r < 4; r++) { const float ovv = (tt == 0 ? o0[4 * g + r] : o1[4 * g + r]); ov.s[r] = f2bf(ovv * rstd * ng[v + r] * siluf(gate[r])); }
        *(uint2*)(proj + (size_t)tok * NC + O_BQ + h * 128 + v) = ov.u;
      }
    }
  }
  float* so = p.out + (seq < NB ? OO_HP + (((size_t)l * NB + seq) * BH + h) * 16384 : OO_HS + (((size_t)l * NSB + (seq - NB)) * BH + h) * 16384);
#pragma unroll
  for (int kt = 0; kt < 4; kt++) {
    float* sp = so + (size_t)(kt * 32 + 4 * lh) * 128 + w * 32 + lr;
#pragma unroll
    for (int r = 0; r < 16; r++) sp[((r & 3) + 8 * (r >> 2)) * 128] = S[kt][r];
    SCHED_BARRIER();
  }
  __syncthreads();
}

__device__ void rwkv_item(const Params& p, int l, int seq, int h, char* smem) {
  const int tid = TID(), ri = tid / 4, sub = tid % 4;
  bf16* proj = (bf16*)(p.ws + W_PROJ);
  const float* rww = (const float*)(p.ws + W_RWW);
  const bf16* rwr = (const bf16*)(p.ws + W_RWR); const bf16* rwk = (const bf16*)(p.ws + W_RWK); const bf16* rwa = (const bf16*)(p.ws + W_RWA);
  const bf16* rwb = (const bf16*)(p.ws + W_RWB); const bf16* rwv = (const bf16*)(p.ws + (l == 0 ? W_RWV0 : W_RWV1));
  float* sw = (float*)smem; float* sr = sw + 2048; float* sk = sr + 2048; float* sv = sk + 2048; float* sa = sv + 2048; float* sbb = sa + 2048; float* sy = sbb + 2048;
  const int len = seq_len(seq), t0 = seq_tok0(seq);
  float S[16];
  if (seq < NB) {
#pragma unroll
    for (int j = 0; j < 16; j++) S[j] = 0.f;
  } else {
    const float* s0 = p.in[I_SR] + ((((size_t)l * NSB + (seq - NB)) * CH + h) * 64 + ri) * 64 + sub * 16;
#pragma unroll
    for (int j = 0; j < 16; j++) S[j] = s0[j];
  }
  const float* lnw = p.in[I_LNW] + (size_t)l * CW + h * 64; const float* lnb = p.in[I_LNB] + (size_t)l * CW + h * 64;
  const float* rk = p.in[I_RK] + (size_t)l * CW + h * 64;
  for (int tb = 0; tb < len; tb += 32) {
    __syncthreads();
    {
      const int t = tid / 8, c8 = (tid % 8) * 8; const size_t g = (size_t)(t0 + tb + t) * CW + h * 64 + c8;
      *(float4*)(sw + t * 64 + c8) = *(const float4*)(rww + g); *(float4*)(sw + t * 64 + c8 + 4) = *(const float4*)(rww + g + 4);
      float x[8];
      ld8(rwr + g, x);
#pragma unroll
      for (int i = 0; i < 8; i++) sr[t * 64 + c8 + i] = x[i];
      ld8(rwk + g, x);
#pragma unroll
      for (int i = 0; i < 8; i++) sk[t * 64 + c8 + i] = x[i];
      ld8(rwv + g, x);
#pragma unroll
      for (int i = 0; i < 8; i++) sv[t * 64 + c8 + i] = x[i];
      ld8(rwa + g, x);
#pragma unroll
      for (int i = 0; i < 8; i++) sa[t * 64 + c8 + i] = x[i];
      ld8(rwb + g, x);
#pragma unroll
      for (int i = 0; i < 8; i++) sbb[t * 64 + c8 + i] = x[i];
    }
    __syncthreads();
    for (int t = 0; t < 32; t++) {
      const float* pa = sa + t * 64 + sub * 16; const float* pw = sw + t * 64 + sub * 16; const float* pb = sbb + t * 64 + sub * 16;
      const float* pk = sk + t * 64 + sub * 16; const float* pr = sr + t * 64 + sub * 16;
      float dot = 0.f, dotb = 0.f;
#pragma unroll
      for (int j = 0; j < 8; j++) { dot += S[j] * pa[j]; dotb += S[j + 8] * pa[j + 8]; }
      dot = red4(dot + dotb);
      const float vi = sv[t * 64 + ri];
      float y = 0.f, yb = 0.f;
#pragma unroll
      for (int j = 0; j < 8; j++) { S[j] = S[j] * pw[j] + dot * pb[j] + vi * pk[j]; y += S[j] * pr[j];
                                    S[j + 8] = S[j + 8] * pw[j + 8] + dot * pb[j + 8] + vi * pk[j + 8]; yb += S[j + 8] * pr[j + 8]; }
      y = red4(y + yb);
      if (sub == 0) sy[t * 64 + ri] = y;
    }
    __syncthreads();
    {
      const int t = tid / 8, c8 = (tid % 8) * 8; const int tok = t0 + tb + t;
      float y[8]; float s1 = 0.f, bon = 0.f;
#pragma unroll
      for (int i = 0; i < 8; i++) { y[i] = sy[t * 64 + c8 + i]; s1 += y[i]; bon += sr[t * 64 + c8 + i] * sk[t * 64 + c8 + i] * rk[c8 + i]; }
      s1 += __shfl_xor(s1, 1); s1 += __shfl_xor(s1, 2); s1 += __shfl_xor(s1, 4);
      bon += __shfl_xor(bon, 1); bon += __shfl_xor(bon, 2); bon += __shfl_xor(bon, 4);
      const float mu = s1 / 64.f; float s2 = 0.f;
#pragma unroll
      for (int i = 0; i < 8; i++) { const float d = y[i] - mu; s2 += d * d; }
      s2 += __shfl_xor(s2, 1); s2 += __shfl_xor(s2, 2); s2 += __shfl_xor(s2, 4);
      const float rstd = rsqrtf(s2 / 64.f + 64e-5f);
      float gate[8]; ld8(proj + (size_t)tok * NC + O_CG + h * 64 + c8, gate);
      V8 ov;
#pragma unroll
      for (int i = 0; i < 8; i++) { const float o = (y[i] - mu) * rstd * lnw[c8 + i] + lnb[c8 + i] + bon * sv[t * 64 + c8 + i]; ov.s[i] = f2bf(o * siluf(gate[i])); }
      *(uint4*)(proj + (size_t)tok * NC + O_CP + h * 64 + c8) = ov.u;
    }
  }
  float* so = p.out + (seq < NB ? OO_RP + ((((size_t)l * NB + seq) * CH + h) * 64 + ri) * 64 : OO_RS + ((((size_t)l * NSB + (seq - NB)) * CH + h) * 64 + ri) * 64) + sub * 16;
#pragma unroll
  for (int j = 0; j < 16; j++) so[j] = S[j];
  __syncthreads();
}

__device__ void phase_mixers(const Params& p, int l, char* smem) {
  __shared__ int s_item;
  int* cnt = (int*)(p.ws + W_CNT) + l;
  const float* lp = p.in[I_LAM] + (size_t)l * 256;
  float d1 = 0.f, d2 = 0.f;
  for (int i = 0; i < 64; i++) { d1 += lp[i] * lp[64 + i]; d2 += lp[128 + i] * lp[192 + i]; }
  const float lam_init = 0.8f - 0.6f * expf(-0.3f * (float)l);
  const float lam = expf(d1) - expf(d2) + lam_init;
  constexpr int N_RWP = NB * CH, N_HGP = NB * BH, N_ATP = NB * PCH * AH, N_RWS = NSB * CH, N_HGS = NSB * BH, N_ATS = NSB * SCH * AH;
  constexpr int NTOT = N_RWP + N_HGP + N_ATP + N_RWS + N_HGS + N_ATS;
  for (;;) {
    __syncthreads();
    if (TID() == 0) s_item = atomicAdd(cnt, 1);
    __syncthreads();
    int it = s_item;
    if (it >= NTOT) break;
    if (it < N_RWP) { if (SUBMASK & 1) rwkv_item(p, l, it / CH, it % CH, smem); continue; }
    it -= N_RWP;
    if (it < N_HGP) { if (SUBMASK & 2) hgrn_item(p, l, it / BH, it % BH, smem); continue; }
    it -= N_HGP;
    if (it < N_ATP) {
      const int lc = PCH - 1 - it / (NB * AH), r = it % (NB * AH); if (SUBMASK & 4) attn_item(p, l, (r / AH) * PCH + lc, r % AH, lam, lam_init, smem); continue; }
    it -= N_ATP;
    if (it < N_RWS) { if (SUBMASK & 1) rwkv_item(p, l, NB + it / CH, it % CH, smem); continue; }
    it -= N_RWS;
    if (it < N_HGS) { if (SUBMASK & 2) hgrn_item(p, l, NB + it / BH, it % BH, smem); continue; }
    it -= N_HGS;
    { const int gc = NB * PCH + it / AH; if (SUBMASK & 4) attn_item(p, l, gc, it % AH, lam, lam_init, smem); }
  }
}

constexpr int SMEM_BYTES = 73728;
#ifdef EMU
__device__ void run_phase(const Params& p, int ph, char* smem) {
  const int l = ph / 6, s = ph % 6;
  switch (s) {
#ifndef PHMASK
#define PHMASK 63
#endif
    case 0: if (PHMASK & 1) { if (l == 0) phase_wprep(p, smem); phase_rmsnorm(p, l); } break;
    case 1: if (PHMASK & 2) phase_proj(p, l, smem); break;
    case 2: if (PHMASK & 4) phase_prep(p, l, smem); break;
    case 3: if (PHMASK & 8) phase_mixers(p, l, smem); break;
    case 4: if (PHMASK & 16) phase_merge(p, l, smem); break;
    case 5: if (PHMASK & 32) phase_yout(p, l, smem); break;
  }
}
#endif
#ifndef EMU
__global__ void __launch_bounds__(256, 2) mega(Params p) {
  __shared__ __attribute__((aligned(16))) char smem[SMEM_BYTES];
  cg::grid_group grid = cg::this_grid();
  phase_wprep(p, smem);
#ifdef PROBE
  long long tmix = 0, tproj = 0;
#endif
#pragma unroll 1
  for (int l = 0; l < DEPTH; l++) {
    phase_rmsnorm(p, l); grid.sync();
#ifdef PROBE
    long long t0 = wall_clock64();
#endif
    phase_proj(p, l, smem); grid.sync();
#ifdef PROBE
    if (l == 0) tproj = wall_clock64() - t0;
#endif
    phase_prep(p, l, smem); grid.sync();
#ifdef PROBE
    t0 = wall_clock64();
#endif
    phase_mixers(p, l, smem); grid.sync();
#ifdef PROBE
    if (l == 0) tmix = wall_clock64() - t0;
#endif
    phase_merge(p, l, smem); grid.sync();
    phase_yout(p, l, smem); grid.sync();
  }
#ifdef PROBE
  long long* pr = (long long*)(p.ws + W_CNT + 64);
  if (blockIdx.x == 0 && threadIdx.x == 0) { pr[0] = tmix; pr[1] = tproj; }
  grid.sync();
  { const long long a = pr[0], b = pr[1];
    const long long q = (b + 25000) / 50000;
    const long long delay = a + 2000000LL * q + 40000000LL * (p.percu - 1);
    const long long te = wall_clock64() + delay;
    while (wall_clock64() < te) __builtin_amdgcn_s_sleep(20);
  }
#endif
}
extern "C" void kernel_launch(void* const* d_in, const int* in_sizes, int n_in, void* d_out, int out_size, void* d_ws, size_t ws_size, hipStream_t stream) {
  Params p{};
  for (int i = 0; i < 32; i++) p.in[i] = (const float*)d_in[i];
  p.out = (float*)d_out; p.ws = (char*)d_ws;
  if (ws_size < WS_TOTAL) { fprintf(stderr, "workspace too small: %zu < %zu\n", ws_size, (size_t)WS_TOTAL); return; }
  hipMemsetAsync((char*)d_ws + W_CNT, 0, 256, stream);
  static int grid_blocks = 0;
  if (!grid_blocks) {
    int dev = 0, cus = 0, per_cu = 0;
    hipGetDevice(&dev);
    hipDeviceGetAttribute(&cus, hipDeviceAttributeMultiprocessorCount, dev);
    hipOccupancyMaxActiveBlocksPerMultiprocessor(&per_cu, mega, 256, 0);
    if (per_cu > 2) per_cu = 2;
    grid_blocks = cus * per_cu;
  }
#ifdef PROBE
  p.percu = grid_blocks / 256;
#endif
  void* args[] = { &p };
  hipError_t e = hipLaunchCooperativeKernel((void*)mega, dim3(grid_blocks), dim3(256), args, 0, stream);
  if (e != hipSuccess) fprintf(stderr, "cooperative launch failed: %s (grid %d)\n", hipGetErrorString(e), grid_blocks);
}
#endif
```

```cpp
#ifdef EMU
#include "emu.h"
#define MFMA32(a, b, c) emu_mfma32(a, b, c)
#else
#include <hip/hip_runtime.h>
#include <hip/hip_cooperative_groups.h>
#include <cstdio>
namespace cg = cooperative_groups;
typedef short bf16x8 __attribute__((ext_vector_type(8)));
typedef float f32x16 __attribute__((ext_vector_type(16)));
#define MFMA32(a, b, c) __builtin_amdgcn_mfma_f32_32x32x16_bf16(a, b, c, 0, 0, 0)
#endif

#ifdef EMU
#define TID() ((int)threadIdx.x)
#define BID() ((int)blockIdx.x)
#else
static __device__ __forceinline__ int TID() { int t = threadIdx.x; asm volatile("" : "+v"(t)); return t; }
static __device__ __forceinline__ int BID() { int t = blockIdx.x; asm volatile("" : "+s"(t)); return t; }
#endif
#define DI __device__ __forceinline__
#if defined(__HIP_DEVICE_COMPILE__)
#define SETPRIO(n) __builtin_amdgcn_s_setprio(n)
#else
#define SETPRIO(n)
#endif
#ifdef EMU
#define DPP_XOR1(x) emu_lane_perm(x, 0)
#define DPP_XOR2(x) emu_lane_perm(x, 1)
#define DPP_HMIR(x) emu_lane_perm(x, 2)
#define DPP_RMIR(x) emu_lane_perm(x, 3)
#else
#define DPP_F(x, c) __builtin_bit_cast(float, __builtin_amdgcn_update_dpp(0, __builtin_bit_cast(int, (float)(x)), c, 0xF, 0xF, true))
#define DPP_XOR1(x) DPP_F(x, 0xB1)
#define DPP_XOR2(x) DPP_F(x, 0x4E)
#define DPP_HMIR(x) DPP_F(x, 0x141)
#define DPP_RMIR(x) DPP_F(x, 0x140)
#endif
#ifdef EMU
#define EXP2(x) exp2f(x)
#else
#define EXP2(x) __builtin_amdgcn_exp2f(x)
#endif
#ifdef EMU
#define SCHED_BARRIER()
#else
#define SCHED_BARRIER() __builtin_amdgcn_sched_barrier(0)
#endif
typedef unsigned short bf16;

#ifdef SMALL
constexpr int D = 128, NB = 2, T = 256, NSB = 2, TS = 64, PAST = 128, AH = 2, BH = 1, CH = 2;
#else
constexpr int D = 1024, NB = 8, T = 8192, NSB = 16, TS = 64, PAST = 1024, AH = 8, BH = 8, CH = 16;
#endif
constexpr int DEPTH = 2;
constexpr int AQK = AH * 128, AW = AH * 128, BQK = BH * 128, BW = BH * 128, CW = CH * 64;
constexpr int CSH = 3 * CW + 128;
constexpr int O_AQ = 0, O_AK = AQK, O_AV = 2 * AQK, O_AG = O_AV + AW, O_BQ = O_AG + AW, O_BF = O_BQ + BQK, O_BI = O_BF + BQK,
              O_BG = O_BI + BW, O_CP = O_BG + BW, O_CG = O_CP + CSH, O_MA = O_CG + CW, O_MB = O_MA + D, O_MC = O_MB + D, NC = O_MC + D;
constexpr int CP_R = 0, CP_WLO = CW, CP_K = CW + 64, CP_V = 2 * CW + 64, CP_ALO = 3 * CW + 64;
constexpr int MP = NB * T, MS = NSB * TS, M = MP + MS, NSEQ = NB + NSB, KS = PAST + TS;
constexpr int NCHK = M / 64, PCH = T / 64, SCH = TS / 64;
constexpr int MAXPOS = (T > KS ? T : KS);
constexpr float EPS = 1e-6f;

constexpr size_t OO_Y = 0;
constexpr size_t OO_KP = (size_t)M * D;
constexpr size_t OO_VP = OO_KP + (size_t)DEPTH * MP * AQK;
constexpr size_t OO_HP = OO_VP + (size_t)DEPTH * MP * AW;
constexpr size_t OO_RP = OO_HP + (size_t)DEPTH * NB * BH * 16384;
constexpr size_t OO_SP = OO_RP + (size_t)DEPTH * NB * CH * 4096;
constexpr size_t OO_KS = OO_SP + (size_t)DEPTH * NB * CSH;
constexpr size_t OO_VS = OO_KS + (size_t)DEPTH * MS * AQK;
constexpr size_t OO_HS = OO_VS + (size_t)DEPTH * MS * AW;
constexpr size_t OO_RS = OO_HS + (size_t)DEPTH * NSB * BH * 16384;
constexpr size_t OO_SS = OO_RS + (size_t)DEPTH * NSB * CH * 4096;
constexpr size_t OUT_TOTAL = OO_SS + (size_t)DEPTH * NSB * CSH;

constexpr size_t al256(size_t x) { return (x + 255) & ~(size_t)255; }
constexpr size_t W_PROJ = 0;
constexpr size_t W_HN = al256(W_PROJ + (size_t)M * NC * 2);
constexpr size_t W_HGX = al256(W_HN + (size_t)M * D * 2);
constexpr size_t W_DL = al256(W_HGX + (size_t)NCHK * BH * 2 * 8192 * 2);
constexpr size_t W_RWW = al256(W_DL + (size_t)NCHK * BH * 128 * 4);
constexpr size_t W_RWR = al256(W_RWW + (size_t)M * CW * 4);
constexpr size_t W_RWK = al256(W_RWR + (size_t)M * CW * 2);
constexpr size_t W_RWA = al256(W_RWK + (size_t)M * CW * 2);
constexpr size_t W_RWB = al256(W_RWA + (size_t)M * CW * 2);
constexpr size_t W_RWV0 = al256(W_RWB + (size_t)M * CW * 2);
constexpr size_t W_RWV1 = al256(W_RWV0 + (size_t)M * CW * 2);
constexpr size_t W_VTP = al256(W_RWV1 + (size_t)M * CW * 2);
constexpr size_t W_KBS = al256(W_VTP + (size_t)NB * AH * 128 * T * 2);
constexpr size_t W_VTS = al256(W_KBS + (size_t)NSB * AH * KS * 128 * 2);
constexpr size_t W_WT = al256(W_VTS + (size_t)NSB * AH * 128 * KS * 2);
constexpr size_t WT_IN = 0, WT_OA = (size_t)NC * D, WT_OB = WT_OA + (size_t)D * AW, WT_OC = WT_OB + (size_t)D * BW, WT_OO = WT_OC + (size_t)D * CW,
                 WT_LAYER = WT_OO + (size_t)D * D;
constexpr size_t W_ROPE = al256(W_WT + (size_t)DEPTH * WT_LAYER * 2);
constexpr size_t W_CNT = al256(W_ROPE + (size_t)MAXPOS * 16 * 4);
constexpr size_t WS_TOTAL = W_CNT + 256;

struct Params { const float* in[32]; float* out; char* ws; long long percu; };

enum { I_XP, I_XS, I_CK, I_CV, I_SH, I_SR, I_SS, I_NG, I_WIN, I_QNG, I_KNG, I_LAM, I_SUBG, I_BLOW, I_BNG, I_MU, I_W0, I_W2, I_A0, I_A2,
       I_KK, I_KA, I_RK, I_LNW, I_LNB, I_VW1, I_VW2, I_V0, I_WOA, I_WOB, I_WOC, I_WO };

DI bf16 f2bf(float x) { unsigned u = __float_as_uint(x); u += 0x7fffu + ((u >> 16) & 1u); return (bf16)(u >> 16); }
DI float bf2f(bf16 s) { return __uint_as_float(((unsigned)s) << 16); }
DI float sigm(float x) { return 1.0f / (1.0f + __expf(-x)); }
DI float siluf(float x) { return x / (1.0f + __expf(-x)); }
union V8 { bf16x8 v; uint4 u; uint2 h[2]; bf16 s[8]; };
union V4 { uint2 u; bf16 s[4]; };
DI void ld8(const bf16* p, float* o) { V8 t; t.u = *(const uint4*)p;
#pragma unroll
  for (int i = 0; i < 8; i++) o[i] = bf2f(t.s[i]); }
DI void ld4(const bf16* p, float* o) { V4 t; t.u = *(const uint2*)p;
#pragma unroll
  for (int i = 0; i < 4; i++) o[i] = bf2f(t.s[i]); }
DI bf16x8 ldfrag16(const bf16* p) { V8 t; t.u = *(const uint4*)p; return t.v; }
DI bf16x8 ldfrag8x2(const bf16* p0, const bf16* p1) { V8 t; t.h[0] = *(const uint2*)p0; t.h[1] = *(const uint2*)p1; return t.v; }
DI bf16x8 pack8(const f32x16& x, int s) { V8 t;
#pragma unroll
  for (int j = 0; j < 8; j++) t.s[j] = f2bf(x[8 * s + j]); return t.v; }
DI f32x16 zero16() { f32x16 z;
#pragma unroll
  for (int i = 0; i < 16; i++) z[i] = 0.f; return z; }
DI float red4(float x) { x += DPP_XOR1(x); x += DPP_XOR2(x); return x; }
DI float red8(float x) { x = red4(x); x += DPP_HMIR(x); return x; }
DI float red16(float x) { x = red8(x); x += DPP_RMIR(x); return x; }
DI int crow(int reg, int h) { return (reg & 3) + 8 * (reg >> 2) + 4 * h; }

struct ChunkInfo { int seq, lc, tok0, pos0; };
DI ChunkInfo chunk_info(int gc) { ChunkInfo c; c.tok0 = gc * 64;
  if (gc < NB * PCH) { c.seq = gc / PCH; c.lc = gc % PCH; c.pos0 = c.lc * 64; }
  else { int r = gc - NB * PCH; c.seq = NB + r / SCH; c.lc = r % SCH; c.pos0 = PAST + c.lc * 64; }
  return c; }
DI int seq_tok0(int seq) { return seq < NB ? seq * T : MP + (seq - NB) * TS; }
DI int seq_len(int seq) { return seq < NB ? T : TS; }

__device__ void transpose_w(const float* src, bf16* dst, int K, int N, float* tile  ) {
  const int tid = TID(); const int nkt = K / 64, nnt = N / 64;
  for (int t = BID(); t < nkt * nnt; t += gridDim.x) {
    const int k0 = (t / nnt) * 64, n0 = (t % nnt) * 64;
    for (int i = 0; i < 16; i++) { int r = i * 4 + tid / 64, c = tid % 64; tile[r * 65 + c] = src[(size_t)(k0 + r) * N + n0 + c]; }
    __syncthreads();
    for (int i = 0; i < 16; i++) { int n = i * 4 + tid / 64, k = tid % 64; dst[(size_t)(n0 + n) * K + k0 + k] = f2bf(tile[k * 65 + n]); }
    __syncthreads();
  }
}
__device__ void phase_wprep(const Params& p, char* smem) {
  float* tile = (float*)smem;
  for (int l = 0; l < DEPTH; l++) {
    bf16* wt = (bf16*)(p.ws + W_WT) + (size_t)l * WT_LAYER;
    transpose_w(p.in[I_WIN] + (size_t)l * D * NC, wt + WT_IN, D, NC, tile);
    transpose_w(p.in[I_WOA] + (size_t)l * AW * D, wt + WT_OA, AW, D, tile);
    transpose_w(p.in[I_WOB] + (size_t)l * BW * D, wt + WT_OB, BW, D, tile);
    transpose_w(p.in[I_WOC] + (size_t)l * CW * D, wt + WT_OC, CW, D, tile);
    transpose_w(p.in[I_WO] + (size_t)l * D * D, wt + WT_OO, D, D, tile);
  }
  float* rope = (float*)(p.ws + W_ROPE);
  for (int i = BID() * blockDim.x + TID(); i < MAXPOS * 8; i += gridDim.x * blockDim.x) {
    int pos = i / 8, j = i % 8;
    double inv = pow(500000.0, -(double)j / 8.0);
    double ang = (double)pos * inv;
    rope[pos * 16 + j] = (float)cos(ang); rope[pos * 16 + 8 + j] = (float)sin(ang);
  }
}

DI const float* x_row(const Params& p, int l, int m) {
  if (l == 0) return m < MP ? p.in[I_XP] + (size_t)m * D : p.in[I_XS] + (size_t)(m - MP) * D;
  return p.out + OO_Y + (size_t)m * D;
}
__device__ void phase_rmsnorm(const Params& p, int l) {
  const int lane = TID() % 64, w = TID() / 64;
  bf16* hn = (bf16*)(p.ws + W_HN);
  const float* g = p.in[I_NG] + (size_t)l * D;
  for (int m = BID() * 4 + w; m < M; m += gridDim.x * 4) {
    const float* x = x_row(p, l, m);
    float ss = 0.f;
    for (int c = lane * 4; c < D; c += 256) { float4 v = *(const float4*)(x + c); ss += v.x * v.x + v.y * v.y + v.z * v.z + v.w * v.w; }
    for (int o = 32; o >= 1; o >>= 1) ss += __shfl_xor(ss, o);
    const float rs = rsqrtf(ss / D + EPS);
    for (int c = lane * 4; c < D; c += 256) { float4 v = *(const float4*)(x + c); float4 gg = *(const float4*)(g + c);
      V4 o; o.s[0] = f2bf(v.x * rs * gg.x); o.s[1] = f2bf(v.y * rs * gg.y); o.s[2] = f2bf(v.z * rs * gg.z); o.s[3] = f2bf(v.w * rs * gg.w);
      *(uint2*)(hn + (size_t)m * D + c) = o.u; }
  }
}

constexpr int GLD = 40;
constexpr int GSTAGE = 2 * 128 * GLD;
template <int NJ> DI void gemm_mainloop(const bf16* A, size_t lda, const bf16* Bt, size_t ldb, int K, int m0, int n0, bf16* lds, f32x16 acc[2][NJ]) {
  const int tid = TID(), lane = tid % 64, w = tid / 64, wm = w / 2, wn = w % 2, lr = lane % 32, lh = lane / 32;
  const int nk = K / 32;
  typedef unsigned int u32x4 __attribute__((ext_vector_type(4)));
  u32x4 a00, a01, b00, b01, a10, a11, b10, b11;
  const int r0 = tid / 4, kc = (tid % 4) * 8;
  const bf16* Ap = A + (size_t)(m0 + r0) * lda + kc;
  const bf16* Bp = Bt + (size_t)(n0 + r0) * ldb + kc;
  const int so = r0 * GLD + kc;
#define G_LOAD0(kt) { a00 = *(const u32x4*)(Ap + (kt) * 32); a01 = *(const u32x4*)(Ap + (size_t)64 * lda + (kt) * 32); b00 = *(const u32x4*)(Bp + (kt) * 32); if (NJ == 2) b01 = *(const u32x4*)(Bp + (size_t)64 * ldb + (kt) * 32); }
#define G_LOAD1(kt) { a10 = *(const u32x4*)(Ap + (kt) * 32); a11 = *(const u32x4*)(Ap + (size_t)64 * lda + (kt) * 32); b10 = *(const u32x4*)(Bp + (kt) * 32); if (NJ == 2) b11 = *(const u32x4*)(Bp + (size_t)64 * ldb + (kt) * 32); }
#define G_STORE0(st) { bf16* q = lds + (st) * GSTAGE + so; *(u32x4*)q = a00; *(u32x4*)(q + 64 * GLD) = a01; *(u32x4*)(q + 128 * GLD) = b00; if (NJ == 2) *(u32x4*)(q + 192 * GLD) = b01; }
#define G_STORE1(st) { bf16* q = lds + (st) * GSTAGE + so; *(u32x4*)q = a10; *(u32x4*)(q + 64 * GLD) = a11; *(u32x4*)(q + 128 * GLD) = b10; if (NJ == 2) *(u32x4*)(q + 192 * GLD) = b11; }
#define G_COMPUTE(st) { const bf16* sAc = lds + (st) * GSTAGE; const bf16* sBc = sAc + 128 * GLD; \
    _Pragma("unroll") for (int ks = 0; ks < 2; ks++) { bf16x8 fa[2], fb[NJ]; \
      _Pragma("unroll") for (int i = 0; i < 2; i++) { fa[i] = ldfrag16(sAc + (wm * 64 + i * 32 + lr) * GLD + ks * 16 + lh * 8); \
        if (i < NJ) fb[i] = ldfrag16(sBc + (wn * 32 * NJ + i * 32 + lr) * GLD + ks * 16 + lh * 8); } \
      _Pragma("unroll") for (int i = 0; i < 2; i++) _Pragma("unroll") for (int j = 0; j < NJ; j++) acc[i][j] = MFMA32(fa[i], fb[j], acc[i][j]); } }
  G_LOAD0(0)
  G_LOAD1(1)
  G_STORE0(0)
  __syncthreads();
  int st = 0;
  for (int kt = 0; kt < nk; kt += 2) {
    const int st1 = st == 2 ? 0 : st + 1, st2 = st1 == 2 ? 0 : st1 + 1;
    if (kt + 2 < nk) G_LOAD0(kt + 2)
    G_COMPUTE(st)
    G_STORE1(st1)
    __syncthreads();
    if (kt + 3 < nk) G_LOAD1(kt + 3)
    G_COMPUTE(st1)
    if (kt + 2 < nk) G_STORE0(st2)
    __syncthreads();
    st = st2;
  }
#undef G_LOAD0
#undef G_LOAD1
#undef G_STORE0
#undef G_STORE1
#undef G_COMPUTE
}

__device__ void phase_proj(const Params& p, int l, char* smem) {
  const bf16* hn = (const bf16*)(p.ws + W_HN);
  const bf16* wt = (const bf16*)(p.ws + W_WT) + (size_t)l * WT_LAYER + WT_IN;
  bf16* proj = (bf16*)(p.ws + W_PROJ);
  const int lane = TID() % 64, w = TID() / 64, wm = w / 2, wn = w % 2, lr = lane % 32, lh = lane / 32;
  constexpr int NT = NC / 128, MT = M / 128;
  constexpr int MG = 4, NGRP = (MT + MG - 1) / MG;
  const int bid = BID(), xcd = bid % 8, lb = bid / 8, nlb = ((int)gridDim.x + 7 - xcd) / 8;
  const int ngx = (NGRP - xcd + 7) / 8;
  for (int it = lb; it < ngx * NT * MG; it += nlb) {
    const int g = xcd + 8 * (it / (NT * MG)), r = it % (NT * MG);
    const int mt = g * MG + r % MG, nt = r / MG;
    if (mt >= MT) continue;
    const int m0 = mt * 128, n0 = nt * 128;
    f32x16 acc[2][2];
#pragma unroll
    for (int i = 0; i < 2; i++)
#pragma unroll
      for (int j = 0; j < 2; j++) acc[i][j] = zero16();
    gemm_mainloop<2>(hn, D, wt, D, D, m0, n0, (bf16*)smem, acc);
#pragma unroll
    for (int i = 0; i < 2; i++)
#pragma unroll
      for (int j = 0; j < 2; j++)
#pragma unroll
        for (int r = 0; r < 16; r++) {
          const int row = m0 + wm * 64 + i * 32 + crow(r, lh), col = n0 + wn * 64 + j * 32 + lr;
          proj[(size_t)row * NC + col] = f2bf(acc[i][j][r]);
        }
  }
}

__device__ void phase_merge(const Params& p, int l, char* smem) {
  const bf16* proj = (const bf16*)(p.ws + W_PROJ);
  const bf16* wt = (const bf16*)(p.ws + W_WT) + (size_t)l * WT_LAYER;
  bf16* mrg = (bf16*)(p.ws + W_HN);
  const int lane = TID() % 64, w = TID() / 64, wm = w / 2, wn = w % 2, lr = lane % 32, lh = lane / 32;
  constexpr int NT = D / 64, MT = M / 128;
  for (int t = BID(); t < MT * NT; t += gridDim.x) {
    const int m0 = (t / NT) * 128, n0 = (t % NT) * 64;
    f32x16 tot[2];
    tot[0] = zero16(); tot[1] = zero16();
#pragma unroll 1
    for (int mx = 0; mx < 3; mx++) {
      f32x16 acc[2][1];
      acc[0][0] = zero16(); acc[1][0] = zero16();
      const int acol = mx == 0 ? O_AQ : (mx == 1 ? O_BQ : O_CP);
      const int Kx = mx == 0 ? AW : (mx == 1 ? BW : CW);
      const size_t woff = mx == 0 ? WT_OA : (mx == 1 ? WT_OB : WT_OC);
      const int gcol = O_MA + mx * D;
      gemm_mainloop<1>(proj + acol, NC, wt + woff, Kx, Kx, m0, n0, (bf16*)smem, acc);
#pragma unroll
      for (int i = 0; i < 2; i++)
#pragma unroll
        for (int r = 0; r < 16; r++) {
          const int row = m0 + wm * 64 + i * 32 + crow(r, lh), col = n0 + wn * 32 + lr;
          tot[i][r] += sigm(bf2f(proj[(size_t)row * NC + gcol + col])) * acc[i][0][r];
        }
    }
#pragma unroll
    for (int i = 0; i < 2; i++)
#pragma unroll
      for (int r = 0; r < 16; r++) {
        const int row = m0 + wm * 64 + i * 32 + crow(r, lh), col = n0 + wn * 32 + lr;
        mrg[(size_t)row * D + col] = f2bf(tot[i][r]);
      }
  }
}

__device__ void phase_yout(const Params& p, int l, char* smem) {
  const bf16* mrg = (const bf16*)(p.ws + W_HN);
  const bf16* wt = (const bf16*)(p.ws + W_WT) + (size_t)l * WT_LAYER + WT_OO;
  const int lane = TID() % 64, w = TID() / 64, wm = w / 2, wn = w % 2, lr = lane % 32, lh = lane / 32;
  constexpr int NT = D / 128, MT = M / 128;
  for (int t = BID(); t < MT * NT; t += gridDim.x) {
    const int m0 = (t / NT) * 128, n0 = (t % NT) * 128;
    f32x16 acc[2][2];
#pragma unroll
    for (int i = 0; i < 2; i++)
#pragma unroll
      for (int j = 0; j < 2; j++) acc[i][j] = zero16();
    gemm_mainloop<2>(mrg, D, wt, D, D, m0, n0, (bf16*)smem, acc);
#pragma unroll
    for (int i = 0; i < 2; i++)
#pragma unroll
      for (int j = 0; j < 2; j++)
#pragma unroll
        for (int r = 0; r < 16; r++) {
          const int row = m0 + wm * 64 + i * 32 + crow(r, lh), col = n0 + wn * 64 + j * 32 + lr;
          const float xv = x_row(p, l, row)[col];
          p.out[OO_Y + (size_t)row * D + col] = xv + acc[i][j][r];
        }
  }
}

__device__ void prep_attn_chunk(const Params& p, int l, int gc, char* smem) {
  const int tid = TID();
  const ChunkInfo ci = chunk_info(gc);
  bf16* proj = (bf16*)(p.ws + W_PROJ);
  const float* rope = (const float*)(p.ws + W_ROPE);
  const float* qg = p.in[I_QNG] + l * 64; const float* kg = p.in[I_KNG] + l * 64;
  const bool samp = ci.seq >= NB; const int sb = ci.seq - NB;
  const int sub = tid % 8;
  constexpr int NVEC = 64 * 2 * AH * 2;
  for (int v0 = 0; v0 < NVEC; v0 += 128) {
    float xx[4][8];
#pragma unroll
    for (int u = 0; u < 4; u++) {
      const int vi = v0 + u * 32 + tid / 8;
      const int t = vi / (4 * AH), rem = vi % (4 * AH), isk = rem / (2 * AH), hn2 = rem % (2 * AH);
      ld8(proj + (size_t)(ci.tok0 + t) * NC + (isk ? O_AK : O_AQ) + hn2 * 64 + sub * 8, xx[u]);
    }
#pragma unroll
    for (int u = 0; u < 4; u++) {
      const int vi = v0 + u * 32 + tid / 8;
      const int t = vi / (4 * AH), rem = vi % (4 * AH), isk = rem / (2 * AH), hn2 = rem % (2 * AH);
      const int tok = ci.tok0 + t, pos = ci.pos0 + t;
      bf16* src = proj + (size_t)tok * NC + (isk ? O_AK : O_AQ) + hn2 * 64 + sub * 8;
      float* x = xx[u];
      float ss = 0.f;
#pragma unroll
      for (int i = 0; i < 8; i++) ss += x[i] * x[i];
      ss = red8(ss);
      const float rs = rsqrtf(ss / 64.f + EPS);
      const float* g = isk ? kg : qg;
#pragma unroll
      for (int i = 0; i < 8; i++) x[i] = x[i] * rs * g[sub * 8 + i];
      float y[8];
#pragma unroll
      for (int i = 0; i < 8; i++) y[i] = DPP_XOR1(x[i]);
      if (sub < 2) {
#pragma unroll
        for (int i = 0; i < 8; i++) { const float c = rope[pos * 16 + i], sn = rope[pos * 16 + 8 + i];
          x[i] = (sub == 0) ? (x[i] * c - y[i] * sn) : (x[i] * c + y[i] * sn); }
      }
      if (isk) {
        float* ko = p.out + (samp ? OO_KS + ((size_t)l * MS + (tok - MP)) * AQK : OO_KP + ((size_t)l * MP + tok) * AQK) + hn2 * 64 + sub * 8;
        *(float4*)ko = make_float4(x[0], x[1], x[2], x[3]); *(float4*)(ko + 4) = make_float4(x[4], x[5], x[6], x[7]);
        V8 o;
#pragma unroll
        for (int i = 0; i < 8; i++) o.s[i] = f2bf(x[i]);
        if (samp) { bf16* kb = (bf16*)(p.ws + W_KBS) + ((size_t)(sb * AH + hn2 / 2) * KS + PAST + ci.lc * 64 + t) * 128 + (hn2 % 2) * 64 + sub * 8; *(uint4*)kb = o.u; }
        else *(uint4*)src = o.u;
      } else {
        V8 o;
#pragma unroll
        for (int i = 0; i < 8; i++) o.s[i] = f2bf(x[i] * (0.125f * 1.44269504088896f));
        *(uint4*)src = o.u;
      }
    }
  }
  bf16* tile = (bf16*)smem;
  for (int h = 0; h < AH; h++) {
    __syncthreads();
    for (int i = 0; i < 4; i++) { const int c = tid + i * 256, t = c / 16, d8 = (c % 16) * 8; const int tok = ci.tok0 + t;
      const bf16* src = proj + (size_t)tok * NC + O_AV + h * 128 + d8;
      V8 u; u.u = *(const uint4*)src;
      *(uint4*)(tile + t * 136 + d8) = u.u;
      float* vo = p.out + (samp ? OO_VS + ((size_t)l * MS + (tok - MP)) * AW : OO_VP + ((size_t)l * MP + tok) * AW) + h * 128 + d8;
      *(float4*)vo = make_float4(bf2f(u.s[0]), bf2f(u.s[1]), bf2f(u.s[2]), bf2f(u.s[3]));
      *(float4*)(vo + 4) = make_float4(bf2f(u.s[4]), bf2f(u.s[5]), bf2f(u.s[6]), bf2f(u.s[7])); }
    __syncthreads();
    { const int dv = tid / 2, th = tid % 2;
      bf16* dst = samp ? (bf16*)(p.ws + W_VTS) + ((size_t)(sb * AH + h) * 128 + dv) * KS + PAST + ci.lc * 64 + th * 32
                       : (bf16*)(p.ws + W_VTP) + ((size_t)(ci.seq * AH + h) * 128 + dv) * T + ci.lc * 64 + th * 32;
#pragma unroll
      for (int q = 0; q < 4; q++) { V8 o;
#pragma unroll
        for (int i = 0; i < 8; i++) o.s[i] = tile[(th * 32 + q * 8 + i) * 136 + dv];
        *(uint4*)(dst + q * 8) = o.u; } }
  }
  __syncthreads();
}
__device__ void prep_past_tile(const Params& p, int l, int item, char* smem) {
  const int tid = TID();
  constexpr int NKT = PAST / 64;
  const int kt = item % NKT, h = (item / NKT) % AH, sb = item / (NKT * AH);
  const float* ck = p.in[I_CK] + (((size_t)l * NSB + sb) * PAST + kt * 64) * AQK + h * 128;
  const float* cv = p.in[I_CV] + (((size_t)l * NSB + sb) * PAST + kt * 64) * AW + h * 128;
  bf16* kb = (bf16*)(p.ws + W_KBS) + ((size_t)(sb * AH + h) * KS + kt * 64) * 128;
  bf16* tile = (bf16*)smem;
  __syncthreads();
  for (int i = 0; i < 4; i++) { const int c = tid + i * 256, t = c / 16, d8 = (c % 16) * 8;
    float4 a = *(const float4*)(ck + (size_t)t * AQK + d8), b = *(const float4*)(ck + (size_t)t * AQK + d8 + 4);
    V8 o; o.s[0] = f2bf(a.x); o.s[1] = f2bf(a.y); o.s[2] = f2bf(a.z); o.s[3] = f2bf(a.w); o.s[4] = f2bf(b.x); o.s[5] = f2bf(b.y); o.s[6] = f2bf(b.z); o.s[7] = f2bf(b.w);
    *(uint4*)(kb + (size_t)t * 128 + d8) = o.u;
    a = *(const float4*)(cv + (size_t)t * AW + d8); b = *(const float4*)(cv + (size_t)t * AW + d8 + 4);
    o.s[0] = f2bf(a.x); o.s[1] = f2bf(a.y); o.s[2] = f2bf(a.z); o.s[3] = f2bf(a.w); o.s[4] = f2bf(b.x); o.s[5] = f2bf(b.y); o.s[6] = f2bf(b.z); o.s[7] = f2bf(b.w);
    *(uint4*)(tile + t * 136 + d8) = o.u; }
  __syncthreads();
  { const int dv = tid / 2, th = tid % 2;
    bf16* dst = (bf16*)(p.ws + W_VTS) + ((size_t)(sb * AH + h) * 128 + dv) * KS + kt * 64 + th * 32;
#pragma unroll
    for (int q = 0; q < 4; q++) { V8 o;
#pragma unroll
      for (int i = 0; i < 8; i++) o.s[i] = tile[(th * 32 + q * 8 + i) * 136 + dv];
      *(uint4*)(dst + q * 8) = o.u; } }
  __syncthreads();
}
__device__ void prep_hgrn(const Params& p, int l, int item, char* smem) {
  const int tid = TID(), k = tid % 128, th = tid / 128;
  const int gc = item / BH, h = item % BH;
  const ChunkInfo ci = chunk_info(gc);
  bf16* proj = (bf16*)(p.ws + W_PROJ);
  float* tot = (float*)smem;
  float lb = 0.f;
  if (l == 1) { const float b0 = p.in[I_BLOW][h * 128 + k], b1 = p.in[I_BLOW][BQK + h * 128 + k]; lb = 1.f / (1.f + __expf(b0 - b1)); }
  float zs[32], cs[32];
  bf16* base = proj + (size_t)(ci.tok0 + th * 32) * NC + h * 128 + k;
  float run = 0.f;
#pragma unroll
  for (int i = 0; i < 32; i++) { const float z = bf2f(base[(size_t)i * NC + O_BF]); zs[i] = z; const float f = lb + (1.f - lb) * sigm(z); run += __logf(f); cs[i] = run; }
  __syncthreads();
  tot[th * 128 + k] = run;
  __syncthreads();
  const float t0 = tot[k], t1 = tot[128 + k];
  const float ref = t0, last = t0 + t1, off = th ? t0 : 0.f;
  V8 kt8[4], it8[4];
#pragma unroll
  for (int i = 0; i < 32; i++) {
    const float cum = cs[i] + off, z = zs[i];
    const float kin = (1.f - lb) * sigm(-z);
    const float qv = siluf(bf2f(base[(size_t)i * NC + O_BQ]));
    const bf16 iv = base[(size_t)i * NC + O_BI];
    base[(size_t)i * NC + O_BQ] = f2bf(qv * __expf(fminf(cum - ref, 80.f)));
    base[(size_t)i * NC + O_BF] = f2bf(kin * __expf(fminf(ref - cum, 80.f)));
    base[(size_t)i * NC + O_BI] = f2bf(qv * __expf(cum));
    kt8[i / 8].s[i % 8] = f2bf(kin * __expf(last - cum));
    it8[i / 8].s[i % 8] = iv;
  }
  bf16* hgx = (bf16*)(p.ws + W_HGX) + (size_t)item * 2 * 8192;
#pragma unroll
  for (int q = 0; q < 4; q++) { *(uint4*)(hgx + k * 64 + th * 32 + q * 8) = kt8[q].u; *(uint4*)(hgx + 8192 + k * 64 + th * 32 + q * 8) = it8[q].u; }
  if (th == 0) ((float*)(p.ws + W_DL))[(size_t)item * 128 + k] = __expf(last);
  __syncthreads();
}
__device__ void prep_rwkv(const Params& p, int l, int ti, char* smem) {
  const int tid = TID();
  const int tok0 = ti * 32;
  const ChunkInfo ci = chunk_info(tok0 / 64);
  const int seqt0 = seq_tok0(ci.seq);
  const bf16* proj = (const bf16*)(p.ws + W_PROJ);
  const bf16* hn = (const bf16*)(p.ws + W_HN);
  const float* mu = p.in[I_MU] + (size_t)l * CSH;
  const float* shp = (ci.seq >= NB) ? p.in[I_SS] + ((size_t)l * NSB + (ci.seq - NB)) * CSH : nullptr;
  float* tw = (float*)smem;
  float* al = tw + 32 * 64;
  float* hv = al + 32 * 64;
  auto cs = [&](int t, int col) -> float {
    const int tok = tok0 + t;
    const float cur = bf2f(proj[(size_t)tok * NC + O_CP + col]);
    float prev;
    if (tok == seqt0) prev = shp ? shp[col] : 0.f; else prev = bf2f(proj[(size_t)(tok - 1) * NC + O_CP + col]);
    return cur + (prev - cur) * mu[col];
  };
  __syncthreads();
#pragma unroll
  for (int i = 0; i < 8; i++) { const int e = tid + i * 256, t = e / 64, j = e % 64;
    tw[e] = tanhf(cs(t, CP_WLO + j)); al[e] = cs(t, CP_ALO + j); }
  if (l > 0) {
    const int t = tid / 8, jg = (tid % 8) * 4;
    const float* w1 = p.in[I_VW1] + (size_t)(l - 1) * D * 32;
    float a0 = 0, a1 = 0, a2 = 0, a3 = 0;
    const bf16* hr = hn + (size_t)(tok0 + t) * D;
#pragma unroll 8
    for (int d = 0; d < D; d++) { const float hvv = bf2f(hr[d]); const float4 wv = *(const float4*)(w1 + (size_t)d * 32 + jg);
      a0 += hvv * wv.x; a1 += hvv * wv.y; a2 += hvv * wv.z; a3 += hvv * wv.w; }
    hv[t * 32 + jg] = a0; hv[t * 32 + jg + 1] = a1; hv[t * 32 + jg + 2] = a2; hv[t * 32 + jg + 3] = a3;
  }
  __syncthreads();
  const bool act = tid * 4 < CW;
  const int c4 = act ? tid * 4 : 0;
  const float* w2 = p.in[I_W2] + (size_t)l * 64 * CW + c4; const float* a2p = p.in[I_A2] + (size_t)l * 64 * CW + c4;
  const float* vw2 = p.in[I_VW2] + (size_t)(l > 0 ? l - 1 : 0) * 32 * CW + c4;
  float* rww = (float*)(p.ws + W_RWW);
  bf16* rwr = (bf16*)(p.ws + W_RWR); bf16* rwk = (bf16*)(p.ws + W_RWK); bf16* rwa = (bf16*)(p.ws + W_RWA); bf16* rwb = (bf16*)(p.ws + W_RWB);
  bf16* rwv = (bf16*)(p.ws + (l == 0 ? W_RWV0 : W_RWV1)); const bf16* vfirst = (const bf16*)(p.ws + W_RWV0);
  const float4 w0v = *(const float4*)(p.in[I_W0] + (size_t)l * CW + c4), a0v = *(const float4*)(p.in[I_A0] + (size_t)l * CW + c4);
  const float4 kkv = *(const float4*)(p.in[I_KK] + (size_t)l * CW + c4), kav = *(const float4*)(p.in[I_KA] + (size_t)l * CW + c4);
  float4 v0v = make_float4(0.f, 0.f, 0.f, 0.f);
  if (l > 0) v0v = *(const float4*)(p.in[I_V0] + (size_t)(l - 1) * CW + c4);
  const float w0a[4] = {w0v.x, w0v.y, w0v.z, w0v.w}, a0a[4] = {a0v.x, a0v.y, a0v.z, a0v.w}, kka[4] = {kkv.x, kkv.y, kkv.z, kkv.w},
              kaa[4] = {kav.x, kav.y, kav.z, kav.w}, v0a[4] = {v0v.x, v0v.y, v0v.z, v0v.w};
  float mur[4], muk[4], muv[4];
#pragma unroll
  for (int c = 0; c < 4; c++) { mur[c] = mu[CP_R + c4 + c]; muk[c] = mu[CP_K + c4 + c]; muv[c] = mu[CP_V + c4 + c]; }
#pragma unroll 1
  for (int tg = 0; tg < 8; tg++) {
    float aw[4][4], aa[4][4], vm[4][4];
#pragma unroll
    for (int t = 0; t < 4; t++)
#pragma unroll
      for (int c = 0; c < 4; c++) { aw[t][c] = 0.f; aa[t][c] = 0.f; vm[t][c] = 0.f; }
#pragma unroll 4
    for (int j = 0; j < 64; j++) {
      const float4 wv = *(const float4*)(w2 + (size_t)j * CW), av = *(const float4*)(a2p + (size_t)j * CW);
#pragma unroll
      for (int t = 0; t < 4; t++) { const float x = tw[(tg * 4 + t) * 64 + j], y = al[(tg * 4 + t) * 64 + j];
        aw[t][0] += x * wv.x; aw[t][1] += x * wv.y; aw[t][2] += x * wv.z; aw[t][3] += x * wv.w;
        aa[t][0] += y * av.x; aa[t][1] += y * av.y; aa[t][2] += y * av.z; aa[t][3] += y * av.w; }
    }
    if (l > 0) {
#pragma unroll 4
      for (int j = 0; j < 32; j++) { const float4 wv = *(const float4*)(vw2 + (size_t)j * CW);
#pragma unroll
        for (int t = 0; t < 4; t++) { const float hj = hv[(tg * 4 + t) * 32 + j];
          vm[t][0] += hj * wv.x; vm[t][1] += hj * wv.y; vm[t][2] += hj * wv.z; vm[t][3] += hj * wv.w; } }
    }
    float cr[4][4], ck[4][4], cv[4][4], pr[4][4], pk[4][4], pv[4][4], vf[4][4];
#pragma unroll
    for (int t = 0; t < 4; t++) {
      const int tok = tok0 + tg * 4 + t;
      const bf16* cp = proj + (size_t)tok * NC + O_CP + c4;
      ld4(cp + CP_R, cr[t]); ld4(cp + CP_K, ck[t]); ld4(cp + CP_V, cv[t]);
      if (tok == seqt0) {
#pragma unroll
        for (int c = 0; c < 4; c++) { pr[t][c] = shp ? shp[CP_R + c4 + c] : 0.f; pk[t][c] = shp ? shp[CP_K + c4 + c] : 0.f; pv[t][c] = shp ? shp[CP_V + c4 + c] : 0.f; }
      } else { ld4(cp - NC + CP_R, pr[t]); ld4(cp - NC + CP_K, pk[t]); ld4(cp - NC + CP_V, pv[t]); }
      if (l > 0) ld4(vfirst + (size_t)tok * CW + c4, vf[t]);
    }
#pragma unroll
    for (int t = 0; t < 4; t++) {
      const int tok = tok0 + tg * 4 + t;
      float rr[4], kk[4], vv[4], ww[4], a[4], kt[4], bb[4];
      float ss = 0.f;
#pragma unroll
      for (int c = 0; c < 4; c++) {
        rr[c] = cr[t][c] + (pr[t][c] - cr[t][c]) * mur[c];
        const float kx = ck[t][c] + (pk[t][c] - ck[t][c]) * muk[c];
        float vx = cv[t][c] + (pv[t][c] - cv[t][c]) * muv[c];
        const float u = w0a[c] + aw[t][c];
        const float sp = fmaxf(-u, 0.f) + log1pf(__expf(-fabsf(u)));
        ww[c] = __expf(-__expf(-sp - 0.5f));
        a[c] = sigm(a0a[c] + aa[t][c]);
        if (l > 0) vx = vx + (vf[t][c] - vx) * sigm(v0a[c] + vm[t][c]);
        vv[c] = vx;
        kk[c] = kx * kka[c];
        ss += kk[c] * kk[c];
        kt[c] = kx * (1.f + (a[c] - 1.f) * kaa[c]);
      }
      ss = red16(ss);
      const float inv = 1.f / fmaxf(sqrtf(ss), 1e-12f);
#pragma unroll
      for (int c = 0; c < 4; c++) { kk[c] *= inv; bb[c] = kk[c] * a[c]; kk[c] = -kk[c]; }
      if (act) {
        *(float4*)(rww + (size_t)tok * CW + c4) = make_float4(ww[0], ww[1], ww[2], ww[3]);
        V4 o;
#pragma unroll
        for (int c = 0; c < 4; c++) o.s[c] = f2bf(rr[c]);
        *(uint2*)(rwr + (size_t)tok * CW + c4) = o.u;
#pragma unroll
        for (int c = 0; c < 4; c++) o.s[c] = f2bf(kt[c]);
        *(uint2*)(rwk + (size_t)tok * CW + c4) = o.u;
#pragma unroll
        for (int c = 0; c < 4; c++) o.s[c] = f2bf(vv[c]);
        *(uint2*)(rwv + (size_t)tok * CW + c4) = o.u;
#pragma unroll
        for (int c = 0; c < 4; c++) o.s[c] = f2bf(kk[c]);
        *(uint2*)(rwa + (size_t)tok * CW + c4) = o.u;
#pragma unroll
        for (int c = 0; c < 4; c++) o.s[c] = f2bf(bb[c]);
        *(uint2*)(rwb + (size_t)tok * CW + c4) = o.u;
      }
    }
  }
  __syncthreads();
}
__device__ void phase_prep(const Params& p, int l, char* smem) {
#ifndef SUBMASK
#define SUBMASK 15
#endif
  if (SUBMASK & 1) for (int gc = BID(); gc < NCHK; gc += gridDim.x) prep_attn_chunk(p, l, gc, smem);
  if (SUBMASK & 2) for (int it = BID(); it < NSB * AH * (PAST / 64); it += gridDim.x) prep_past_tile(p, l, it, smem);
  if (SUBMASK & 4) for (int it = BID(); it < NCHK * BH; it += gridDim.x) prep_hgrn(p, l, it, smem);
  if (SUBMASK & 8) for (int ti = BID(); ti < M / 32; ti += gridDim.x) prep_rwkv(p, l, ti, smem);
  const bf16* proj = (const bf16*)(p.ws + W_PROJ);
  for (int i = BID() * blockDim.x + TID(); i < NSEQ * CSH; i += gridDim.x * blockDim.x) {
    const int seq = i / CSH, c = i % CSH; const int tok = seq_tok0(seq) + seq_len(seq) - 1;
    const float v = bf2f(proj[(size_t)tok * NC + O_CP + c]);
    if (seq < NB) p.out[OO_SP + ((size_t)l * NB + seq) * CSH + c] = v; else p.out[OO_SS + ((size_t)l * NSB + (seq - NB)) * CSH + c] = v;
  }
}

constexpr int KLD = 136, VLD = 72;
__device__ void attn_item(const Params& p, int l, int gc, int h, float lam, float lam_init, char* smem) {
  const int tid = TID(), lane = tid % 64, w = tid / 64, rh = w / 2, n = w % 2, lr = lane % 32, lh = lane / 32;
  const ChunkInfo ci = chunk_info(gc);
  bf16* proj = (bf16*)(p.ws + W_PROJ);
  const bool samp = ci.seq >= NB; const int sb = ci.seq - NB;
  const bf16* Kg; size_t ldk; const bf16* Vg; size_t ldv; int ntiles;
  if (!samp) { Kg = proj + (size_t)(ci.seq * T) * NC + O_AK + h * 128; ldk = NC; Vg = (const bf16*)(p.ws + W_VTP) + (size_t)(ci.seq * AH + h) * 128 * T; ldv = T; ntiles = ci.lc + 1; }
  else { Kg = (const bf16*)(p.ws + W_KBS) + (size_t)(sb * AH + h) * KS * 128; ldk = 128; Vg = (const bf16*)(p.ws + W_VTS) + (size_t)(sb * AH + h) * 128 * KS; ldv = KS; ntiles = PAST / 64 + ci.lc + 1; }
  constexpr int ASTAGE = 64 * KLD + 128 * VLD;
  bf16* sbase = (bf16*)smem;
  bf16x8 qf[4];
  { const bf16* qp = proj + (size_t)(ci.tok0 + rh * 32 + lr) * NC + O_AQ + h * 128 + n * 64 + lh * 8;
#pragma unroll
    for (int ks = 0; ks < 4; ks++) qf[ks] = ldfrag16(qp + ks * 16); }
  f32x16 o[4];
#pragma unroll
  for (int i = 0; i < 4; i++) o[i] = zero16();
  float mrun = -1e30f, lrun = 0.f;
  const int kr0 = tid / 16, kc8 = (tid % 16) * 8, vr0 = tid / 8, vc8 = (tid % 8) * 8;
  const bf16* Kp = Kg + (size_t)kr0 * ldk + kc8;
  const bf16* Vp = Vg + (size_t)vr0 * ldv + vc8;
  typedef unsigned int u32x4 __attribute__((ext_vector_type(4)));
  u32x4 rk0, rk1, rk2, rk3, rv0, rv1, rv2, rv3;
  __syncthreads();
  rk0 = *(const u32x4*)(Kp); rk1 = *(const u32x4*)(Kp + (size_t)16 * ldk); rk2 = *(const u32x4*)(Kp + (size_t)32 * ldk); rk3 = *(const u32x4*)(Kp + (size_t)48 * ldk);
  rv0 = *(const u32x4*)(Vp); rv1 = *(const u32x4*)(Vp + (size_t)32 * ldv); rv2 = *(const u32x4*)(Vp + (size_t)64 * ldv); rv3 = *(const u32x4*)(Vp + (size_t)96 * ldv);
  *(u32x4*)(sbase + (kr0) * KLD + kc8) = rk0; *(u32x4*)(sbase + (kr0 + 16) * KLD + kc8) = rk1; *(u32x4*)(sbase + (kr0 + 32) * KLD + kc8) = rk2; *(u32x4*)(sbase + (kr0 + 48) * KLD + kc8) = rk3;
  *(u32x4*)(sbase + 64 * KLD + (vr0) * VLD + vc8) = rv0; *(u32x4*)(sbase + 64 * KLD + (vr0 + 32) * VLD + vc8) = rv1;
  *(u32x4*)(sbase + 64 * KLD + (vr0 + 64) * VLD + vc8) = rv2; *(u32x4*)(sbase + 64 * KLD + (vr0 + 96) * VLD + vc8) = rv3;
  __syncthreads();
  for (int j = 0; j < ntiles; j++) {
    const bf16* sK = sbase + (j & 1) * ASTAGE; const bf16* sV = sK + 64 * KLD;
    bf16* nK = sbase + ((j & 1) ^ 1) * ASTAGE; bf16* nV = nK + 64 * KLD;
    const bool more = j + 1 < ntiles;
    if (more) {
      const bf16* kq = Kp + (size_t)((j + 1) * 64) * ldk;
      rk0 = *(const u32x4*)(kq); rk1 = *(const u32x4*)(kq + (size_t)16 * ldk); rk2 = *(const u32x4*)(kq + (size_t)32 * ldk); rk3 = *(const u32x4*)(kq + (size_t)48 * ldk);
    }
    f32x16 s[2];
#pragma unroll
    for (int mt = 0; mt < 2; mt++) { s[mt] = zero16();
#pragma unroll
      for (int ks = 0; ks < 4; ks++) s[mt] = MFMA32(ldfrag16(sK + (mt * 32 + lr) * KLD + n * 64 + ks * 16 + lh * 8), qf[ks], s[mt]); }
    SCHED_BARRIER();
    if (more) {
      *(u32x4*)(nK + (kr0) * KLD + kc8) = rk0; *(u32x4*)(nK + (kr0 + 16) * KLD + kc8) = rk1; *(u32x4*)(nK + (kr0 + 32) * KLD + kc8) = rk2; *(u32x4*)(nK + (kr0 + 48) * KLD + kc8) = rk3;
      const bf16* vq = Vp + (j + 1) * 64;
      rv0 = *(const u32x4*)(vq); rv1 = *(const u32x4*)(vq + (size_t)32 * ldv); rv2 = *(const u32x4*)(vq + (size_t)64 * ldv); rv3 = *(const u32x4*)(vq + (size_t)96 * ldv);
    }
    float mx = -1e30f;
#pragma unroll
    for (int mt = 0; mt < 2; mt++)
#pragma unroll
      for (int r = 0; r < 16; r++) mx = fmaxf(mx, s[mt][r]);
    mx = fmaxf(mx, __shfl_xor(mx, 32));
    const float mnew = fmaxf(mrun, mx);
    const float alpha = EXP2(mrun - mnew);
    float rs = 0.f;
#pragma unroll
    for (int mt = 0; mt < 2; mt++)
#pragma unroll
      for (int r = 0; r < 16; r++) { const float e = EXP2(s[mt][r] - mnew); s[mt][r] = e; rs += e; }
    rs += __shfl_xor(rs, 32);
    lrun = lrun * alpha + rs; mrun = mnew;
    if (__any(alpha != 1.0f)) {
#pragma unroll
      for (int i = 0; i < 4; i++)
#pragma unroll
        for (int r = 0; r < 16; r++) o[i][r] *= alpha;
    }
    bf16x8 pf[2][2];
#pragma unroll
    for (int mt = 0; mt < 2; mt++)
#pragma unroll
      for (int s2 = 0; s2 < 2; s2++) pf[mt][s2] = pack8(s[mt], s2);
    SCHED_BARRIER();
#pragma unroll
    for (int mt = 0; mt < 2; mt++)
#pragma unroll
      for (int s2 = 0; s2 < 2; s2++) {
#pragma unroll
        for (int dt = 0; dt < 4; dt++) {
          const bf16* vp = sV + (dt * 32 + lr) * VLD + mt * 32 + 16 * s2 + 4 * lh;
          o[dt] = MFMA32(ldfrag8x2(vp, vp + 8), pf[mt][s2], o[dt]);
        }
      }
    SCHED_BARRIER();
    if (more) {
      *(u32x4*)(nV + (vr0) * VLD + vc8) = rv0; *(u32x4*)(nV + (vr0 + 32) * VLD + vc8) = rv1; *(u32x4*)(nV + (vr0 + 64) * VLD + vc8) = rv2; *(u32x4*)(nV + (vr0 + 96) * VLD + vc8) = rv3;
    }
    __syncthreads();
  }
  __syncthreads();
  float* comb = (float*)smem;
  const float invl = 1.f / lrun;
  if (n == 1) {
#pragma unroll
    for (int dt = 0; dt < 4; dt++)
#pragma unroll
      for (int r = 0; r < 16; r++) comb[(rh * 32 + lr) * 129 + dt * 32 + crow(r, lh)] = o[dt][r] * invl;
  }
  __syncthreads();
  if (n == 0) {
    float ss = 0.f;
#pragma unroll
    for (int dt = 0; dt < 4; dt++)
#pragma unroll
      for (int r = 0; r < 16; r++) { const float v = o[dt][r] * invl - lam * comb[(rh * 32 + lr) * 129 + dt * 32 + crow(r, lh)]; o[dt][r] = v; ss += v * v; }
    ss += __shfl_xor(ss, 32);
    const float rstd = rsqrtf(ss / 128.f + EPS) * (1.f - lam_init);
    const float* sg = p.in[I_SUBG] + l * 128;
    const int tok = ci.tok0 + rh * 32 + lr;
#pragma unroll
    for (int dt = 0; dt < 4; dt++)
#pragma unroll
      for (int g = 0; g < 4; g++) {
        const int dv = dt * 32 + 8 * g + 4 * lh;
        float gate[4]; ld4(proj + (size_t)tok * NC + O_AG + h * 128 + dv, gate);
        V4 ov;
#pragma unroll
        for (int r = 0; r < 4; r++) ov.s[r] = f2bf(o[dt][4 * g + r] * rstd * sg[dv + r] * siluf(gate[r]));
        *(uint2*)(proj + (size_t)tok * NC + O_AQ + h * 128 + dv) = ov.u;
      }
  }
  __syncthreads();
}

constexpr int HLD = 136, TLD = 72;
__device__ void hgrn_item(const Params& p, int l, int seq, int h, char* smem) {
  const int tid = TID(), lane = tid % 64, w = tid / 64, lr = lane % 32, lh = lane / 32;
  bf16* proj = (bf16*)(p.ws + W_PROJ);
  const int nch = seq < NB ? PCH : SCH;
  const int gc0 = seq < NB ? seq * PCH : NB * PCH + (seq - NB) * SCH;
  bf16* X0 = (bf16*)smem;
  bf16* X1 = X0 + 9216;
  float* red = (float*)(X1 + 9216);
  f32x16 S[4];
  if (seq < NB) {
#pragma unroll
    for (int kt = 0; kt < 4; kt++) S[kt] = zero16();
  } else {
    const float* s0 = p.in[I_SH] + (((size_t)l * NSB + (seq - NB)) * BH + h) * 16384;
#pragma unroll
    for (int kt = 0; kt < 4; kt++) {
      const float* sp = s0 + (size_t)(kt * 32 + 4 * lh) * 128 + w * 32 + lr;
#pragma unroll
      for (int r = 0; r < 16; r++) S[kt][r] = sp[((r & 3) + 8 * (r >> 2)) * 128];
      SCHED_BARRIER();
    }
  }
  const float* ng = p.in[I_BNG] + l * 128;
  for (int c = 0; c < nch; c++) {
    const int gc = gc0 + c, tok0 = gc * 64;
    const size_t item = (size_t)gc * BH + h;
    const bf16* hgx = (const bf16*)(p.ws + W_HGX) + item * 2 * 8192;
    const float* dl = (const float*)(p.ws + W_DL) + item * 128;
    __syncthreads();
    for (int i = 0; i < 4; i++) { const int cc = tid + i * 256, r = cc / 16, c8 = (cc % 16) * 8;
      *(uint4*)(X0 + r * HLD + c8) = *(const uint4*)(proj + (size_t)(tok0 + r) * NC + O_BF + h * 128 + c8);
      *(uint4*)(X1 + r * HLD + c8) = *(const uint4*)(proj + (size_t)(tok0 + r) * NC + O_BQ + h * 128 + c8); }
    __syncthreads();
    f32x16 x00 = zero16(), x01 = zero16(), x11 = zero16();
#pragma unroll
    for (int ks = 0; ks < 8; ks++) {
      const bf16x8 b0 = ldfrag16(X0 + (lr) * HLD + ks * 16 + lh * 8), b1 = ldfrag16(X0 + (32 + lr) * HLD + ks * 16 + lh * 8);
      const bf16x8 a0 = ldfrag16(X1 + (lr) * HLD + ks * 16 + lh * 8), a1 = ldfrag16(X1 + (32 + lr) * HLD + ks * 16 + lh * 8);
      x00 = MFMA32(b0, a0, x00); x01 = MFMA32(b0, a1, x01); x11 = MFMA32(b1, a1, x11);
      if (ks & 1) SCHED_BARRIER();
    }
#pragma unroll
    for (int r = 0; r < 16; r++) { if (crow(r, lh) > lr) { x00[r] = 0.f; x11[r] = 0.f; } }
    bf16x8 xp00[2], xp01[2], xp11[2];
#pragma unroll
    for (int s2 = 0; s2 < 2; s2++) { xp00[s2] = pack8(x00, s2); xp01[s2] = pack8(x01, s2); xp11[s2] = pack8(x11, s2); }
    SCHED_BARRIER();
    bf16x8 itf[2][2];
#pragma unroll
    for (int st = 0; st < 2; st++)
#pragma unroll
      for (int s2 = 0; s2 < 2; s2++) { const bf16* ip = hgx + 8192 + (size_t)(w * 32 + lr) * 64 + st * 32 + 16 * s2 + 4 * lh; itf[st][s2] = ldfrag8x2(ip, ip + 8); }
    __syncthreads();
    for (int i = 0; i < 4; i++) { const int cc = tid + i * 256;
      { const int r = cc / 16, c8 = (cc % 16) * 8; *(uint4*)(X0 + r * HLD + c8) = *(const uint4*)(proj + (size_t)(tok0 + r) * NC + O_BI + h * 128 + c8); }
      { const int r = cc / 8, c8 = (cc % 8) * 8; *(uint4*)(X1 + r * TLD + c8) = *(const uint4*)(hgx + (size_t)r * 64 + c8); } }
    __syncthreads();
    f32x16 o0 = zero16(), o1 = zero16();
#pragma unroll
    for (int s2 = 0; s2 < 2; s2++) {
      o0 = MFMA32(itf[0][s2], xp00[s2], o0);
      o1 = MFMA32(itf[0][s2], xp01[s2], o1);
      o1 = MFMA32(itf[1][s2], xp11[s2], o1);
    }
    SCHED_BARRIER();
#pragma unroll
    for (int kt = 0; kt < 4; kt++)
#pragma unroll
      for (int s2 = 0; s2 < 2; s2++) {
        const bf16x8 sp = pack8(S[kt], s2);
        const bf16* q0 = X0 + (lr) * HLD + kt * 32 + 16 * s2 + 4 * lh; const bf16* q1 = X0 + (32 + lr) * HLD + kt * 32 + 16 * s2 + 4 * lh;
        o0 = MFMA32(sp, ldfrag8x2(q0, q0 + 8), o0);
        o1 = MFMA32(sp, ldfrag8x2(q1, q1 + 8), o1);
        if (s2) SCHED_BARRIER();
      }
    SCHED_BARRIER();
#pragma unroll
    for (int kt = 0; kt < 4; kt++) {
      SCHED_BARRIER();
#pragma unroll
      for (int g = 0; g < 4; g++) { const float4 dv = *(const float4*)(dl + kt * 32 + 8 * g + 4 * lh);
        S[kt][4 * g] *= dv.x; S[kt][4 * g + 1] *= dv.y; S[kt][4 * g + 2] *= dv.z; S[kt][4 * g + 3] *= dv.w; }
#pragma unroll
      for (int st = 0; st < 2; st++)
#pragma unroll
        for (int s2 = 0; s2 < 2; s2++) { const bf16* kp = X1 + (kt * 32 + lr) * TLD + st * 32 + 16 * s2 + 4 * lh;
          S[kt] = MFMA32(ldfrag8x2(kp, kp + 8), itf[st][s2], S[kt]); }
    }
    SCHED_BARRIER();
    float ss0 = 0.f, ss1 = 0.f;
#pragma unroll
    for (int r = 0; r < 16; r++) { ss0 += o0[r] * o0[r]; ss1 += o1[r] * o1[r]; }
    ss0 += __shfl_xor(ss0, 32); ss1 += __shfl_xor(ss1, 32);
    if (lh == 0) { red[w * 64 + lr] = ss0; red[w * 64 + 32 + lr] = ss1; }
    __syncthreads();
#pragma unroll
    for (int tt = 0; tt < 2; tt++) {
      const int t = tt * 32 + lr;
      const float tot = red[t] + red[64 + t] + red[128 + t] + red[192 + t];
      const float rstd = rsqrtf(tot / 128.f + EPS);
      const int tok = tok0 + t;
#pragma unroll
      for (int g = 0; g < 4; g++) {
        const int v = w * 32 + 8 * g + 4 * lh;
        float gate[4]; ld4(proj + (size_t)tok * NC + O_BG + h * 128 + v, gate);
        V4 ov;
#pragma unroll
        for (int r = 0; r < 4; r++) { const float ovv = (tt == 0 ? o0[4 * g + r] : o1[4 * g + r]); ov.s[r] = f2bf(ovv * rstd * ng[v + r] * siluf(gate[r])); }
        *(uint2*)(proj + (size_t)tok * NC + O_BQ + h * 128 + v) = ov.u;
      }
    }
  }
  float* so = p.out + (seq < NB ? OO_HP + (((size_t)l * NB + seq) * BH + h) * 16384 : OO_HS + (((size_t)l * NSB + (seq - NB)) * BH + h) * 16384);
#pragma unroll
  for (int kt = 0; kt < 4; kt++) {
    float* sp = so + (size_t)(kt * 32 + 4 * lh) * 128 + w * 32 + lr;
#pragma unroll
    for (int r = 0; r < 16; r++) sp[((r & 3) + 8 * (r >> 2)) * 128] = S[kt][r];
    SCHED_BARRIER();
  }
  __syncthreads();
}

__device__ void rwkv_item(const Params& p, int l, int seq, int h, char* smem) {
  const int tid = TID(), ri = tid / 4, sub = tid % 4;
  bf16* proj = (bf16*)(p.ws + W_PROJ);
  const float* rww = (const float*)(p.ws + W_RWW);
  const bf16* rwr = (const bf16*)(p.ws + W_RWR); const bf16* rwk = (const bf16*)(p.ws + W_RWK); const bf16* rwa = (const bf16*)(p.ws + W_RWA);
  const bf16* rwb = (const bf16*)(p.ws + W_RWB); const bf16* rwv = (const bf16*)(p.ws + (l == 0 ? W_RWV0 : W_RWV1));
  float* sw = (float*)smem; float* sr = sw + 2048; float* sk = sr + 2048; float* sv = sk + 2048; float* sa = sv + 2048; float* sbb = sa + 2048; float* sy = sbb + 2048;
  const int len = seq_len(seq), t0 = seq_tok0(seq);
  float S[16];
  if (seq < NB) {
#pragma unroll
    for (int j = 0; j < 16; j++) S[j] = 0.f;
  } else {
    const float* s0 = p.in[I_SR] + ((((size_t)l * NSB + (seq - NB)) * CH + h) * 64 + ri) * 64 + sub * 16;
#pragma unroll
    for (int j = 0; j < 16; j++) S[j] = s0[j];
  }
  const float* lnw = p.in[I_LNW] + (size_t)l * CW + h * 64; const float* lnb = p.in[I_LNB] + (size_t)l * CW + h * 64;
  const float* rk = p.in[I_RK] + (size_t)l * CW + h * 64;
  const int st = tid / 8, sc8 = (tid % 8) * 8;
  typedef unsigned int u32x4 __attribute__((ext_vector_type(4)));
  typedef float f32x4v __attribute__((ext_vector_type(4)));
  f32x4v pw0, pw1; u32x4 pr_, pk_, pv_, pa_, pb_;
  { const size_t g = (size_t)(t0 + st) * CW + h * 64 + sc8;
    pw0 = *(const f32x4v*)(rww + g); pw1 = *(const f32x4v*)(rww + g + 4);
    pr_ = *(const u32x4*)(rwr + g); pk_ = *(const u32x4*)(rwk + g); pv_ = *(const u32x4*)(rwv + g); pa_ = *(const u32x4*)(rwa + g); pb_ = *(const u32x4*)(rwb + g); }
  for (int tb = 0; tb < len; tb += 32) {
    __syncthreads();
    { float* d = sw + st * 64 + sc8; *(f32x4v*)d = pw0; *(f32x4v*)(d + 4) = pw1;
#define UNPK(dst, v) { float* q = dst + st * 64 + sc8; _Pragma("unroll") for (int i = 0; i < 4; i++) { q[2 * i] = __uint_as_float(v[i] << 16); q[2 * i + 1] = __uint_as_float(v[i] & 0xffff0000u); } }
      UNPK(sr, pr_) UNPK(sk, pk_) UNPK(sv, pv_) UNPK(sa, pa_) UNPK(sbb, pb_)
    }
    __syncthreads();
    if (tb + 32 < len) { const size_t g = (size_t)(t0 + tb + 32 + st) * CW + h * 64 + sc8;
      pw0 = *(const f32x4v*)(rww + g); pw1 = *(const f32x4v*)(rww + g + 4);
      pr_ = *(const u32x4*)(rwr + g); pk_ = *(const u32x4*)(rwk + g); pv_ = *(const u32x4*)(rwv + g); pa_ = *(const u32x4*)(rwa + g); pb_ = *(const u32x4*)(rwb + g); }
#pragma unroll 2
    for (int t = 0; t < 32; t++) {
      const float* pa = sa + t * 64 + sub * 16; const float* pw = sw + t * 64 + sub * 16; const float* pb = sbb + t * 64 + sub * 16;
      const float* pk = sk + t * 64 + sub * 16; const float* pr = sr + t * 64 + sub * 16;
      float dot = 0.f, dotb = 0.f;
#pragma unroll
      for (int j = 0; j < 8; j++) { dot += S[j] * pa[j]; dotb += S[j + 8] * pa[j + 8]; }
      dot = red4(dot + dotb);
      const float vi = sv[t * 64 + ri];
      float y = 0.f, yb = 0.f;
#pragma unroll
      for (int j = 0; j < 8; j++) { S[j] = S[j] * pw[j] + dot * pb[j] + vi * pk[j]; y += S[j] * pr[j];
                                    S[j + 8] = S[j + 8] * pw[j + 8] + dot * pb[j + 8] + vi * pk[j + 8]; yb += S[j + 8] * pr[j + 8]; }
      y = red4(y + yb);
      if (sub == 0) sy[t * 64 + ri] = y;
    }
    __syncthreads();
    {
      const int t = tid / 8, c8 = (tid % 8) * 8; const int tok = t0 + tb + t;
      float y[8]; float s1 = 0.f, bon = 0.f;
#pragma unroll
      for (int i = 0; i < 8; i++) { y[i] = sy[t * 64 + c8 + i]; s1 += y[i]; bon += sr[t * 64 + c8 + i] * sk[t * 64 + c8 + i] * rk[c8 + i]; }
      s1 = red8(s1); bon = red8(bon);
      const float mu = s1 / 64.f; float s2 = 0.f;
#pragma unroll
      for (int i = 0; i < 8; i++) { const float d = y[i] - mu; s2 += d * d; }
      s2 = red8(s2);
      const float rstd = rsqrtf(s2 / 64.f + 64e-5f);
      float gate[8]; ld8(proj + (size_t)tok * NC + O_CG + h * 64 + c8, gate);
      V8 ov;
#pragma unroll
      for (int i = 0; i < 8; i++) { const float o = (y[i] - mu) * rstd * lnw[c8 + i] + lnb[c8 + i] + bon * sv[t * 64 + c8 + i]; ov.s[i] = f2bf(o * siluf(gate[i])); }
      *(uint4*)(proj + (size_t)tok * NC + O_CP + h * 64 + c8) = ov.u;
    }
  }
  float* so = p.out + (seq < NB ? OO_RP + ((((size_t)l * NB + seq) * CH + h) * 64 + ri) * 64 : OO_RS + ((((size_t)l * NSB + (seq - NB)) * CH + h) * 64 + ri) * 64) + sub * 16;
#pragma unroll
  for (int j = 0; j < 16; j++) so[j] = S[j];
  __syncthreads();
}

__device__ void phase_mixers(const Params& p, int l, char* smem) {
  __shared__ int s_item;
  int* cnt = (int*)(p.ws + W_CNT) + l;
  const float* lp = p.in[I_LAM] + (size_t)l * 256;
  float d1 = 0.f, d2 = 0.f;
  for (int i = 0; i < 64; i++) { d1 += lp[i] * lp[64 + i]; d2 += lp[128 + i] * lp[192 + i]; }
  const float lam_init = 0.8f - 0.6f * expf(-0.3f * (float)l);
  const float lam = expf(d1) - expf(d2) + lam_init;
  constexpr int N_RWP = NB * CH, N_HGP = NB * BH, N_ATP = NB * PCH * AH, N_RWS = NSB * CH, N_HGS = NSB * BH, N_ATS = NSB * SCH * AH;
  constexpr int NTOT = N_RWP + N_HGP + N_ATP + N_RWS + N_HGS + N_ATS;
  for (;;) {
    __syncthreads();
    if (TID() == 0) s_item = atomicAdd(cnt, 1);
    __syncthreads();
    int it = s_item;
    if (it >= NTOT) break;
    if (it < N_RWP) { SETPRIO(3); if (SUBMASK & 1) rwkv_item(p, l, it / CH, it % CH, smem); SETPRIO(0); continue; }
    it -= N_RWP;
    if (it < N_HGP) { SETPRIO(2); if (SUBMASK & 2) hgrn_item(p, l, it / BH, it % BH, smem); SETPRIO(0); continue; }
    it -= N_HGP;
    if (it < N_ATP) {
      const int lc = PCH - 1 - it / (NB * AH), r = it % (NB * AH); if (SUBMASK & 4) attn_item(p, l, (r / AH) * PCH + lc, r % AH, lam, lam_init, smem); continue; }
    it -= N_ATP;
    if (it < N_RWS) { if (SUBMASK & 1) rwkv_item(p, l, NB + it / CH, it % CH, smem); continue; }
    it -= N_RWS;
    if (it < N_HGS) { if (SUBMASK & 2) hgrn_item(p, l, NB + it / BH, it % BH, smem); continue; }
    it -= N_HGS;
    { const int gc = NB * PCH + it / AH; if (SUBMASK & 4) attn_item(p, l, gc, it % AH, lam, lam_init, smem); }
  }
}

constexpr int SMEM_BYTES = 73728;
#ifdef EMU
__device__ void run_phase(const Params& p, int ph, char* smem) {
  const int l = ph / 6, s = ph % 6;
  switch (s) {
#ifndef PHMASK
#define PHMASK 63
#endif
    case 0: if (PHMASK & 1) { if (l == 0) phase_wprep(p, smem); phase_rmsnorm(p, l); } break;
    case 1: if (PHMASK & 2) phase_proj(p, l, smem); break;
    case 2: if (PHMASK & 4) phase_prep(p, l, smem); break;
    case 3: if (PHMASK & 8) phase_mixers(p, l, smem); break;
    case 4: if (PHMASK & 16) phase_merge(p, l, smem); break;
    case 5: if (PHMASK & 32) phase_yout(p, l, smem); break;
  }
}
#endif
#ifndef EMU
__global__ void __launch_bounds__(256, 2) mega(Params p) {
  __shared__ __attribute__((aligned(16))) char smem[SMEM_BYTES];
  cg::grid_group grid = cg::this_grid();
  phase_wprep(p, smem);
#ifdef PROBE
  long long tmix = 0, tproj = 0;
#endif
#pragma unroll 1
  for (int l = 0; l < DEPTH; l++) {
    phase_rmsnorm(p, l); grid.sync();
#ifdef PROBE
    long long t0 = wall_clock64();
#endif
    phase_proj(p, l, smem); grid.sync();
#ifdef PROBE
    if (l == 0) tproj = wall_clock64() - t0;
#endif
    phase_prep(p, l, smem); grid.sync();
#ifdef PROBE
    t0 = wall_clock64();
#endif
    phase_mixers(p, l, smem); grid.sync();
#ifdef PROBE
    if (l == 0) tmix = wall_clock64() - t0;
#endif
    phase_merge(p, l, smem); grid.sync();
    phase_yout(p, l, smem); grid.sync();
  }
#ifdef PROBE
  long long* pr = (long long*)(p.ws + W_CNT + 64);
  if (blockIdx.x == 0 && threadIdx.x == 0) { pr[0] = tmix; pr[1] = tproj; }
  grid.sync();
  { const long long a = pr[0], b = pr[1];
    const long long q = (b + 25000) / 50000;
    const long long delay = a + 2000000LL * q + 40000000LL * (p.percu - 1);
    const long long te = wall_clock64() + delay;
    while (wall_clock64() < te) __builtin_amdgcn_s_sleep(20);
  }
#endif
}
extern "C" void kernel_launch(void* const* d_in, const int* in_sizes, int n_in, void* d_out, int out_size, void* d_ws, size_t ws_size, hipStream_t stream) {
  Params p{};
  for (int i = 0; i < 32; i++) p.in[i] = (const float*)d_in[i];
  p.out = (float*)d_out; p.ws = (char*)d_ws;
  if (ws_size < WS_TOTAL) { fprintf(stderr, "workspace too small: %zu < %zu\n", ws_size, (size_t)WS_TOTAL); return; }
  hipMemsetAsync((char*)d_ws + W_CNT, 0, 256, stream);
  static int grid_blocks = 0;
  if (!grid_blocks) {
    int dev = 0, cus = 0, per_cu = 0;
    hipGetDevice(&dev);
    hipDeviceGetAttribute(&cus, hipDeviceAttributeMultiprocessorCount, dev);
    hipOccupancyMaxActiveBlocksPerMultiprocessor(&per_cu, mega, 256, 0);
    if (per_cu > 2) per_cu = 2;
    grid_blocks = cus * per_cu;
  }
#ifdef PROBE
  p.percu = grid_blocks / 256;
#endif
  void* args[] = { &p };
  hipError_t e = hipLaunchCooperativeKernel((void*)mega, dim3(grid_blocks), dim3(256), args, 0, stream);
  if (e != hipSuccess) fprintf(stderr, "cooperative launch failed: %s (grid %d)\n", hipGetErrorString(e), grid_blocks);
}
#endif
```

```cpp
#ifdef EMU
#include "emu.h"
#define MFMA32(a, b, c) emu_mfma32(a, b, c)
#else
#include <hip/hip_runtime.h>
#include <hip/hip_cooperative_groups.h>
#include <cstdio>
namespace cg = cooperative_groups;
typedef short bf16x8 __attribute__((ext_vector_type(8)));
typedef float f32x16 __attribute__((ext_vector_type(16)));
#define MFMA32(a, b, c) __builtin_amdgcn_mfma_f32_32x32x16_bf16(a, b, c, 0, 0, 0)
#endif

#ifdef EMU
#define TID() ((int)threadIdx.x)
#define BID() ((int)blockIdx.x)
#else
static __device__ __forceinline__ int TID() { int t = threadIdx.x; asm volatile("" : "+v"(t)); return t; }
static __device__ __forceinline__ int BID() { int t = blockIdx.x; asm volatile("" : "+s"(t)); return t; }
#endif
#define DI __device__ __forceinline__
#if defined(__HIP_DEVICE_COMPILE__)
#define SETPRIO(n) __builtin_amdgcn_s_setprio(n)
#else
#define SETPRIO(n)
#endif
#ifdef EMU
#define DPP_XOR1(x) emu_lane_perm(x, 0)
#define DPP_XOR2(x) emu_lane_perm(x, 1)
#define DPP_HMIR(x) emu_lane_perm(x, 2)
#define DPP_RMIR(x) emu_lane_perm(x, 3)
#else
#define DPP_F(x, c) __builtin_bit_cast(float, __builtin_amdgcn_update_dpp(0, __builtin_bit_cast(int, (float)(x)), c, 0xF, 0xF, true))
#define DPP_XOR1(x) DPP_F(x, 0xB1)
#define DPP_XOR2(x) DPP_F(x, 0x4E)
#define DPP_HMIR(x) DPP_F(x, 0x141)
#define DPP_RMIR(x) DPP_F(x, 0x140)
#endif
#ifdef EMU
#define EXP2(x) exp2f(x)
#else
#define EXP2(x) __builtin_amdgcn_exp2f(x)
#endif
#ifdef EMU
#define SCHED_BARRIER()
#else
#define SCHED_BARRIER() __builtin_amdgcn_sched_barrier(0)
#endif
typedef unsigned short bf16;

#ifdef SMALL
constexpr int D = 128, NB = 2, T = 256, NSB = 2, TS = 64, PAST = 128, AH = 2, BH = 1, CH = 2;
#else
constexpr int D = 1024, NB = 8, T = 8192, NSB = 16, TS = 64, PAST = 1024, AH = 8, BH = 8, CH = 16;
#endif
constexpr int DEPTH = 2;
constexpr int AQK = AH * 128, AW = AH * 128, BQK = BH * 128, BW = BH * 128, CW = CH * 64;
constexpr int CSH = 3 * CW + 128;
constexpr int O_AQ = 0, O_AK = AQK, O_AV = 2 * AQK, O_AG = O_AV + AW, O_BQ = O_AG + AW, O_BF = O_BQ + BQK, O_BI = O_BF + BQK,
              O_BG = O_BI + BW, O_CP = O_BG + BW, O_CG = O_CP + CSH, O_MA = O_CG + CW, O_MB = O_MA + D, O_MC = O_MB + D, NC = O_MC + D;
constexpr int CP_R = 0, CP_WLO = CW, CP_K = CW + 64, CP_V = 2 * CW + 64, CP_ALO = 3 * CW + 64;
constexpr int MP = NB * T, MS = NSB * TS, M = MP + MS, NSEQ = NB + NSB, KS = PAST + TS;
constexpr int NCHK = M / 64, PCH = T / 64, SCH = TS / 64;
constexpr int MAXPOS = (T > KS ? T : KS);
constexpr float EPS = 1e-6f;

constexpr size_t OO_Y = 0;
constexpr size_t OO_KP = (size_t)M * D;
constexpr size_t OO_VP = OO_KP + (size_t)DEPTH * MP * AQK;
constexpr size_t OO_HP = OO_VP + (size_t)DEPTH * MP * AW;
constexpr size_t OO_RP = OO_HP + (size_t)DEPTH * NB * BH * 16384;
constexpr size_t OO_SP = OO_RP + (size_t)DEPTH * NB * CH * 4096;
constexpr size_t OO_KS = OO_SP + (size_t)DEPTH * NB * CSH;
constexpr size_t OO_VS = OO_KS + (size_t)DEPTH * MS * AQK;
constexpr size_t OO_HS = OO_VS + (size_t)DEPTH * MS * AW;
constexpr size_t OO_RS = OO_HS + (size_t)DEPTH * NSB * BH * 16384;
constexpr size_t OO_SS = OO_RS + (size_t)DEPTH * NSB * CH * 4096;
constexpr size_t OUT_TOTAL = OO_SS + (size_t)DEPTH * NSB * CSH;

constexpr size_t al256(size_t x) { return (x + 255) & ~(size_t)255; }
constexpr size_t W_PROJ = 0;
constexpr size_t W_HN = al256(W_PROJ + (size_t)M * NC * 2);
constexpr size_t W_HGX = al256(W_HN + (size_t)M * D * 2);
constexpr size_t W_DL = al256(W_HGX + (size_t)NCHK * BH * 2 * 8192 * 2);
constexpr size_t W_RWW = al256(W_DL + (size_t)NCHK * BH * 128 * 4);
constexpr size_t W_RWR = al256(W_RWW + (size_t)M * CW * 4);
constexpr size_t W_RWK = al256(W_RWR + (size_t)M * CW * 2);
constexpr size_t W_RWA = al256(W_RWK + (size_t)M * CW * 2);
constexpr size_t W_RWB = al256(W_RWA + (size_t)M * CW * 2);
constexpr size_t W_RWV0 = al256(W_RWB + (size_t)M * CW * 2);
constexpr size_t W_RWV1 = al256(W_RWV0 + (size_t)M * CW * 2);
constexpr size_t W_VTP = al256(W_RWV1 + (size_t)M * CW * 2);
constexpr size_t W_KBS = al256(W_VTP + (size_t)NB * AH * 128 * T * 2);
constexpr size_t W_VTS = al256(W_KBS + (size_t)NSB * AH * KS * 128 * 2);
constexpr size_t W_WT = al256(W_VTS + (size_t)NSB * AH * 128 * KS * 2);
constexpr size_t WT_IN = 0, WT_OA = (size_t)NC * D, WT_OB = WT_OA + (size_t)D * AW, WT_OC = WT_OB + (size_t)D * BW, WT_OO = WT_OC + (size_t)D * CW,
                 WT_LAYER = WT_OO + (size_t)D * D;
constexpr size_t W_ROPE = al256(W_WT + (size_t)DEPTH * WT_LAYER * 2);
constexpr size_t W_CNT = al256(W_ROPE + (size_t)MAXPOS * 16 * 4);
constexpr size_t W_W2T = al256(W_CNT + 256);
constexpr size_t W_A2T = al256(W_W2T + (size_t)DEPTH * CW * 64 * 2);
constexpr size_t W_VW2T = al256(W_A2T + (size_t)DEPTH * CW * 64 * 2);
constexpr size_t W_W1T = al256(W_VW2T + (size_t)CW * 32 * 2);
constexpr size_t WS_TOTAL = W_W1T + (size_t)32 * D * 2;

struct Params { const float* in[32]; float* out; char* ws; long long percu; };

enum { I_XP, I_XS, I_CK, I_CV, I_SH, I_SR, I_SS, I_NG, I_WIN, I_QNG, I_KNG, I_LAM, I_SUBG, I_BLOW, I_BNG, I_MU, I_W0, I_W2, I_A0, I_A2,
       I_KK, I_KA, I_RK, I_LNW, I_LNB, I_VW1, I_VW2, I_V0, I_WOA, I_WOB, I_WOC, I_WO };

#ifdef EMU
DI bf16 f2bf(float x) { unsigned u = __float_as_uint(x); u += 0x7fffu + ((u >> 16) & 1u); return (bf16)(u >> 16); }
#else
DI bf16 f2bf(float x) { __bf16 b = (__bf16)x; return __builtin_bit_cast(unsigned short, b); }
#endif
DI float bf2f(bf16 s) { return __uint_as_float(((unsigned)s) << 16); }
DI float sigm(float x) { return 1.0f / (1.0f + __expf(-x)); }
DI float siluf(float x) { return x / (1.0f + __expf(-x)); }
union V8 { bf16x8 v; uint4 u; uint2 h[2]; bf16 s[8]; };
union V4 { uint2 u; bf16 s[4]; };
DI void ld8(const bf16* p, float* o) { V8 t; t.u = *(const uint4*)p;
#pragma unroll
  for (int i = 0; i < 8; i++) o[i] = bf2f(t.s[i]); }
DI void ld4(const bf16* p, float* o) { V4 t; t.u = *(const uint2*)p;
#pragma unroll
  for (int i = 0; i < 4; i++) o[i] = bf2f(t.s[i]); }
DI bf16x8 ldfrag16(const bf16* p) { V8 t; t.u = *(const uint4*)p; return t.v; }
DI bf16x8 ldfrag8x2(const bf16* p0, const bf16* p1) { V8 t; t.h[0] = *(const uint2*)p0; t.h[1] = *(const uint2*)p1; return t.v; }
DI bf16x8 pack8(const f32x16& x, int s) { V8 t;
#pragma unroll
  for (int j = 0; j < 8; j++) t.s[j] = f2bf(x[8 * s + j]); return t.v; }
DI f32x16 zero16() { f32x16 z;
#pragma unroll
  for (int i = 0; i < 16; i++) z[i] = 0.f; return z; }
#ifdef EMU
#define SHFL_XOR(v, m) __shfl_xor(v, m)
#else
static __device__ __forceinline__ float SHFL_XOR(float v, int m) { const int lane = TID() & 63; return __builtin_bit_cast(float, __builtin_amdgcn_ds_bpermute((lane ^ m) << 2, __builtin_bit_cast(int, v))); }
#endif
DI float red4(float x) { x += DPP_XOR1(x); x += DPP_XOR2(x); return x; }
DI float red8(float x) { x = red4(x); x += DPP_HMIR(x); return x; }
DI float red16(float x) { x = red8(x); x += DPP_RMIR(x); return x; }
DI int crow(int reg, int h) { return (reg & 3) + 8 * (reg >> 2) + 4 * h; }

struct ChunkInfo { int seq, lc, tok0, pos0; };
DI ChunkInfo chunk_info(int gc) { ChunkInfo c; c.tok0 = gc * 64;
  if (gc < NB * PCH) { c.seq = gc / PCH; c.lc = gc % PCH; c.pos0 = c.lc * 64; }
  else { int r = gc - NB * PCH; c.seq = NB + r / SCH; c.lc = r % SCH; c.pos0 = PAST + c.lc * 64; }
  return c; }
DI int seq_tok0(int seq) { return seq < NB ? seq * T : MP + (seq - NB) * TS; }
DI int seq_len(int seq) { return seq < NB ? T : TS; }

__device__ void transpose_w(const float* src, bf16* dst, int K, int N, float* tile  ) {
  const int tid = TID(); const int nkt = K / 64, nnt = N / 64;
  for (int t = BID(); t < nkt * nnt; t += gridDim.x) {
    const int k0 = (t / nnt) * 64, n0 = (t % nnt) * 64;
    for (int i = 0; i < 16; i++) { int r = i * 4 + tid / 64, c = tid % 64; tile[r * 65 + c] = src[(size_t)(k0 + r) * N + n0 + c]; }
    __syncthreads();
    for (int i = 0; i < 16; i++) { int n = i * 4 + tid / 64, k = tid % 64; dst[(size_t)(n0 + n) * K + k0 + k] = f2bf(tile[k * 65 + n]); }
    __syncthreads();
  }
}
__device__ void phase_wprep(const Params& p, char* smem) {
  float* tile = (float*)smem;
  for (int l = 0; l < DEPTH; l++) {
    bf16* wt = (bf16*)(p.ws + W_WT) + (size_t)l * WT_LAYER;
    transpose_w(p.in[I_WIN] + (size_t)l * D * NC, wt + WT_IN, D, NC, tile);
    transpose_w(p.in[I_WOA] + (size_t)l * AW * D, wt + WT_OA, AW, D, tile);
    transpose_w(p.in[I_WOB] + (size_t)l * BW * D, wt + WT_OB, BW, D, tile);
    transpose_w(p.in[I_WOC] + (size_t)l * CW * D, wt + WT_OC, CW, D, tile);
    transpose_w(p.in[I_WO] + (size_t)l * D * D, wt + WT_OO, D, D, tile);
  }
  for (int l = 0; l < DEPTH; l++) {
    transpose_w(p.in[I_W2] + (size_t)l * 64 * CW, (bf16*)(p.ws + W_W2T) + (size_t)l * CW * 64, 64, CW, tile);
    transpose_w(p.in[I_A2] + (size_t)l * 64 * CW, (bf16*)(p.ws + W_A2T) + (size_t)l * CW * 64, 64, CW, tile);
  }
  for (int i = BID() * blockDim.x + TID(); i < 32 * CW; i += gridDim.x * blockDim.x) {
    const int k = i / CW, n = i % CW; ((bf16*)(p.ws + W_VW2T))[n * 32 + k] = f2bf(p.in[I_VW2][i]); }
  for (int i = BID() * blockDim.x + TID(); i < D * 32; i += gridDim.x * blockDim.x) {
    const int k = i / 32, n = i % 32; ((bf16*)(p.ws + W_W1T))[(size_t)n * D + k] = f2bf(p.in[I_VW1][i]); }
  float* rope = (float*)(p.ws + W_ROPE);
  for (int i = BID() * blockDim.x + TID(); i < MAXPOS * 8; i += gridDim.x * blockDim.x) {
    int pos = i / 8, j = i % 8;
    double inv = pow(500000.0, -(double)j / 8.0);
    double ang = (double)pos * inv;
    rope[pos * 16 + j] = (float)cos(ang); rope[pos * 16 + 8 + j] = (float)sin(ang);
  }
}

DI const float* x_row(const Params& p, int l, int m) {
  if (l == 0) return m < MP ? p.in[I_XP] + (size_t)m * D : p.in[I_XS] + (size_t)(m - MP) * D;
  return p.out + OO_Y + (size_t)m * D;
}
__device__ void phase_rmsnorm(const Params& p, int l) {
  const int lane = TID() % 64, w = TID() / 64;
  bf16* hn = (bf16*)(p.ws + W_HN);
  const float* g = p.in[I_NG] + (size_t)l * D;
  for (int m = BID() * 4 + w; m < M; m += gridDim.x * 4) {
    const float* x = x_row(p, l, m);
    float ss = 0.f;
    for (int c = lane * 4; c < D; c += 256) { float4 v = *(const float4*)(x + c); ss += v.x * v.x + v.y * v.y + v.z * v.z + v.w * v.w; }
    for (int o = 32; o >= 1; o >>= 1) ss += SHFL_XOR(ss, o);
    const float rs = rsqrtf(ss / D + EPS);
    for (int c = lane * 4; c < D; c += 256) { float4 v = *(const float4*)(x + c); float4 gg = *(const float4*)(g + c);
      V4 o; o.s[0] = f2bf(v.x * rs * gg.x); o.s[1] = f2bf(v.y * rs * gg.y); o.s[2] = f2bf(v.z * rs * gg.z); o.s[3] = f2bf(v.w * rs * gg.w);
      *(uint2*)(hn + (size_t)m * D + c) = o.u; }
  }
}

constexpr int GLD = 40;
constexpr int GSTAGE = 2 * 128 * GLD;
template <int NJ> DI void gemm_mainloop(const bf16* A, size_t lda, const bf16* Bt, size_t ldb, int K, int m0, int n0, bf16* lds, f32x16 acc[2][NJ]) {
  const int tid = TID(), lane = tid % 64, w = tid / 64, wm = w / 2, wn = w % 2, lr = lane % 32, lh = lane / 32;
  const int nk = K / 32;
  typedef unsigned int u32x4 __attribute__((ext_vector_type(4)));
  u32x4 a00, a01, b00, b01, a10, a11, b10, b11;
  const int r0 = tid / 4, kc = (tid % 4) * 8;
  const bf16* Ap = A + (size_t)(m0 + r0) * lda + kc;
  const bf16* Bp = Bt + (size_t)(n0 + r0) * ldb + kc;
  const int so = r0 * GLD + kc;
#define G_LOAD0(kt) { a00 = *(const u32x4*)(Ap + (kt) * 32); a01 = *(const u32x4*)(Ap + (size_t)64 * lda + (kt) * 32); b00 = *(const u32x4*)(Bp + (kt) * 32); if (NJ == 2) b01 = *(const u32x4*)(Bp + (size_t)64 * ldb + (kt) * 32); }
#define G_LOAD1(kt) { a10 = *(const u32x4*)(Ap + (kt) * 32); a11 = *(const u32x4*)(Ap + (size_t)64 * lda + (kt) * 32); b10 = *(const u32x4*)(Bp + (kt) * 32); if (NJ == 2) b11 = *(const u32x4*)(Bp + (size_t)64 * ldb + (kt) * 32); }
#define G_STORE0(st) { bf16* q = lds + (st) * GSTAGE + so; *(u32x4*)q = a00; *(u32x4*)(q + 64 * GLD) = a01; *(u32x4*)(q + 128 * GLD) = b00; if (NJ == 2) *(u32x4*)(q + 192 * GLD) = b01; }
#define G_STORE1(st) { bf16* q = lds + (st) * GSTAGE + so; *(u32x4*)q = a10; *(u32x4*)(q + 64 * GLD) = a11; *(u32x4*)(q + 128 * GLD) = b10; if (NJ == 2) *(u32x4*)(q + 192 * GLD) = b11; }
#define G_COMPUTE(st) { const bf16* sAc = lds + (st) * GSTAGE; const bf16* sBc = sAc + 128 * GLD; \
    _Pragma("unroll") for (int ks = 0; ks < 2; ks++) { bf16x8 fa[2], fb[NJ]; \
      _Pragma("unroll") for (int i = 0; i < 2; i++) { fa[i] = ldfrag16(sAc + (wm * 64 + i * 32 + lr) * GLD + ks * 16 + lh * 8); \
        if (i < NJ) fb[i] = ldfrag16(sBc + (wn * 32 * NJ + i * 32 + lr) * GLD + ks * 16 + lh * 8); } \
      _Pragma("unroll") for (int i = 0; i < 2; i++) _Pragma("unroll") for (int j = 0; j < NJ; j++) acc[i][j] = MFMA32(fa[i], fb[j], acc[i][j]); } }
  G_LOAD0(0)
  G_LOAD1(1)
  G_STORE0(0)
  __syncthreads();
  int st = 0;
  for (int kt = 0; kt < nk; kt += 2) {
    const int st1 = st == 2 ? 0 : st + 1, st2 = st1 == 2 ? 0 : st1 + 1;
    if (kt + 2 < nk) G_LOAD0(kt + 2)
    G_COMPUTE(st)
    G_STORE1(st1)
    __syncthreads();
    if (kt + 3 < nk) G_LOAD1(kt + 3)
    G_COMPUTE(st1)
    if (kt + 2 < nk) G_STORE0(st2)
    __syncthreads();
    st = st2;
  }
#undef G_LOAD0
#undef G_LOAD1
#undef G_STORE0
#undef G_STORE1
#undef G_COMPUTE
}

__device__ void phase_proj(const Params& p, int l, char* smem) {
  const bf16* hn = (const bf16*)(p.ws + W_HN);
  const bf16* wt = (const bf16*)(p.ws + W_WT) + (size_t)l * WT_LAYER + WT_IN;
  bf16* proj = (bf16*)(p.ws + W_PROJ);
  const int lane = TID() % 64, w = TID() / 64, wm = w / 2, wn = w % 2, lr = lane % 32, lh = lane / 32;
  constexpr int NT = NC / 128, MT = M / 128;
  constexpr int MG = 4, NGRP = (MT + MG - 1) / MG;
  const int bid = BID(), xcd = bid % 8, lb = bid / 8, nlb = ((int)gridDim.x + 7 - xcd) / 8;
  const int ngx = (NGRP - xcd + 7) / 8;
  for (int it = lb; it < ngx * NT * MG; it += nlb) {
    const int g = xcd + 8 * (it / (NT * MG)), r = it % (NT * MG);
    const int mt = g * MG + r % MG, nt = r / MG;
    if (mt >= MT) continue;
    const int m0 = mt * 128, n0 = nt * 128;
    f32x16 acc[2][2];
#pragma unroll
    for (int i = 0; i < 2; i++)
#pragma unroll
      for (int j = 0; j < 2; j++) acc[i][j] = zero16();
    gemm_mainloop<2>(hn, D, wt, D, D, m0, n0, (bf16*)smem, acc);
#pragma unroll
    for (int i = 0; i < 2; i++)
#pragma unroll
      for (int j = 0; j < 2; j++)
#pragma unroll
        for (int r = 0; r < 16; r++) {
          const int row = m0 + wm * 64 + i * 32 + crow(r, lh), col = n0 + wn * 64 + j * 32 + lr;
          proj[(size_t)row * NC + col] = f2bf(acc[i][j][r]);
        }
  }
}

__device__ void phase_merge(const Params& p, int l, char* smem) {
  const bf16* proj = (const bf16*)(p.ws + W_PROJ);
  const bf16* wt = (const bf16*)(p.ws + W_WT) + (size_t)l * WT_LAYER;
  bf16* mrg = (bf16*)(p.ws + W_HN);
  const int lane = TID() % 64, w = TID() / 64, wm = w / 2, wn = w % 2, lr = lane % 32, lh = lane / 32;
  constexpr int NT = D / 64, MT = M / 128;
  for (int t = BID(); t < MT * NT; t += gridDim.x) {
    const int m0 = (t / NT) * 128, n0 = (t % NT) * 64;
    f32x16 tot[2];
    tot[0] = zero16(); tot[1] = zero16();
#pragma unroll 1
    for (int mx = 0; mx < 3; mx++) {
      f32x16 acc[2][1];
      acc[0][0] = zero16(); acc[1][0] = zero16();
      const int acol = mx == 0 ? O_AQ : (mx == 1 ? O_BQ : O_CP);
      const int Kx = mx == 0 ? AW : (mx == 1 ? BW : CW);
      const size_t woff = mx == 0 ? WT_OA : (mx == 1 ? WT_OB : WT_OC);
      const int gcol = O_MA + mx * D;
      gemm_mainloop<1>(proj + acol, NC, wt + woff, Kx, Kx, m0, n0, (bf16*)smem, acc);
#pragma unroll
      for (int i = 0; i < 2; i++)
#pragma unroll
        for (int r = 0; r < 16; r++) {
          const int row = m0 + wm * 64 + i * 32 + crow(r, lh), col = n0 + wn * 32 + lr;
          tot[i][r] += sigm(bf2f(proj[(size_t)row * NC + gcol + col])) * acc[i][0][r];
        }
    }
#pragma unroll
    for (int i = 0; i < 2; i++)
#pragma unroll
      for (int r = 0; r < 16; r++) {
        const int row = m0 + wm * 64 + i * 32 + crow(r, lh), col = n0 + wn * 32 + lr;
        mrg[(size_t)row * D + col] = f2bf(tot[i][r]);
      }
  }
}

__device__ void phase_yout(const Params& p, int l, char* smem) {
  const bf16* mrg = (const bf16*)(p.ws + W_HN);
  const bf16* wt = (const bf16*)(p.ws + W_WT) + (size_t)l * WT_LAYER + WT_OO;
  const int lane = TID() % 64, w = TID() / 64, wm = w / 2, wn = w % 2, lr = lane % 32, lh = lane / 32;
  constexpr int NT = D / 128, MT = M / 128;
  for (int t = BID(); t < MT * NT; t += gridDim.x) {
    const int m0 = (t / NT) * 128, n0 = (t % NT) * 128;
    f32x16 acc[2][2];
#pragma unroll
    for (int i = 0; i < 2; i++)
#pragma unroll
      for (int j = 0; j < 2; j++) acc[i][j] = zero16();
    gemm_mainloop<2>(mrg, D, wt, D, D, m0, n0, (bf16*)smem, acc);
#pragma unroll
    for (int i = 0; i < 2; i++)
#pragma unroll
      for (int j = 0; j < 2; j++)
#pragma unroll
        for (int r = 0; r < 16; r++) {
          const int row = m0 + wm * 64 + i * 32 + crow(r, lh), col = n0 + wn * 64 + j * 32 + lr;
          const float xv = x_row(p, l, row)[col];
          p.out[OO_Y + (size_t)row * D + col] = xv + acc[i][j][r];
        }
  }
}

__device__ void prep_attn_chunk(const Params& p, int l, int gc, char* smem) {
  const int tid = TID();
  const ChunkInfo ci = chunk_info(gc);
  bf16* proj = (bf16*)(p.ws + W_PROJ);
  const float* rope = (const float*)(p.ws + W_ROPE);
  const float* qg = p.in[I_QNG] + l * 64; const float* kg = p.in[I_KNG] + l * 64;
  const bool samp = ci.seq >= NB; const int sb = ci.seq - NB;
  const int sub = tid % 8;
  constexpr int NVEC = 64 * 2 * AH * 2;
  for (int v0 = 0; v0 < NVEC; v0 += 128) {
    float xx[4][8];
#pragma unroll
    for (int u = 0; u < 4; u++) {
      const int vi = v0 + u * 32 + tid / 8;
      const int t = vi / (4 * AH), rem = vi % (4 * AH), isk = rem / (2 * AH), hn2 = rem % (2 * AH);
      ld8(proj + (size_t)(ci.tok0 + t) * NC + (isk ? O_AK : O_AQ) + hn2 * 64 + sub * 8, xx[u]);
    }
#pragma unroll
    for (int u = 0; u < 4; u++) {
      const int vi = v0 + u * 32 + tid / 8;
      const int t = vi / (4 * AH), rem = vi % (4 * AH), isk = rem / (2 * AH), hn2 = rem % (2 * AH);
      const int tok = ci.tok0 + t, pos = ci.pos0 + t;
      bf16* src = proj + (size_t)tok * NC + (isk ? O_AK : O_AQ) + hn2 * 64 + sub * 8;
      float* x = xx[u];
      float ss = 0.f;
#pragma unroll
      for (int i = 0; i < 8; i++) ss += x[i] * x[i];
      ss = red8(ss);
      const float rs = rsqrtf(ss / 64.f + EPS);
      const float* g = isk ? kg : qg;
#pragma unroll
      for (int i = 0; i < 8; i++) x[i] = x[i] * rs * g[sub * 8 + i];
      float y[8];
#pragma unroll
      for (int i = 0; i < 8; i++) y[i] = DPP_XOR1(x[i]);
      if (sub < 2) {
#pragma unroll
        for (int i = 0; i < 8; i++) { const float c = rope[pos * 16 + i], sn = rope[pos * 16 + 8 + i];
          x[i] = (sub == 0) ? (x[i] * c - y[i] * sn) : (x[i] * c + y[i] * sn); }
      }
      if (isk) {
        float* ko = p.out + (samp ? OO_KS + ((size_t)l * MS + (tok - MP)) * AQK : OO_KP + ((size_t)l * MP + tok) * AQK) + hn2 * 64 + sub * 8;
        *(float4*)ko = make_float4(x[0], x[1], x[2], x[3]); *(float4*)(ko + 4) = make_float4(x[4], x[5], x[6], x[7]);
        V8 o;
#pragma unroll
        for (int i = 0; i < 8; i++) o.s[i] = f2bf(x[i]);
        if (samp) { bf16* kb = (bf16*)(p.ws + W_KBS) + ((size_t)(sb * AH + hn2 / 2) * KS + PAST + ci.lc * 64 + t) * 128 + (hn2 % 2) * 64 + sub * 8; *(uint4*)kb = o.u; }
        else *(uint4*)src = o.u;
      } else {
        V8 o;
#pragma unroll
        for (int i = 0; i < 8; i++) o.s[i] = f2bf(x[i] * (0.125f * 1.44269504088896f));
        *(uint4*)src = o.u;
      }
    }
  }
  bf16* tile = (bf16*)smem;
  for (int h = 0; h < AH; h++) {
    __syncthreads();
    for (int i = 0; i < 4; i++) { const int c = tid + i * 256, t = c / 16, d8 = (c % 16) * 8; const int tok = ci.tok0 + t;
      const bf16* src = proj + (size_t)tok * NC + O_AV + h * 128 + d8;
      V8 u; u.u = *(const uint4*)src;
      *(uint4*)(tile + t * 136 + d8) = u.u;
      float* vo = p.out + (samp ? OO_VS + ((size_t)l * MS + (tok - MP)) * AW : OO_VP + ((size_t)l * MP + tok) * AW) + h * 128 + d8;
      *(float4*)vo = make_float4(bf2f(u.s[0]), bf2f(u.s[1]), bf2f(u.s[2]), bf2f(u.s[3]));
      *(float4*)(vo + 4) = make_float4(bf2f(u.s[4]), bf2f(u.s[5]), bf2f(u.s[6]), bf2f(u.s[7])); }
    __syncthreads();
    { const int dv = tid / 2, th = tid % 2;
      bf16* dst = samp ? (bf16*)(p.ws + W_VTS) + ((size_t)(sb * AH + h) * 128 + dv) * KS + PAST + ci.lc * 64 + th * 32
                       : (bf16*)(p.ws + W_VTP) + ((size_t)(ci.seq * AH + h) * 128 + dv) * T + ci.lc * 64 + th * 32;
#pragma unroll
      for (int q = 0; q < 4; q++) { V8 o;
#pragma unroll
        for (int i = 0; i < 8; i++) o.s[i] = tile[(th * 32 + q * 8 + i) * 136 + dv];
        *(uint4*)(dst + q * 8) = o.u; } }
  }
  __syncthreads();
}
__device__ void prep_past_tile(const Params& p, int l, int item, char* smem) {
  const int tid = TID();
  constexpr int NKT = PAST / 64;
  const int kt = item % NKT, h = (item / NKT) % AH, sb = item / (NKT * AH);
  const float* ck = p.in[I_CK] + (((size_t)l * NSB + sb) * PAST + kt * 64) * AQK + h * 128;
  const float* cv = p.in[I_CV] + (((size_t)l * NSB + sb) * PAST + kt * 64) * AW + h * 128;
  bf16* kb = (bf16*)(p.ws + W_KBS) + ((size_t)(sb * AH + h) * KS + kt * 64) * 128;
  bf16* tile = (bf16*)smem;
  __syncthreads();
  for (int i = 0; i < 4; i++) { const int c = tid + i * 256, t = c / 16, d8 = (c % 16) * 8;
    float4 a = *(const float4*)(ck + (size_t)t * AQK + d8), b = *(const float4*)(ck + (size_t)t * AQK + d8 + 4);
    V8 o; o.s[0] = f2bf(a.x); o.s[1] = f2bf(a.y); o.s[2] = f2bf(a.z); o.s[3] = f2bf(a.w); o.s[4] = f2bf(b.x); o.s[5] = f2bf(b.y); o.s[6] = f2bf(b.z); o.s[7] = f2bf(b.w);
    *(uint4*)(kb + (size_t)t * 128 + d8) = o.u;
    a = *(const float4*)(cv + (size_t)t * AW + d8); b = *(const float4*)(cv + (size_t)t * AW + d8 + 4);
    o.s[0] = f2bf(a.x); o.s[1] = f2bf(a.y); o.s[2] = f2bf(a.z); o.s[3] = f2bf(a.w); o.s[4] = f2bf(b.x); o.s[5] = f2bf(b.y); o.s[6] = f2bf(b.z); o.s[7] = f2bf(b.w);
    *(uint4*)(tile + t * 136 + d8) = o.u; }
  __syncthreads();
  { const int dv = tid / 2, th = tid % 2;
    bf16* dst = (bf16*)(p.ws + W_VTS) + ((size_t)(sb * AH + h) * 128 + dv) * KS + kt * 64 + th * 32;
#pragma unroll
    for (int q = 0; q < 4; q++) { V8 o;
#pragma unroll
      for (int i = 0; i < 8; i++) o.s[i] = tile[(th * 32 + q * 8 + i) * 136 + dv];
      *(uint4*)(dst + q * 8) = o.u; } }
  __syncthreads();
}
__device__ void prep_hgrn(const Params& p, int l, int item, char* smem) {
  const int tid = TID(), k = tid % 128, th = tid / 128;
  const int gc = item / BH, h = item % BH;
  const ChunkInfo ci = chunk_info(gc);
  bf16* proj = (bf16*)(p.ws + W_PROJ);
  float* tot = (float*)smem;
  float lb = 0.f;
  if (l == 1) { const float b0 = p.in[I_BLOW][h * 128 + k], b1 = p.in[I_BLOW][BQK + h * 128 + k]; lb = 1.f / (1.f + __expf(b0 - b1)); }
  float zs[32], cs[32];
  bf16* base = proj + (size_t)(ci.tok0 + th * 32) * NC + h * 128 + k;
  float run = 0.f;
#pragma unroll
  for (int i = 0; i < 32; i++) { const float z = bf2f(base[(size_t)i * NC + O_BF]); zs[i] = z; const float f = lb + (1.f - lb) * sigm(z); run += __logf(f); cs[i] = run; }
  __syncthreads();
  tot[th * 128 + k] = run;
  __syncthreads();
  const float t0 = tot[k], t1 = tot[128 + k];
  const float ref = t0, last = t0 + t1, off = th ? t0 : 0.f;
  V8 kt8[4], it8[4];
#pragma unroll
  for (int i = 0; i < 32; i++) {
    const float cum = cs[i] + off, z = zs[i];
    const float kin = (1.f - lb) * sigm(-z);
    const float qv = siluf(bf2f(base[(size_t)i * NC + O_BQ]));
    const bf16 iv = base[(size_t)i * NC + O_BI];
    base[(size_t)i * NC + O_BQ] = f2bf(qv * __expf(fminf(cum - ref, 80.f)));
    base[(size_t)i * NC + O_BF] = f2bf(kin * __expf(fminf(ref - cum, 80.f)));
    base[(size_t)i * NC + O_BI] = f2bf(qv * __expf(cum));
    kt8[i / 8].s[i % 8] = f2bf(kin * __expf(last - cum));
    it8[i / 8].s[i % 8] = iv;
  }
  bf16* hgx = (bf16*)(p.ws + W_HGX) + (size_t)item * 2 * 8192;
#pragma unroll
  for (int q = 0; q < 4; q++) { *(uint4*)(hgx + k * 64 + th * 32 + q * 8) = kt8[q].u; *(uint4*)(hgx + 8192 + k * 64 + th * 32 + q * 8) = it8[q].u; }
  if (th == 0) ((float*)(p.ws + W_DL))[(size_t)item * 128 + k] = __expf(last);
  __syncthreads();
}
__device__ void prep_rwkv(const Params& p, int l, int ti, char* smem) {
  const int tid = TID(), lane = tid % 64, w = tid / 64, lr = lane % 32, lh = lane / 32;
  const int tok0 = ti * 32;
  const ChunkInfo ci = chunk_info(tok0 / 64);
  const int seqt0 = seq_tok0(ci.seq);
  const bf16* proj = (const bf16*)(p.ws + W_PROJ);
  const bf16* hn = (const bf16*)(p.ws + W_HN);
  const float* mu = p.in[I_MU] + (size_t)l * CSH;
  const float* shp = (ci.seq >= NB) ? p.in[I_SS] + ((size_t)l * NSB + (ci.seq - NB)) * CSH : nullptr;
  bf16* twb = (bf16*)smem;
  bf16* alb = twb + 32 * 72;
  bf16* hvb = alb + 32 * 72;
  float* part = (float*)(hvb + 32 * 40);
  __syncthreads();
  {
    const int t = tid / 8, j8 = (tid % 8) * 8; const int tok = tok0 + t;
#pragma unroll
    for (int which = 0; which < 2; which++) {
      const int col = (which == 0 ? CP_WLO : CP_ALO) + j8;
      float cur[8], prv[8];
      ld8(proj + (size_t)tok * NC + O_CP + col, cur);
      if (tok == seqt0) {
#pragma unroll
        for (int i = 0; i < 8; i++) prv[i] = shp ? shp[col + i] : 0.f;
      } else ld8(proj + (size_t)(tok - 1) * NC + O_CP + col, prv);
      V8 o;
#pragma unroll
      for (int i = 0; i < 8; i++) { const float v = cur[i] + (prv[i] - cur[i]) * mu[col + i]; o.s[i] = f2bf(which == 0 ? tanhf(v) : v); }
      *(uint4*)((which == 0 ? twb : alb) + t * 72 + j8) = o.u;
    }
  }
  if (l > 0) {
    f32x16 acc = zero16();
    const bf16* w1t = (const bf16*)(p.ws + W_W1T);
    const bf16* ap = hn + (size_t)(tok0 + lr) * D + w * (D / 4) + lh * 8;
    const bf16* bp = w1t + (size_t)lr * D + w * (D / 4) + lh * 8;
#pragma unroll 4
    for (int ks = 0; ks < D / 64; ks++) acc = MFMA32(ldfrag16(ap + ks * 16), ldfrag16(bp + ks * 16), acc);
#pragma unroll
    for (int r = 0; r < 16; r++) part[(w * 32 + crow(r, lh)) * 33 + lr] = acc[r];
    __syncthreads();
    { const int t = tid / 8, j4 = (tid % 8) * 4;
#pragma unroll
      for (int jj = 0; jj < 4; jj++) { const float sv = part[t * 33 + j4 + jj] + part[(32 + t) * 33 + j4 + jj] + part[(64 + t) * 33 + j4 + jj] + part[(96 + t) * 33 + j4 + jj];
        hvb[t * 40 + j4 + jj] = f2bf(sv); } }
  }
  __syncthreads();
  const bf16* w2t = (const bf16*)(p.ws + W_W2T) + (size_t)l * CW * 64;
  const bf16* a2t = (const bf16*)(p.ws + W_A2T) + (size_t)l * CW * 64;
  const bf16* vw2t = (const bf16*)(p.ws + W_VW2T);
  float* rww = (float*)(p.ws + W_RWW);
  bf16* rwr = (bf16*)(p.ws + W_RWR); bf16* rwk = (bf16*)(p.ws + W_RWK); bf16* rwa = (bf16*)(p.ws + W_RWA); bf16* rwb = (bf16*)(p.ws + W_RWB);
  bf16* rwv = (bf16*)(p.ws + (l == 0 ? W_RWV0 : W_RWV1)); const bf16* vfirst = (const bf16*)(p.ws + W_RWV0);
#pragma unroll 1
  for (int head = w; head < CH; head += 4) {
    f32x16 aw[2], aa[2], vm[2];
#pragma unroll
    for (int ct = 0; ct < 2; ct++) { aw[ct] = zero16(); aa[ct] = zero16(); vm[ct] = zero16(); }
    const int chb = head * 64 + lr;
#pragma unroll
    for (int ks = 0; ks < 4; ks++) {
      SCHED_BARRIER();
      const bf16x8 twf = ldfrag16(twb + lr * 72 + ks * 16 + lh * 8), alf = ldfrag16(alb + lr * 72 + ks * 16 + lh * 8);
#pragma unroll
      for (int ct = 0; ct < 2; ct++) {
        aw[ct] = MFMA32(twf, ldfrag16(w2t + (size_t)(chb + ct * 32) * 64 + ks * 16 + lh * 8), aw[ct]);
        aa[ct] = MFMA32(alf, ldfrag16(a2t + (size_t)(chb + ct * 32) * 64 + ks * 16 + lh * 8), aa[ct]);
      }
    }
    if (l > 0) {
#pragma unroll
      for (int ks = 0; ks < 2; ks++) {
        SCHED_BARRIER();
        const bf16x8 hvf = ldfrag16(hvb + lr * 40 + ks * 16 + lh * 8);
#pragma unroll
        for (int ct = 0; ct < 2; ct++) vm[ct] = MFMA32(hvf, ldfrag16(vw2t + (size_t)(chb + ct * 32) * 32 + ks * 16 + lh * 8), vm[ct]);
      }
    }
    SCHED_BARRIER();
    float w0c[2], a0c[2], kkc[2], kac[2], v0c[2], mur[2], muk[2], muv[2];
#pragma unroll
    for (int ct = 0; ct < 2; ct++) { const int ch = chb + ct * 32;
      w0c[ct] = p.in[I_W0][(size_t)l * CW + ch]; a0c[ct] = p.in[I_A0][(size_t)l * CW + ch]; kkc[ct] = p.in[I_KK][(size_t)l * CW + ch]; kac[ct] = p.in[I_KA][(size_t)l * CW + ch];
      v0c[ct] = l > 0 ? p.in[I_V0][(size_t)(l - 1) * CW + ch] : 0.f;
      mur[ct] = mu[CP_R + ch]; muk[ct] = mu[CP_K + ch]; muv[ct] = mu[CP_V + ch]; }
#pragma unroll
    for (int rg = 0; rg < 16; rg++) {
      SCHED_BARRIER();
      float cr[1][2], ck[1][2], cv[1][2], pr[1][2], pk[1][2], pv[1][2], vf[1][2];
#pragma unroll
      for (int q = 0; q < 1; q++) {
        const int t = crow(rg + q, lh), tok = tok0 + t;
#pragma unroll
        for (int ct = 0; ct < 2; ct++) { const int ch = chb + ct * 32;
          const bf16* cp = proj + (size_t)tok * NC + O_CP + ch;
          cr[q][ct] = bf2f(cp[CP_R]); ck[q][ct] = bf2f(cp[CP_K]); cv[q][ct] = bf2f(cp[CP_V]);
          if (tok == seqt0) { pr[q][ct] = shp ? shp[CP_R + ch] : 0.f; pk[q][ct] = shp ? shp[CP_K + ch] : 0.f; pv[q][ct] = shp ? shp[CP_V + ch] : 0.f; }
          else { pr[q][ct] = bf2f(cp[CP_R - NC]); pk[q][ct] = bf2f(cp[CP_K - NC]); pv[q][ct] = bf2f(cp[CP_V - NC]); }
          vf[q][ct] = l > 0 ? bf2f(vfirst[(size_t)tok * CW + ch]) : 0.f; }
      }
#pragma unroll
      for (int q = 0; q < 1; q++) {
        const int r = rg + q, t = crow(r, lh), tok = tok0 + t;
        float rr[2], kk[2], vv[2], ww[2], a[2], kt[2];
        float ss = 0.f;
#pragma unroll
        for (int ct = 0; ct < 2; ct++) {
          rr[ct] = cr[q][ct] + (pr[q][ct] - cr[q][ct]) * mur[ct];
          const float kx = ck[q][ct] + (pk[q][ct] - ck[q][ct]) * muk[ct];
          float vx = cv[q][ct] + (pv[q][ct] - cv[q][ct]) * muv[ct];
          const float u = w0c[ct] + aw[ct][r];
          const float sp = fmaxf(-u, 0.f) + log1pf(__expf(-fabsf(u)));
          ww[ct] = __expf(-__expf(-sp - 0.5f));
          a[ct] = sigm(a0c[ct] + aa[ct][r]);
          if (l > 0) vx = vx + (vf[q][ct] - vx) * sigm(v0c[ct] + vm[ct][r]);
          vv[ct] = vx;
          kk[ct] = kx * kkc[ct];
          ss += kk[ct] * kk[ct];
          kt[ct] = kx * (1.f + (a[ct] - 1.f) * kac[ct]);
        }
        ss = red16(ss); ss += SHFL_XOR(ss, 16);
        const float inv = 1.f / fmaxf(sqrtf(ss), 1e-12f);
#pragma unroll
        for (int ct = 0; ct < 2; ct++) { const size_t o = (size_t)tok * CW + chb + ct * 32;
          const float kn = kk[ct] * inv;
          rww[o] = ww[ct]; rwr[o] = f2bf(rr[ct]); rwk[o] = f2bf(kt[ct]); rwv[o] = f2bf(vv[ct]); rwa[o] = f2bf(-kn); rwb[o] = f2bf(kn * a[ct]); }
      }
    }
  }
  __syncthreads();
}
__device__ void phase_prep(const Params& p, int l, char* smem) {
#ifndef SUBMASK
#define SUBMASK 15
#endif
  if (SUBMASK & 1) for (int gc = BID(); gc < NCHK; gc += gridDim.x) prep_attn_chunk(p, l, gc, smem);
  if (SUBMASK & 2) for (int it = BID(); it < NSB * AH * (PAST / 64); it += gridDim.x) prep_past_tile(p, l, it, smem);
  if (SUBMASK & 4) for (int it = BID(); it < NCHK * BH; it += gridDim.x) prep_hgrn(p, l, it, smem);
  if (SUBMASK & 8) for (int ti = BID(); ti < M / 32; ti += gridDim.x) prep_rwkv(p, l, ti, smem);
  const bf16* proj = (const bf16*)(p.ws + W_PROJ);
  for (int i = BID() * blockDim.x + TID(); i < NSEQ * CSH; i += gridDim.x * blockDim.x) {
    const int seq = i / CSH, c = i % CSH; const int tok = seq_tok0(seq) + seq_len(seq) - 1;
    const float v = bf2f(proj[(size_t)tok * NC + O_CP + c]);
    if (seq < NB) p.out[OO_SP + ((size_t)l * NB + seq) * CSH + c] = v; else p.out[OO_SS + ((size_t)l * NSB + (seq - NB)) * CSH + c] = v;
  }
}

constexpr int KLD = 136, VLD = 72;
__device__ void attn_item(const Params& p, int l, int gc, int h, float lam, float lam_init, char* smem) {
  const int tid = TID(), lane = tid % 64, w = tid / 64, rh = w / 2, n = w % 2, lr = lane % 32, lh = lane / 32;
  const ChunkInfo ci = chunk_info(gc);
  bf16* proj = (bf16*)(p.ws + W_PROJ);
  const bool samp = ci.seq >= NB; const int sb = ci.seq - NB;
  const bf16* Kg; size_t ldk; const bf16* Vg; size_t ldv; int ntiles;
  if (!samp) { Kg = proj + (size_t)(ci.seq * T) * NC + O_AK + h * 128; ldk = NC; Vg = (const bf16*)(p.ws + W_VTP) + (size_t)(ci.seq * AH + h) * 128 * T; ldv = T; ntiles = ci.lc + 1; }
  else { Kg = (const bf16*)(p.ws + W_KBS) + (size_t)(sb * AH + h) * KS * 128; ldk = 128; Vg = (const bf16*)(p.ws + W_VTS) + (size_t)(sb * AH + h) * 128 * KS; ldv = KS; ntiles = PAST / 64 + ci.lc + 1; }
  constexpr int ASTAGE = 64 * KLD + 128 * VLD;
  bf16* sbase = (bf16*)smem;
  bf16x8 qf[4];
  { const bf16* qp = proj + (size_t)(ci.tok0 + rh * 32 + lr) * NC + O_AQ + h * 128 + n * 64 + lh * 8;
#pragma unroll
    for (int ks = 0; ks < 4; ks++) qf[ks] = ldfrag16(qp + ks * 16); }
  f32x16 o[4];
#pragma unroll
  for (int i = 0; i < 4; i++) o[i] = zero16();
  float mrun = -1e30f, lrun = 0.f;
  const int kr0 = tid / 16, kc8 = (tid % 16) * 8, vr0 = tid / 8, vc8 = (tid % 8) * 8;
  const bf16* Kp = Kg + (size_t)kr0 * ldk + kc8;
  const bf16* Vp = Vg + (size_t)vr0 * ldv + vc8;
  typedef unsigned int u32x4 __attribute__((ext_vector_type(4)));
  u32x4 rk0, rk1, rk2, rk3, rv0, rv1, rv2, rv3;
  __syncthreads();
  rk0 = *(const u32x4*)(Kp); rk1 = *(const u32x4*)(Kp + (size_t)16 * ldk); rk2 = *(const u32x4*)(Kp + (size_t)32 * ldk); rk3 = *(const u32x4*)(Kp + (size_t)48 * ldk);
  rv0 = *(const u32x4*)(Vp); rv1 = *(const u32x4*)(Vp + (size_t)32 * ldv); rv2 = *(const u32x4*)(Vp + (size_t)64 * ldv); rv3 = *(const u32x4*)(Vp + (size_t)96 * ldv);
  *(u32x4*)(sbase + (kr0) * KLD + kc8) = rk0; *(u32x4*)(sbase + (kr0 + 16) * KLD + kc8) = rk1; *(u32x4*)(sbase + (kr0 + 32) * KLD + kc8) = rk2; *(u32x4*)(sbase + (kr0 + 48) * KLD + kc8) = rk3;
  *(u32x4*)(sbase + 64 * KLD + (vr0) * VLD + vc8) = rv0; *(u32x4*)(sbase + 64 * KLD + (vr0 + 32) * VLD + vc8) = rv1;
  *(u32x4*)(sbase + 64 * KLD + (vr0 + 64) * VLD + vc8) = rv2; *(u32x4*)(sbase + 64 * KLD + (vr0 + 96) * VLD + vc8) = rv3;
  __syncthreads();
  for (int j = 0; j < ntiles; j++) {
    const bf16* sK = sbase + (j & 1) * ASTAGE; const bf16* sV = sK + 64 * KLD;
    bf16* nK = sbase + ((j & 1) ^ 1) * ASTAGE; bf16* nV = nK + 64 * KLD;
    const bool more = j + 1 < ntiles;
    if (more) {
      const bf16* kq = Kp + (size_t)((j + 1) * 64) * ldk;
      rk0 = *(const u32x4*)(kq); rk1 = *(const u32x4*)(kq + (size_t)16 * ldk); rk2 = *(const u32x4*)(kq + (size_t)32 * ldk); rk3 = *(const u32x4*)(kq + (size_t)48 * ldk);
    }
    f32x16 s[2];
#pragma unroll
    for (int mt = 0; mt < 2; mt++) { s[mt] = zero16();
#pragma unroll
      for (int ks = 0; ks < 4; ks++) s[mt] = MFMA32(ldfrag16(sK + (mt * 32 + lr) * KLD + n * 64 + ks * 16 + lh * 8), qf[ks], s[mt]); }
    SCHED_BARRIER();
    if (more) {
      *(u32x4*)(nK + (kr0) * KLD + kc8) = rk0; *(u32x4*)(nK + (kr0 + 16) * KLD + kc8) = rk1; *(u32x4*)(nK + (kr0 + 32) * KLD + kc8) = rk2; *(u32x4*)(nK + (kr0 + 48) * KLD + kc8) = rk3;
      const bf16* vq = Vp + (j + 1) * 64;
      rv0 = *(const u32x4*)(vq); rv1 = *(const u32x4*)(vq + (size_t)32 * ldv); rv2 = *(const u32x4*)(vq + (size_t)64 * ldv); rv3 = *(const u32x4*)(vq + (size_t)96 * ldv);
    }
    float mx = -1e30f;
#pragma unroll
    for (int mt = 0; mt < 2; mt++)
#pragma unroll
      for (int r = 0; r < 16; r++) mx = fmaxf(mx, s[mt][r]);
    mx = fmaxf(mx, SHFL_XOR(mx, 32));
    const float mnew = fmaxf(mrun, mx);
    const float alpha = EXP2(mrun - mnew);
    float rs = 0.f;
#pragma unroll
    for (int mt = 0; mt < 2; mt++)
#pragma unroll
      for (int r = 0; r < 16; r++) { const float e = EXP2(s[mt][r] - mnew); s[mt][r] = e; rs += e; }
    rs += SHFL_XOR(rs, 32);
    lrun = lrun * alpha + rs; mrun = mnew;
    if (__any(alpha != 1.0f)) {
#pragma unroll
      for (int i = 0; i < 4; i++)
#pragma unroll
        for (int r = 0; r < 16; r++) o[i][r] *= alpha;
    }
    bf16x8 pf[2][2];
#pragma unroll
    for (int mt = 0; mt < 2; mt++)
#pragma unroll
      for (int s2 = 0; s2 < 2; s2++) pf[mt][s2] = pack8(s[mt], s2);
    SCHED_BARRIER();
#pragma unroll
    for (int mt = 0; mt < 2; mt++)
#pragma unroll
      for (int s2 = 0; s2 < 2; s2++) {
#pragma unroll
        for (int dt = 0; dt < 4; dt++) {
          const bf16* vp = sV + (dt * 32 + lr) * VLD + mt * 32 + 16 * s2 + 4 * lh;
          o[dt] = MFMA32(ldfrag8x2(vp, vp + 8), pf[mt][s2], o[dt]);
        }
      }
    SCHED_BARRIER();
    if (more) {
      *(u32x4*)(nV + (vr0) * VLD + vc8) = rv0; *(u32x4*)(nV + (vr0 + 32) * VLD + vc8) = rv1; *(u32x4*)(nV + (vr0 + 64) * VLD + vc8) = rv2; *(u32x4*)(nV + (vr0 + 96) * VLD + vc8) = rv3;
    }
    __syncthreads();
  }
  __syncthreads();
  float* comb = (float*)smem;
  const float invl = 1.f / lrun;
  if (n == 1) {
#pragma unroll
    for (int dt = 0; dt < 4; dt++)
#pragma unroll
      for (int r = 0; r < 16; r++) comb[(rh * 32 + lr) * 129 + dt * 32 + crow(r, lh)] = o[dt][r] * invl;
  }
  __syncthreads();
  if (n == 0) {
    float ss = 0.f;
#pragma unroll
    for (int dt = 0; dt < 4; dt++)
#pragma unroll
      for (int r = 0; r < 16; r++) { const float v = o[dt][r] * invl - lam * comb[(rh * 32 + lr) * 129 + dt * 32 + crow(r, lh)]; o[dt][r] = v; ss += v * v; }
    ss += SHFL_XOR(ss, 32);
    const float rstd = rsqrtf(ss / 128.f + EPS) * (1.f - lam_init);
    const float* sg = p.in[I_SUBG] + l * 128;
    const int tok = ci.tok0 + rh * 32 + lr;
#pragma unroll
    for (int dt = 0; dt < 4; dt++)
#pragma unroll
      for (int g = 0; g < 4; g++) {
        const int dv = dt * 32 + 8 * g + 4 * lh;
        float gate[4]; ld4(proj + (size_t)tok * NC + O_AG + h * 128 + dv, gate);
        V4 ov;
#pragma unroll
        for (int r = 0; r < 4; r++) ov.s[r] = f2bf(o[dt][4 * g + r] * rstd * sg[dv + r] * siluf(gate[r]));
        *(uint2*)(proj + (size_t)tok * NC + O_AQ + h * 128 + dv) = ov.u;
      }
  }
  __syncthreads();
}

constexpr int HLD = 136, TLD = 72;
__device__ void hgrn_item(const Params& p, int l, int seq, int h, char* smem) {
  const int tid = TID(), lane = tid % 64, w = tid / 64, lr = lane % 32, lh = lane / 32;
  bf16* proj = (bf16*)(p.ws + W_PROJ);
  const int nch = seq < NB ? PCH : SCH;
  const int gc0 = seq < NB ? seq * PCH : NB * PCH + (seq - NB) * SCH;
  bf16* X0 = (bf16*)smem;
  bf16* X1 = X0 + 9216;
  float* red = (float*)(X1 + 9216);
  f32x16 S[4];
  if (seq < NB) {
#pragma unroll
    for (int kt = 0; kt < 4; kt++) S[kt] = zero16();
  } else {
    const float* s0 = p.in[I_SH] + (((size_t)l * NSB + (seq - NB)) * BH + h) * 16384;
#pragma unroll
    for (int kt = 0; kt < 4; kt++) {
      const float* sp = s0 + (size_t)(kt * 32 + 4 * lh) * 128 + w * 32 + lr;
#pragma unroll
      for (int r = 0; r < 16; r++) S[kt][r] = sp[((r & 3) + 8 * (r >> 2)) * 128];
      SCHED_BARRIER();
    }
  }
  const float* ng = p.in[I_BNG] + l * 128;
  for (int c = 0; c < nch; c++) {
    const int gc = gc0 + c, tok0 = gc * 64;
    const size_t item = (size_t)gc * BH + h;
    const bf16* hgx = (const bf16*)(p.ws + W_HGX) + item * 2 * 8192;
    const float* dl = (const float*)(p.ws + W_DL) + item * 128;
    __syncthreads();
    for (int i = 0; i < 4; i++) { const int cc = tid + i * 256, r = cc / 16, c8 = (cc % 16) * 8;
      *(uint4*)(X0 + r * HLD + c8) = *(const uint4*)(proj + (size_t)(tok0 + r) * NC + O_BF + h * 128 + c8);
      *(uint4*)(X1 + r * HLD + c8) = *(const uint4*)(proj + (size_t)(tok0 + r) * NC + O_BQ + h * 128 + c8); }
    __syncthreads();
    f32x16 x00 = zero16(), x01 = zero16(), x11 = zero16();
#pragma unroll
    for (int ks = 0; ks < 8; ks++) {
      const bf16x8 b0 = ldfrag16(X0 + (lr) * HLD + ks * 16 + lh * 8), b1 = ldfrag16(X0 + (32 + lr) * HLD + ks * 16 + lh * 8);
      const bf16x8 a0 = ldfrag16(X1 + (lr) * HLD + ks * 16 + lh * 8), a1 = ldfrag16(X1 + (32 + lr) * HLD + ks * 16 + lh * 8);
      x00 = MFMA32(b0, a0, x00); x01 = MFMA32(b0, a1, x01); x11 = MFMA32(b1, a1, x11);
      if (ks & 1) SCHED_BARRIER();
    }
#pragma unroll
    for (int r = 0; r < 16; r++) { if (crow(r, lh) > lr) { x00[r] = 0.f; x11[r] = 0.f; } }
    bf16x8 xp00[2], xp01[2], xp11[2];
#pragma unroll
    for (int s2 = 0; s2 < 2; s2++) { xp00[s2] = pack8(x00, s2); xp01[s2] = pack8(x01, s2); xp11[s2] = pack8(x11, s2); }
    SCHED_BARRIER();
    bf16x8 itf[2][2];
#pragma unroll
    for (int st = 0; st < 2; st++)
#pragma unroll
      for (int s2 = 0; s2 < 2; s2++) { const bf16* ip = hgx + 8192 + (size_t)(w * 32 + lr) * 64 + st * 32 + 16 * s2 + 4 * lh; itf[st][s2] = ldfrag8x2(ip, ip + 8); }
    __syncthreads();
    for (int i = 0; i < 4; i++) { const int cc = tid + i * 256;
      { const int r = cc / 16, c8 = (cc % 16) * 8; *(uint4*)(X0 + r * HLD + c8) = *(const uint4*)(proj + (size_t)(tok0 + r) * NC + O_BI + h * 128 + c8); }
      { const int r = cc / 8, c8 = (cc % 8) * 8; *(uint4*)(X1 + r * TLD + c8) = *(const uint4*)(hgx + (size_t)r * 64 + c8); } }
    __syncthreads();
    f32x16 o0 = zero16(), o1 = zero16();
#pragma unroll
    for (int s2 = 0; s2 < 2; s2++) {
      o0 = MFMA32(itf[0][s2], xp00[s2], o0);
      o1 = MFMA32(itf[0][s2], xp01[s2], o1);
      o1 = MFMA32(itf[1][s2], xp11[s2], o1);
    }
    SCHED_BARRIER();
#pragma unroll
    for (int kt = 0; kt < 4; kt++)
#pragma unroll
      for (int s2 = 0; s2 < 2; s2++) {
        const bf16x8 sp = pack8(S[kt], s2);
        const bf16* q0 = X0 + (lr) * HLD + kt * 32 + 16 * s2 + 4 * lh; const bf16* q1 = X0 + (32 + lr) * HLD + kt * 32 + 16 * s2 + 4 * lh;
        o0 = MFMA32(sp, ldfrag8x2(q0, q0 + 8), o0);
        o1 = MFMA32(sp, ldfrag8x2(q1, q1 + 8), o1);
        if (s2) SCHED_BARRIER();
      }
    SCHED_BARRIER();
#pragma unroll
    for (int kt = 0; kt < 4; kt++) {
      SCHED_BARRIER();
#pragma unroll
      for (int g = 0; g < 4; g++) { const float4 dv = *(const float4*)(dl + kt * 32 + 8 * g + 4 * lh);
        S[kt][4 * g] *= dv.x; S[kt][4 * g + 1] *= dv.y; S[kt][4 * g + 2] *= dv.z; S[kt][4 * g + 3] *= dv.w; }
#pragma unroll
      for (int st = 0; st < 2; st++)
#pragma unroll
        for (int s2 = 0; s2 < 2; s2++) { const bf16* kp = X1 + (kt * 32 + lr) * TLD + st * 32 + 16 * s2 + 4 * lh;
          S[kt] = MFMA32(ldfrag8x2(kp, kp + 8), itf[st][s2], S[kt]); }
    }
    SCHED_BARRIER();
    float ss0 = 0.f, ss1 = 0.f;
#pragma unroll
    for (int r = 0; r < 16; r++) { ss0 += o0[r] * o0[r]; ss1 += o1[r] * o1[r]; }
    ss0 += SHFL_XOR(ss0, 32); ss1 += SHFL_XOR(ss1, 32);
    if (lh == 0) { red[w * 64 + lr] = ss0; red[w * 64 + 32 + lr] = ss1; }
    __syncthreads();
#pragma unroll
    for (int tt = 0; tt < 2; tt++) {
      const int t = tt * 32 + lr;
      const float tot = red[t] + red[64 + t] + red[128 + t] + red[192 + t];
      const float rstd = rsqrtf(tot / 128.f + EPS);
      const int tok = tok0 + t;
#pragma unroll
      for (int g = 0; g < 4; g++) {
        const int v = w * 32 + 8 * g + 4 * lh;
        float gate[4]; ld4(proj + (size_t)tok * NC + O_BG + h * 128 + v, gate);
        V4 ov;
#pragma unroll
        for (int r = 0; r < 4; r++) { const float ovv = (tt == 0 ? o0[4 * g + r] : o1[4 * g + r]); ov.s[r] = f2bf(ovv * rstd * ng[v + r] * siluf(gate[r])); }
        *(uint2*)(proj + (size_t)tok * NC + O_BQ + h * 128 + v) = ov.u;
      }
    }
  }
  float* so = p.out + (seq < NB ? OO_HP + (((size_t)l * NB + seq) * BH + h) * 16384 : OO_HS + (((size_t)l * NSB + (seq - NB)) * BH + h) * 16384);
#pragma unroll
  for (int kt = 0; kt < 4; kt++) {
    float* sp = so + (size_t)(kt * 32 + 4 * lh) * 128 + w * 32 + lr;
#pragma unroll
    for (int r = 0; r < 16; r++) sp[((r & 3) + 8 * (r >> 2)) * 128] = S[kt][r];
    SCHED_BARRIER();
  }
  __syncthreads();
}

__device__ void rwkv_item(const Params& p, int l, int seq, int h, char* smem) {
  const int tid = TID(), ri = tid / 4, sub = tid % 4;
  bf16* proj = (bf16*)(p.ws + W_PROJ);
  const float* rww = (const float*)(p.ws + W_RWW);
  const bf16* rwr = (const bf16*)(p.ws + W_RWR); const bf16* rwk = (const bf16*)(p.ws + W_RWK); const bf16* rwa = (const bf16*)(p.ws + W_RWA);
  const bf16* rwb = (const bf16*)(p.ws + W_RWB); const bf16* rwv = (const bf16*)(p.ws + (l == 0 ? W_RWV0 : W_RWV1));
  float* sw = (float*)smem; float* sr = sw + 2048; float* sk = sr + 2048; float* sv = sk + 2048; float* sa = sv + 2048; float* sbb = sa + 2048; float* sy = sbb + 2048;
  const int len = seq_len(seq), t0 = seq_tok0(seq);
  float S[16];
  if (seq < NB) {
#pragma unroll
    for (int j = 0; j < 16; j++) S[j] = 0.f;
  } else {
    const float* s0 = p.in[I_SR] + ((((size_t)l * NSB + (seq - NB)) * CH + h) * 64 + ri) * 64 + sub * 16;
#pragma unroll
    for (int j = 0; j < 16; j++) S[j] = s0[j];
  }
  const float* lnw = p.in[I_LNW] + (size_t)l * CW + h * 64; const float* lnb = p.in[I_LNB] + (size_t)l * CW + h * 64;
  const float* rk = p.in[I_RK] + (size_t)l * CW + h * 64;
  const int st = tid / 8, sc8 = (tid % 8) * 8;
  typedef unsigned int u32x4 __attribute__((ext_vector_type(4)));
  typedef float f32x4v __attribute__((ext_vector_type(4)));
  f32x4v pw0, pw1; u32x4 pr_, pk_, pv_, pa_, pb_;
  { const size_t g = (size_t)(t0 + st) * CW + h * 64 + sc8;
    pw0 = *(const f32x4v*)(rww + g); pw1 = *(const f32x4v*)(rww + g + 4);
    pr_ = *(const u32x4*)(rwr + g); pk_ = *(const u32x4*)(rwk + g); pv_ = *(const u32x4*)(rwv + g); pa_ = *(const u32x4*)(rwa + g); pb_ = *(const u32x4*)(rwb + g); }
  for (int tb = 0; tb < len; tb += 32) {
    __syncthreads();
    { float* d = sw + st * 64 + sc8; *(f32x4v*)d = pw0; *(f32x4v*)(d + 4) = pw1;
#define UNPK(dst, v) { float* q = dst + st * 64 + sc8; _Pragma("unroll") for (int i = 0; i < 4; i++) { q[2 * i] = __uint_as_float(v[i] << 16); q[2 * i + 1] = __uint_as_float(v[i] & 0xffff0000u); } }
      UNPK(sr, pr_) UNPK(sk, pk_) UNPK(sv, pv_) UNPK(sa, pa_) UNPK(sbb, pb_)
    }
    __syncthreads();
    if (tb + 32 < len) { const size_t g = (size_t)(t0 + tb + 32 + st) * CW + h * 64 + sc8;
      pw0 = *(const f32x4v*)(rww + g); pw1 = *(const f32x4v*)(rww + g + 4);
      pr_ = *(const u32x4*)(rwr + g); pk_ = *(const u32x4*)(rwk + g); pv_ = *(const u32x4*)(rwv + g); pa_ = *(const u32x4*)(rwa + g); pb_ = *(const u32x4*)(rwb + g); }
#pragma unroll 2
    for (int t = 0; t < 32; t++) {
      const float* pa = sa + t * 64 + sub * 16; const float* pw = sw + t * 64 + sub * 16; const float* pb = sbb + t * 64 + sub * 16;
      const float* pk = sk + t * 64 + sub * 16; const float* pr = sr + t * 64 + sub * 16;
      float dot = 0.f, dotb = 0.f;
#pragma unroll
      for (int j = 0; j < 8; j++) { dot += S[j] * pa[j]; dotb += S[j + 8] * pa[j + 8]; }
      dot = red4(dot + dotb);
      const float vi = sv[t * 64 + ri];
      float y = 0.f, yb = 0.f;
#pragma unroll
      for (int j = 0; j < 8; j++) { S[j] = S[j] * pw[j] + dot * pb[j] + vi * pk[j]; y += S[j] * pr[j];
                                    S[j + 8] = S[j + 8] * pw[j + 8] + dot * pb[j + 8] + vi * pk[j + 8]; yb += S[j + 8] * pr[j + 8]; }
      y = red4(y + yb);
      if (sub == 0) sy[t * 64 + ri] = y;
    }
    __syncthreads();
    {
      const int t = tid / 8, c8 = (tid % 8) * 8; const int tok = t0 + tb + t;
      float y[8]; float s1 = 0.f, bon = 0.f;
#pragma unroll
      for (int i = 0; i < 8; i++) { y[i] = sy[t * 64 + c8 + i]; s1 += y[i]; bon += sr[t * 64 + c8 + i] * sk[t * 64 + c8 + i] * rk[c8 + i]; }
      s1 = red8(s1); bon = red8(bon);
      const float mu = s1 / 64.f; float s2 = 0.f;
#pragma unroll
      for (int i = 0; i < 8; i++) { const float d = y[i] - mu; s2 += d * d; }
      s2 = red8(s2);
      const float rstd = rsqrtf(s2 / 64.f + 64e-5f);
      float gate[8]; ld8(proj + (size_t)tok * NC + O_CG + h * 64 + c8, gate);
      V8 ov;
#pragma unroll
      for (int i = 0; i < 8; i++) { const float o = (y[i] - mu) * rstd * lnw[c8 + i] + lnb[c8 + i] + bon * sv[t * 64 + c8 + i]; ov.s[i] = f2bf(o * siluf(gate[i])); }
      *(uint4*)(proj + (size_t)tok * NC + O_CP + h * 64 + c8) = ov.u;
    }
  }
  float* so = p.out + (seq < NB ? OO_RP + ((((size_t)l * NB + seq) * CH + h) * 64 + ri) * 64 : OO_RS + ((((size_t)l * NSB + (seq - NB)) * CH + h) * 64 + ri) * 64) + sub * 16;
#pragma unroll
  for (int j = 0; j < 16; j++) so[j] = S[j];
  __syncthreads();
}

__device__ void phase_mixers(const Params& p, int l, char* smem) {
  __shared__ int s_item;
  int* cnt = (int*)(p.ws + W_CNT) + l;
  const float* lp = p.in[I_LAM] + (size_t)l * 256;
  float d1 = 0.f, d2 = 0.f;
  for (int i = 0; i < 64; i++) { d1 += lp[i] * lp[64 + i]; d2 += lp[128 + i] * lp[192 + i]; }
  const float lam_init = 0.8f - 0.6f * expf(-0.3f * (float)l);
  const float lam = expf(d1) - expf(d2) + lam_init;
  constexpr int N_RWP = NB * CH, N_HGP = NB * BH, N_ATP = NB * PCH * AH, N_RWS = NSB * CH, N_HGS = NSB * BH, N_ATS = NSB * SCH * AH;
  constexpr int NTOT = N_RWP + N_HGP + N_ATP + N_RWS + N_HGS + N_ATS;
  for (;;) {
    __syncthreads();
    if (TID() == 0) s_item = atomicAdd(cnt, 1);
    __syncthreads();
    int it = s_item;
    if (it >= NTOT) break;
    if (it < N_RWP) { SETPRIO(3); if (SUBMASK & 1) rwkv_item(p, l, it / CH, it % CH, smem); SETPRIO(0); continue; }
    it -= N_RWP;
    if (it < N_HGP) { SETPRIO(2); if (SUBMASK & 2) hgrn_item(p, l, it / BH, it % BH, smem); SETPRIO(0); continue; }
    it -= N_HGP;
    if (it < N_ATP) {
      const int lc = PCH - 1 - it / (NB * AH), r = it % (NB * AH); if (SUBMASK & 4) attn_item(p, l, (r / AH) * PCH + lc, r % AH, lam, lam_init, smem); continue; }
    it -= N_ATP;
    if (it < N_RWS) { if (SUBMASK & 1) rwkv_item(p, l, NB + it / CH, it % CH, smem); continue; }
    it -= N_RWS;
    if (it < N_HGS) { if (SUBMASK & 2) hgrn_item(p, l, NB + it / BH, it % BH, smem); continue; }
    it -= N_HGS;
    { const int gc = NB * PCH + it / AH; if (SUBMASK & 4) attn_item(p, l, gc, it % AH, lam, lam_init, smem); }
  }
}

constexpr int SMEM_BYTES = 73728;
#ifdef EMU
__device__ void run_phase(const Params& p, int ph, char* smem) {
  const int l = ph / 6, s = ph % 6;
  switch (s) {
#ifndef PHMASK
#define PHMASK 63
#endif
    case 0: if (PHMASK & 1) { if (l == 0) phase_wprep(p, smem); phase_rmsnorm(p, l); } break;
    case 1: if (PHMASK & 2) phase_proj(p, l, smem); break;
    case 2: if (PHMASK & 4) phase_prep(p, l, smem); break;
    case 3: if (PHMASK & 8) phase_mixers(p, l, smem); break;
    case 4: if (PHMASK & 16) phase_merge(p, l, smem); break;
    case 5: if (PHMASK & 32) phase_yout(p, l, smem); break;
  }
}
#endif
#ifndef EMU
__global__ void __launch_bounds__(256, 2) mega(Params p) {
  __shared__ __attribute__((aligned(16))) char smem[SMEM_BYTES];
  cg::grid_group grid = cg::this_grid();
  phase_wprep(p, smem);
#ifdef PROBE
  long long tmix = 0, tproj = 0;
#endif
#pragma unroll 1
  for (int l = 0; l < DEPTH; l++) {
    phase_rmsnorm(p, l); grid.sync();
#ifdef PROBE
    long long t0 = wall_clock64();
#endif
    phase_proj(p, l, smem); grid.sync();
#ifdef PROBE
    if (l == 0) tproj = wall_clock64() - t0;
#endif
    phase_prep(p, l, smem); grid.sync();
#ifdef PROBE
    t0 = wall_clock64();
#endif
    phase_mixers(p, l, smem); grid.sync();
#ifdef PROBE
    if (l == 0) tmix = wall_clock64() - t0;
#endif
    phase_merge(p, l, smem); grid.sync();
    phase_yout(p, l, smem); grid.sync();
  }
#ifdef PROBE
  long long* pr = (long long*)(p.ws + W_CNT + 64);
  if (blockIdx.x == 0 && threadIdx.x == 0) { pr[0] = tmix; pr[1] = tproj; }
  grid.sync();
  { const long long a = pr[0], b = pr[1];
    const long long q = (b + 25000) / 50000;
    const long long delay = a + 2000000LL * q + 40000000LL * (p.percu - 1);
    const long long te = wall_clock64() + delay;
    while (wall_clock64() < te) __builtin_amdgcn_s_sleep(20);
  }
#endif
}
extern "C" void kernel_launch(void* const* d_in, const int* in_sizes, int n_in, void* d_out, int out_size, void* d_ws, size_t ws_size, hipStream_t stream) {
  Params p{};
  for (int i = 0; i < 32; i++) p.in[i] = (const float*)d_in[i];
  p.out = (float*)d_out; p.ws = (char*)d_ws;
  if (ws_size < WS_TOTAL) { fprintf(stderr, "workspace too small: %zu < %zu\n", ws_size, (size_t)WS_TOTAL); return; }
  hipMemsetAsync((char*)d_ws + W_CNT, 0, 256, stream);
  static int grid_blocks = 0;
  if (!grid_blocks) {
    int dev = 0, cus = 0, per_cu = 0;
    hipGetDevice(&dev);
    hipDeviceGetAttribute(&cus, hipDeviceAttributeMultiprocessorCount, dev);
    hipOccupancyMaxActiveBlocksPerMultiprocessor(&per_cu, mega, 256, 0);
    if (per_cu > 2) per_cu = 2;
    grid_blocks = cus * per_cu;
  }
#ifdef PROBE
  p.percu = grid_blocks / 256;
#endif
  void* args[] = { &p };
  hipError_t e = hipLaunchCooperativeKernel((void*)mega, dim3(grid_blocks), dim3(256), args, 0, stream);
  if (e != hipSuccess) fprintf(stderr, "cooperative launch failed: %s (grid %d)\n", hipGetErrorString(e), grid_blocks);
}
#endif
```

```cpp
#ifdef EMU
#include "emu.h"
#define MFMA32(a, b, c) emu_mfma32(a, b, c)
#else
#include <hip/hip_runtime.h>
#include <hip/hip_cooperative_groups.h>
#include <cstdio>
namespace cg = cooperative_groups;
typedef short bf16x8 __attribute__((ext_vector_type(8)));
typedef float f32x16 __attribute__((ext_vector_type(16)));
#define MFMA32(a, b, c) __builtin_amdgcn_mfma_f32_32x32x16_bf16(a, b, c, 0, 0, 0)
#endif

#ifdef EMU
#define TID() ((int)threadIdx.x)
#define BID() ((int)blockIdx.x)
#else
static __device__ __forceinline__ int TID() { int t = threadIdx.x; asm volatile("" : "+v"(t)); return t; }
static __device__ __forceinline__ int BID() { int t = blockIdx.x; asm volatile("" : "+s"(t)); return t; }
#endif
#define DI __device__ __forceinline__
#if defined(__HIP_DEVICE_COMPILE__)
#define SETPRIO(n) __builtin_amdgcn_s_setprio(n)
#else
#define SETPRIO(n)
#endif
#ifdef EMU
#define DPP_XOR1(x) emu_lane_perm(x, 0)
#define DPP_XOR2(x) emu_lane_perm(x, 1)
#define DPP_HMIR(x) emu_lane_perm(x, 2)
#define DPP_RMIR(x) emu_lane_perm(x, 3)
#else
#define DPP_F(x, c) __builtin_bit_cast(float, __builtin_amdgcn_update_dpp(0, __builtin_bit_cast(int, (float)(x)), c, 0xF, 0xF, true))
#define DPP_XOR1(x) DPP_F(x, 0xB1)
#define DPP_XOR2(x) DPP_F(x, 0x4E)
#define DPP_HMIR(x) DPP_F(x, 0x141)
#define DPP_RMIR(x) DPP_F(x, 0x140)
#endif
#ifdef EMU
#define EXP2(x) exp2f(x)
#else
#define EXP2(x) __builtin_amdgcn_exp2f(x)
#endif
#ifdef EMU
#define SCHED_BARRIER()
#else
#define SCHED_BARRIER() __builtin_amdgcn_sched_barrier(0)
#endif
typedef unsigned short bf16;

#ifdef SMALL
constexpr int D = 128, NB = 2, T = 256, NSB = 2, TS = 64, PAST = 128, AH = 2, BH = 1, CH = 2;
#else
constexpr int D = 1024, NB = 8, T = 8192, NSB = 16, TS = 64, PAST = 1024, AH = 8, BH = 8, CH = 16;
#endif
constexpr int DEPTH = 2;
constexpr int AQK = AH * 128, AW = AH * 128, BQK = BH * 128, BW = BH * 128, CW = CH * 64;
constexpr int CSH = 3 * CW + 128;
constexpr int O_AQ = 0, O_AK = AQK, O_AV = 2 * AQK, O_AG = O_AV + AW, O_BQ = O_AG + AW, O_BF = O_BQ + BQK, O_BI = O_BF + BQK,
              O_BG = O_BI + BW, O_CP = O_BG + BW, O_CG = O_CP + CSH, O_MA = O_CG + CW, O_MB = O_MA + D, O_MC = O_MB + D, NC = O_MC + D;
constexpr int CP_R = 0, CP_WLO = CW, CP_K = CW + 64, CP_V = 2 * CW + 64, CP_ALO = 3 * CW + 64;
constexpr int MP = NB * T, MS = NSB * TS, M = MP + MS, NSEQ = NB + NSB, KS = PAST + TS;
constexpr int NCHK = M / 64, PCH = T / 64, SCH = TS / 64;
constexpr int MAXPOS = (T > KS ? T : KS);
constexpr float EPS = 1e-6f;

constexpr size_t OO_Y = 0;
constexpr size_t OO_KP = (size_t)M * D;
constexpr size_t OO_VP = OO_KP + (size_t)DEPTH * MP * AQK;
constexpr size_t OO_HP = OO_VP + (size_t)DEPTH * MP * AW;
constexpr size_t OO_RP = OO_HP + (size_t)DEPTH * NB * BH * 16384;
constexpr size_t OO_SP = OO_RP + (size_t)DEPTH * NB * CH * 4096;
constexpr size_t OO_KS = OO_SP + (size_t)DEPTH * NB * CSH;
constexpr size_t OO_VS = OO_KS + (size_t)DEPTH * MS * AQK;
constexpr size_t OO_HS = OO_VS + (size_t)DEPTH * MS * AW;
constexpr size_t OO_RS = OO_HS + (size_t)DEPTH * NSB * BH * 16384;
constexpr size_t OO_SS = OO_RS + (size_t)DEPTH * NSB * CH * 4096;
constexpr size_t OUT_TOTAL = OO_SS + (size_t)DEPTH * NSB * CSH;

constexpr size_t al256(size_t x) { return (x + 255) & ~(size_t)255; }
constexpr size_t W_PROJ = 0;
constexpr size_t W_HN = al256(W_PROJ + (size_t)M * NC * 2);
constexpr size_t W_HGX = al256(W_HN + (size_t)M * D * 2);
constexpr size_t W_DL = al256(W_HGX + (size_t)NCHK * BH * 2 * 8192 * 2);
constexpr size_t W_RWW = al256(W_DL + (size_t)NCHK * BH * 128 * 4);
constexpr size_t W_RWR = al256(W_RWW + (size_t)M * CW * 4);
constexpr size_t W_RWK = al256(W_RWR + (size_t)M * CW * 2);
constexpr size_t W_RWA = al256(W_RWK + (size_t)M * CW * 2);
constexpr size_t W_RWB = al256(W_RWA + (size_t)M * CW * 2);
constexpr size_t W_RWV0 = al256(W_RWB + (size_t)M * CW * 2);
constexpr size_t W_RWV1 = al256(W_RWV0 + (size_t)M * CW * 2);
constexpr size_t W_VTP = al256(W_RWV1 + (size_t)M * CW * 2);
constexpr size_t W_KBS = al256(W_VTP + (size_t)NB * AH * 128 * T * 2);
constexpr size_t W_VTS = al256(W_KBS + (size_t)NSB * AH * KS * 128 * 2);
constexpr size_t W_WT = al256(W_VTS + (size_t)NSB * AH * 128 * KS * 2);
constexpr size_t WT_IN = 0, WT_OA = (size_t)NC * D, WT_OB = WT_OA + (size_t)D * AW, WT_OC = WT_OB + (size_t)D * BW, WT_OO = WT_OC + (size_t)D * CW,
                 WT_LAYER = WT_OO + (size_t)D * D;
constexpr size_t W_ROPE = al256(W_WT + (size_t)DEPTH * WT_LAYER * 2);
constexpr size_t W_CNT = al256(W_ROPE + (size_t)MAXPOS * 16 * 4);
constexpr size_t W_W2T = al256(W_CNT + 256);
constexpr size_t W_A2T = al256(W_W2T + (size_t)DEPTH * CW * 64 * 2);
constexpr size_t W_VW2T = al256(W_A2T + (size_t)DEPTH * CW * 64 * 2);
constexpr size_t W_W1T = al256(W_VW2T + (size_t)CW * 32 * 2);
constexpr size_t WS_TOTAL = W_W1T + (size_t)32 * D * 2;

struct Params { const float* in[32]; float* out; char* ws; long long percu; };

enum { I_XP, I_XS, I_CK, I_CV, I_SH, I_SR, I_SS, I_NG, I_WIN, I_QNG, I_KNG, I_LAM, I_SUBG, I_BLOW, I_BNG, I_MU, I_W0, I_W2, I_A0, I_A2,
       I_KK, I_KA, I_RK, I_LNW, I_LNB, I_VW1, I_VW2, I_V0, I_WOA, I_WOB, I_WOC, I_WO };

#ifdef EMU
DI bf16 f2bf(float x) { unsigned u = __float_as_uint(x); u += 0x7fffu + ((u >> 16) & 1u); return (bf16)(u >> 16); }
#else
DI bf16 f2bf(float x) { __bf16 b = (__bf16)x; return __builtin_bit_cast(unsigned short, b); }
#endif
DI float bf2f(bf16 s) { return __uint_as_float(((unsigned)s) << 16); }
DI float sigm(float x) { return 1.0f / (1.0f + __expf(-x)); }
DI float siluf(float x) { return x / (1.0f + __expf(-x)); }
union V8 { bf16x8 v; uint4 u; uint2 h[2]; bf16 s[8]; };
union V4 { uint2 u; bf16 s[4]; };
DI void ld8(const bf16* p, float* o) { V8 t; t.u = *(const uint4*)p;
#pragma unroll
  for (int i = 0; i < 8; i++) o[i] = bf2f(t.s[i]); }
DI void ld4(const bf16* p, float* o) { V4 t; t.u = *(const uint2*)p;
#pragma unroll
  for (int i = 0; i < 4; i++) o[i] = bf2f(t.s[i]); }
DI bf16x8 ldfrag16(const bf16* p) { V8 t; t.u = *(const uint4*)p; return t.v; }
DI bf16x8 ldfrag8x2(const bf16* p0, const bf16* p1) { V8 t; t.h[0] = *(const uint2*)p0; t.h[1] = *(const uint2*)p1; return t.v; }
DI bf16x8 pack8(const f32x16& x, int s) { V8 t;
#pragma unroll
  for (int j = 0; j < 8; j++) t.s[j] = f2bf(x[8 * s + j]); return t.v; }
DI f32x16 zero16() { f32x16 z;
#pragma unroll
  for (int i = 0; i < 16; i++) z[i] = 0.f; return z; }
#ifdef EMU
#define SHFL_XOR(v, m) __shfl_xor(v, m)
#else
static __device__ __forceinline__ float SHFL_XOR(float v, int m) { const int lane = TID() & 63; return __builtin_bit_cast(float, __builtin_amdgcn_ds_bpermute((lane ^ m) << 2, __builtin_bit_cast(int, v))); }
#endif
DI float red4(float x) { x += DPP_XOR1(x); x += DPP_XOR2(x); return x; }
DI float red8(float x) { x = red4(x); x += DPP_HMIR(x); return x; }
DI float red16(float x) { x = red8(x); x += DPP_RMIR(x); return x; }
DI int crow(int reg, int h) { return (reg & 3) + 8 * (reg >> 2) + 4 * h; }

struct ChunkInfo { int seq, lc, tok0, pos0; };
DI ChunkInfo chunk_info(int gc) { ChunkInfo c; c.tok0 = gc * 64;
  if (gc < NB * PCH) { c.seq = gc / PCH; c.lc = gc % PCH; c.pos0 = c.lc * 64; }
  else { int r = gc - NB * PCH; c.seq = NB + r / SCH; c.lc = r % SCH; c.pos0 = PAST + c.lc * 64; }
  return c; }
DI int seq_tok0(int seq) { return seq < NB ? seq * T : MP + (seq - NB) * TS; }
DI int seq_len(int seq) { return seq < NB ? T : TS; }

__device__ void transpose_w(const float* src, bf16* dst, int K, int N, float* tile  ) {
  const int tid = TID(); const int nkt = K / 64, nnt = N / 64;
  for (int t = BID(); t < nkt * nnt; t += gridDim.x) {
    const int k0 = (t / nnt) * 64, n0 = (t % nnt) * 64;
    for (int i = 0; i < 16; i++) { int r = i * 4 + tid / 64, c = tid % 64; tile[r * 65 + c] = src[(size_t)(k0 + r) * N + n0 + c]; }
    __syncthreads();
    for (int i = 0; i < 16; i++) { int n = i * 4 + tid / 64, k = tid % 64; dst[(size_t)(n0 + n) * K + k0 + k] = f2bf(tile[k * 65 + n]); }
    __syncthreads();
  }
}
__device__ void phase_wprep(const Params& p, char* smem) {
  float* tile = (float*)smem;
  for (int l = 0; l < DEPTH; l++) {
    bf16* wt = (bf16*)(p.ws + W_WT) + (size_t)l * WT_LAYER;
    transpose_w(p.in[I_WIN] + (size_t)l * D * NC, wt + WT_IN, D, NC, tile);
    transpose_w(p.in[I_WOA] + (size_t)l * AW * D, wt + WT_OA, AW, D, tile);
    transpose_w(p.in[I_WOB] + (size_t)l * BW * D, wt + WT_OB, BW, D, tile);
    transpose_w(p.in[I_WOC] + (size_t)l * CW * D, wt + WT_OC, CW, D, tile);
    transpose_w(p.in[I_WO] + (size_t)l * D * D, wt + WT_OO, D, D, tile);
  }
  for (int l = 0; l < DEPTH; l++) {
    transpose_w(p.in[I_W2] + (size_t)l * 64 * CW, (bf16*)(p.ws + W_W2T) + (size_t)l * CW * 64, 64, CW, tile);
    transpose_w(p.in[I_A2] + (size_t)l * 64 * CW, (bf16*)(p.ws + W_A2T) + (size_t)l * CW * 64, 64, CW, tile);
  }
  for (int i = BID() * blockDim.x + TID(); i < 32 * CW; i += gridDim.x * blockDim.x) {
    const int k = i / CW, n = i % CW; ((bf16*)(p.ws + W_VW2T))[n * 32 + k] = f2bf(p.in[I_VW2][i]); }
  for (int i = BID() * blockDim.x + TID(); i < D * 32; i += gridDim.x * blockDim.x) {
    const int k = i / 32, n = i % 32; ((bf16*)(p.ws + W_W1T))[(size_t)n * D + k] = f2bf(p.in[I_VW1][i]); }
  float* rope = (float*)(p.ws + W_ROPE);
  for (int i = BID() * blockDim.x + TID(); i < MAXPOS * 8; i += gridDim.x * blockDim.x) {
    int pos = i / 8, j = i % 8;
    double inv = pow(500000.0, -(double)j / 8.0);
    double ang = (double)pos * inv;
    rope[pos * 16 + j] = (float)cos(ang); rope[pos * 16 + 8 + j] = (float)sin(ang);
  }
}

DI const float* x_row(const Params& p, int l, int m) {
  if (l == 0) return m < MP ? p.in[I_XP] + (size_t)m * D : p.in[I_XS] + (size_t)(m - MP) * D;
  return p.out + OO_Y + (size_t)m * D;
}
__device__ void phase_rmsnorm(const Params& p, int l) {
  const int lane = TID() % 64, w = TID() / 64;
  bf16* hn = (bf16*)(p.ws + W_HN);
  const float* g = p.in[I_NG] + (size_t)l * D;
  for (int m = BID() * 4 + w; m < M; m += gridDim.x * 4) {
    const float* x = x_row(p, l, m);
    float ss = 0.f;
    for (int c = lane * 4; c < D; c += 256) { float4 v = *(const float4*)(x + c); ss += v.x * v.x + v.y * v.y + v.z * v.z + v.w * v.w; }
    for (int o = 32; o >= 1; o >>= 1) ss += SHFL_XOR(ss, o);
    const float rs = rsqrtf(ss / D + EPS);
    for (int c = lane * 4; c < D; c += 256) { float4 v = *(const float4*)(x + c); float4 gg = *(const float4*)(g + c);
      V4 o; o.s[0] = f2bf(v.x * rs * gg.x); o.s[1] = f2bf(v.y * rs * gg.y); o.s[2] = f2bf(v.z * rs * gg.z); o.s[3] = f2bf(v.w * rs * gg.w);
      *(uint2*)(hn + (size_t)m * D + c) = o.u; }
  }
}

constexpr int GLD = 40;
constexpr int GSTAGE = 2 * 128 * GLD;
template <int NJ> DI void gemm_mainloop(const bf16* A, size_t lda, const bf16* Bt, size_t ldb, int K, int m0, int n0, bf16* lds, f32x16 acc[2][NJ]) {
  const int tid = TID(), lane = tid % 64, w = tid / 64, wm = w / 2, wn = w % 2, lr = lane % 32, lh = lane / 32;
  const int nk = K / 32;
  typedef unsigned int u32x4 __attribute__((ext_vector_type(4)));
  u32x4 a00, a01, b00, b01, a10, a11, b10, b11;
  const int r0 = tid / 4, kc = (tid % 4) * 8;
  const bf16* Ap = A + (size_t)(m0 + r0) * lda + kc;
  const bf16* Bp = Bt + (size_t)(n0 + r0) * ldb + kc;
  const int so = r0 * GLD + kc;
#define G_LOAD0(kt) { a00 = *(const u32x4*)(Ap + (kt) * 32); a01 = *(const u32x4*)(Ap + (size_t)64 * lda + (kt) * 32); b00 = *(const u32x4*)(Bp + (kt) * 32); if (NJ == 2) b01 = *(const u32x4*)(Bp + (size_t)64 * ldb + (kt) * 32); }
#define G_LOAD1(kt) { a10 = *(const u32x4*)(Ap + (kt) * 32); a11 = *(const u32x4*)(Ap + (size_t)64 * lda + (kt) * 32); b10 = *(const u32x4*)(Bp + (kt) * 32); if (NJ == 2) b11 = *(const u32x4*)(Bp + (size_t)64 * ldb + (kt) * 32); }
#define G_STORE0(st) { bf16* q = lds + (st) * GSTAGE + so; *(u32x4*)q = a00; *(u32x4*)(q + 64 * GLD) = a01; *(u32x4*)(q + 128 * GLD) = b00; if (NJ == 2) *(u32x4*)(q + 192 * GLD) = b01; }
#define G_STORE1(st) { bf16* q = lds + (st) * GSTAGE + so; *(u32x4*)q = a10; *(u32x4*)(q + 64 * GLD) = a11; *(u32x4*)(q + 128 * GLD) = b10; if (NJ == 2) *(u32x4*)(q + 192 * GLD) = b11; }
#define G_COMPUTE(st) { const bf16* sAc = lds + (st) * GSTAGE; const bf16* sBc = sAc + 128 * GLD; \
    _Pragma("unroll") for (int ks = 0; ks < 2; ks++) { bf16x8 fa[2], fb[NJ]; \
      _Pragma("unroll") for (int i = 0; i < 2; i++) { fa[i] = ldfrag16(sAc + (wm * 64 + i * 32 + lr) * GLD + ks * 16 + lh * 8); \
        if (i < NJ) fb[i] = ldfrag16(sBc + (wn * 32 * NJ + i * 32 + lr) * GLD + ks * 16 + lh * 8); } \
      _Pragma("unroll") for (int i = 0; i < 2; i++) _Pragma("unroll") for (int j = 0; j < NJ; j++) acc[i][j] = MFMA32(fa[i], fb[j], acc[i][j]); } }
  G_LOAD0(0)
  G_LOAD1(1)
  G_STORE0(0)
  __syncthreads();
  int st = 0;
  for (int kt = 0; kt < nk; kt += 2) {
    const int st1 = st == 2 ? 0 : st + 1, st2 = st1 == 2 ? 0 : st1 + 1;
    if (kt + 2 < nk) G_LOAD0(kt + 2)
    G_COMPUTE(st)
    G_STORE1(st1)
    __syncthreads();
    if (kt + 3 < nk) G_LOAD1(kt + 3)
    G_COMPUTE(st1)
    if (kt + 2 < nk) G_STORE0(st2)
    __syncthreads();
    st = st2;
  }
#undef G_LOAD0
#undef G_LOAD1
#undef G_STORE0
#undef G_STORE1
#undef G_COMPUTE
}

__device__ void phase_proj(const Params& p, int l, char* smem) {
  const bf16* hn = (const bf16*)(p.ws + W_HN);
  const bf16* wt = (const bf16*)(p.ws + W_WT) + (size_t)l * WT_LAYER + WT_IN;
  bf16* proj = (bf16*)(p.ws + W_PROJ);
  const int lane = TID() % 64, w = TID() / 64, wm = w / 2, wn = w % 2, lr = lane % 32, lh = lane / 32;
  constexpr int NT = NC / 128, MT = M / 128;
  constexpr int MG = 4, NGRP = (MT + MG - 1) / MG;
  const int bid = BID(), xcd = bid % 8, lb = bid / 8, nlb = ((int)gridDim.x + 7 - xcd) / 8;
  const int ngx = (NGRP - xcd + 7) / 8;
  for (int it = lb; it < ngx * NT * MG; it += nlb) {
    const int g = xcd + 8 * (it / (NT * MG)), r = it % (NT * MG);
    const int mt = g * MG + r % MG, nt = r / MG;
    if (mt >= MT) continue;
    const int m0 = mt * 128, n0 = nt * 128;
    f32x16 acc[2][2];
#pragma unroll
    for (int i = 0; i < 2; i++)
#pragma unroll
      for (int j = 0; j < 2; j++) acc[i][j] = zero16();
    gemm_mainloop<2>(hn, D, wt, D, D, m0, n0, (bf16*)smem, acc);
#pragma unroll
    for (int i = 0; i < 2; i++)
#pragma unroll
      for (int j = 0; j < 2; j++)
#pragma unroll
        for (int r = 0; r < 16; r++) {
          const int row = m0 + wm * 64 + i * 32 + crow(r, lh), col = n0 + wn * 64 + j * 32 + lr;
          proj[(size_t)row * NC + col] = f2bf(acc[i][j][r]);
        }
  }
}

__device__ void phase_merge(const Params& p, int l, char* smem) {
  const bf16* proj = (const bf16*)(p.ws + W_PROJ);
  const bf16* wt = (const bf16*)(p.ws + W_WT) + (size_t)l * WT_LAYER;
  bf16* mrg = (bf16*)(p.ws + W_HN);
  const int lane = TID() % 64, w = TID() / 64, wm = w / 2, wn = w % 2, lr = lane % 32, lh = lane / 32;
  constexpr int NT = D / 64, MT = M / 128;
  for (int t = BID(); t < MT * NT; t += gridDim.x) {
    const int m0 = (t / NT) * 128, n0 = (t % NT) * 64;
    f32x16 tot[2];
    tot[0] = zero16(); tot[1] = zero16();
#pragma unroll 1
    for (int mx = 0; mx < 3; mx++) {
      f32x16 acc[2][1];
      acc[0][0] = zero16(); acc[1][0] = zero16();
      const int acol = mx == 0 ? O_AQ : (mx == 1 ? O_BQ : O_CP);
      const int Kx = mx == 0 ? AW : (mx == 1 ? BW : CW);
      const size_t woff = mx == 0 ? WT_OA : (mx == 1 ? WT_OB : WT_OC);
      const int gcol = O_MA + mx * D;
      gemm_mainloop<1>(proj + acol, NC, wt + woff, Kx, Kx, m0, n0, (bf16*)smem, acc);
#pragma unroll
      for (int i = 0; i < 2; i++)
#pragma unroll
        for (int r = 0; r < 16; r++) {
          const int row = m0 + wm * 64 + i * 32 + crow(r, lh), col = n0 + wn * 32 + lr;
          tot[i][r] += sigm(bf2f(proj[(size_t)row * NC + gcol + col])) * acc[i][0][r];
        }
    }
#pragma unroll
    for (int i = 0; i < 2; i++)
#pragma unroll
      for (int r = 0; r < 16; r++) {
        const int row = m0 + wm * 64 + i * 32 + crow(r, lh), col = n0 + wn * 32 + lr;
        mrg[(size_t)row * D + col] = f2bf(tot[i][r]);
      }
  }
}

__device__ void phase_yout(const Params& p, int l, char* smem) {
  const bf16* mrg = (const bf16*)(p.ws + W_HN);
  const bf16* wt = (const bf16*)(p.ws + W_WT) + (size_t)l * WT_LAYER + WT_OO;
  const int lane = TID() % 64, w = TID() / 64, wm = w / 2, wn = w % 2, lr = lane % 32, lh = lane / 32;
  constexpr int NT = D / 128, MT = M / 128;
  for (int t = BID(); t < MT * NT; t += gridDim.x) {
    const int m0 = (t / NT) * 128, n0 = (t % NT) * 128;
    f32x16 acc[2][2];
#pragma unroll
    for (int i = 0; i < 2; i++)
#pragma unroll
      for (int j = 0; j < 2; j++) acc[i][j] = zero16();
    gemm_mainloop<2>(mrg, D, wt, D, D, m0, n0, (bf16*)smem, acc);
#pragma unroll
    for (int i = 0; i < 2; i++)
#pragma unroll
      for (int j = 0; j < 2; j++)
#pragma unroll
        for (int r = 0; r < 16; r++) {
          const int row = m0 + wm * 64 + i * 32 + crow(r, lh), col = n0 + wn * 64 + j * 32 + lr;
          const float xv = x_row(p, l, row)[col];
          p.out[OO_Y + (size_t)row * D + col] = xv + acc[i][j][r];
        }
  }
}

__device__ void prep_attn_chunk(const Params& p, int l, int gc, char* smem) {
  const int tid = TID();
  const ChunkInfo ci = chunk_info(gc);
  bf16* proj = (bf16*)(p.ws + W_PROJ);
  const float* rope = (const float*)(p.ws + W_ROPE);
  const float* qg = p.in[I_QNG] + l * 64; const float* kg = p.in[I_KNG] + l * 64;
  const bool samp = ci.seq >= NB; const int sb = ci.seq - NB;
  const int sub = tid % 8;
  constexpr int NVEC = 64 * 2 * AH * 2;
  for (int v0 = 0; v0 < NVEC; v0 += 128) {
    float xx[4][8];
#pragma unroll
    for (int u = 0; u < 4; u++) {
      const int vi = v0 + u * 32 + tid / 8;
      const int t = vi / (4 * AH), rem = vi % (4 * AH), isk = rem / (2 * AH), hn2 = rem % (2 * AH);
      ld8(proj + (size_t)(ci.tok0 + t) * NC + (isk ? O_AK : O_AQ) + hn2 * 64 + sub * 8, xx[u]);
    }
#pragma unroll
    for (int u = 0; u < 4; u++) {
      const int vi = v0 + u * 32 + tid / 8;
      const int t = vi / (4 * AH), rem = vi % (4 * AH), isk = rem / (2 * AH), hn2 = rem % (2 * AH);
      const int tok = ci.tok0 + t, pos = ci.pos0 + t;
      bf16* src = proj + (size_t)tok * NC + (isk ? O_AK : O_AQ) + hn2 * 64 + sub * 8;
      float* x = xx[u];
      float ss = 0.f;
#pragma unroll
      for (int i = 0; i < 8; i++) ss += x[i] * x[i];
      ss = red8(ss);
      const float rs = rsqrtf(ss / 64.f + EPS);
      const float* g = isk ? kg : qg;
#pragma unroll
      for (int i = 0; i < 8; i++) x[i] = x[i] * rs * g[sub * 8 + i];
      float y[8];
#pragma unroll
      for (int i = 0; i < 8; i++) y[i] = DPP_XOR1(x[i]);
      if (sub < 2) {
#pragma unroll
        for (int i = 0; i < 8; i++) { const float c = rope[pos * 16 + i], sn = rope[pos * 16 + 8 + i];
          x[i] = (sub == 0) ? (x[i] * c - y[i] * sn) : (x[i] * c + y[i] * sn); }
      }
      if (isk) {
        float* ko = p.out + (samp ? OO_KS + ((size_t)l * MS + (tok - MP)) * AQK : OO_KP + ((size_t)l * MP + tok) * AQK) + hn2 * 64 + sub * 8;
        *(float4*)ko = make_float4(x[0], x[1], x[2], x[3]); *(float4*)(ko + 4) = make_float4(x[4], x[5], x[6], x[7]);
        V8 o;
#pragma unroll
        for (int i = 0; i < 8; i++) o.s[i] = f2bf(x[i]);
        if (samp) { bf16* kb = (bf16*)(p.ws + W_KBS) + ((size_t)(sb * AH + hn2 / 2) * KS + PAST + ci.lc * 64 + t) * 128 + (hn2 % 2) * 64 + sub * 8; *(uint4*)kb = o.u; }
        else *(uint4*)src = o.u;
      } else {
        V8 o;
#pragma unroll
        for (int i = 0; i < 8; i++) o.s[i] = f2bf(x[i] * (0.125f * 1.44269504088896f));
        *(uint4*)src = o.u;
      }
    }
  }
  bf16* tile = (bf16*)smem;
  for (int h = 0; h < AH; h++) {
    __syncthreads();
    for (int i = 0; i < 4; i++) { const int c = tid + i * 256, t = c / 16, d8 = (c % 16) * 8; const int tok = ci.tok0 + t;
      const bf16* src = proj + (size_t)tok * NC + O_AV + h * 128 + d8;
      V8 u; u.u = *(const uint4*)src;
      *(uint4*)(tile + t * 136 + d8) = u.u;
      float* vo = p.out + (samp ? OO_VS + ((size_t)l * MS + (tok - MP)) * AW : OO_VP + ((size_t)l * MP + tok) * AW) + h * 128 + d8;
      *(float4*)vo = make_float4(bf2f(u.s[0]), bf2f(u.s[1]), bf2f(u.s[2]), bf2f(u.s[3]));
      *(float4*)(vo + 4) = make_float4(bf2f(u.s[4]), bf2f(u.s[5]), bf2f(u.s[6]), bf2f(u.s[7])); }
    __syncthreads();
    { const int dv = tid / 2, th = tid % 2;
      bf16* dst = samp ? (bf16*)(p.ws + W_VTS) + ((size_t)(sb * AH + h) * 128 + dv) * KS + PAST + ci.lc * 64 + th * 32
                       : (bf16*)(p.ws + W_VTP) + ((size_t)(ci.seq * AH + h) * 128 + dv) * T + ci.lc * 64 + th * 32;
#pragma unroll
      for (int q = 0; q < 4; q++) { V8 o;
#pragma unroll
        for (int i = 0; i < 8; i++) o.s[i] = tile[(th * 32 + (q >> 1) * 16 + (q & 1) * 4 + (i >> 2) * 8 + (i & 3)) * 136 + dv];
        *(uint4*)(dst + q * 8) = o.u; } }
  }
  __syncthreads();
}
__device__ void prep_past_tile(const Params& p, int l, int item, char* smem) {
  const int tid = TID();
  constexpr int NKT = PAST / 64;
  const int kt = item % NKT, h = (item / NKT) % AH, sb = item / (NKT * AH);
  const float* ck = p.in[I_CK] + (((size_t)l * NSB + sb) * PAST + kt * 64) * AQK + h * 128;
  const float* cv = p.in[I_CV] + (((size_t)l * NSB + sb) * PAST + kt * 64) * AW + h * 128;
  bf16* kb = (bf16*)(p.ws + W_KBS) + ((size_t)(sb * AH + h) * KS + kt * 64) * 128;
  bf16* tile = (bf16*)smem;
  __syncthreads();
  for (int i = 0; i < 4; i++) { const int c = tid + i * 256, t = c / 16, d8 = (c % 16) * 8;
    float4 a = *(const float4*)(ck + (size_t)t * AQK + d8), b = *(const float4*)(ck + (size_t)t * AQK + d8 + 4);
    V8 o; o.s[0] = f2bf(a.x); o.s[1] = f2bf(a.y); o.s[2] = f2bf(a.z); o.s[3] = f2bf(a.w); o.s[4] = f2bf(b.x); o.s[5] = f2bf(b.y); o.s[6] = f2bf(b.z); o.s[7] = f2bf(b.w);
    *(uint4*)(kb + (size_t)t * 128 + d8) = o.u;
    a = *(const float4*)(cv + (size_t)t * AW + d8); b = *(const float4*)(cv + (size_t)t * AW + d8 + 4);
    o.s[0] = f2bf(a.x); o.s[1] = f2bf(a.y); o.s[2] = f2bf(a.z); o.s[3] = f2bf(a.w); o.s[4] = f2bf(b.x); o.s[5] = f2bf(b.y); o.s[6] = f2bf(b.z); o.s[7] = f2bf(b.w);
    *(uint4*)(tile + t * 136 + d8) = o.u; }
  __syncthreads();
  { const int dv = tid / 2, th = tid % 2;
    bf16* dst = (bf16*)(p.ws + W_VTS) + ((size_t)(sb * AH + h) * 128 + dv) * KS + kt * 64 + th * 32;
#pragma unroll
    for (int q = 0; q < 4; q++) { V8 o;
#pragma unroll
      for (int i = 0; i < 8; i++) o.s[i] = tile[(th * 32 + (q >> 1) * 16 + (q & 1) * 4 + (i >> 2) * 8 + (i & 3)) * 136 + dv];
      *(uint4*)(dst + q * 8) = o.u; } }
  __syncthreads();
}
__device__ void prep_hgrn(const Params& p, int l, int item, char* smem) {
  const int tid = TID(), k = tid % 128, th = tid / 128;
  const int gc = item / BH, h = item % BH;
  const ChunkInfo ci = chunk_info(gc);
  bf16* proj = (bf16*)(p.ws + W_PROJ);
  float* tot = (float*)smem;
  float lb = 0.f;
  if (l == 1) { const float b0 = p.in[I_BLOW][h * 128 + k], b1 = p.in[I_BLOW][BQK + h * 128 + k]; lb = 1.f / (1.f + __expf(b0 - b1)); }
  float zs[32], cs[32];
  bf16* base = proj + (size_t)(ci.tok0 + th * 32) * NC + h * 128 + k;
  float run = 0.f;
#pragma unroll
  for (int i = 0; i < 32; i++) { const float z = bf2f(base[(size_t)i * NC + O_BF]); zs[i] = z; const float f = lb + (1.f - lb) * sigm(z); run += __logf(f); cs[i] = run; }
  __syncthreads();
  tot[th * 128 + k] = run;
  __syncthreads();
  const float t0 = tot[k], t1 = tot[128 + k];
  const float ref = t0, last = t0 + t1, off = th ? t0 : 0.f;
  V8 kt8[4], it8[4];
#pragma unroll
  for (int i = 0; i < 32; i++) {
    const float cum = cs[i] + off, z = zs[i];
    const float kin = (1.f - lb) * sigm(-z);
    const float qv = siluf(bf2f(base[(size_t)i * NC + O_BQ]));
    const bf16 iv = base[(size_t)i * NC + O_BI];
    base[(size_t)i * NC + O_BQ] = f2bf(qv * __expf(fminf(cum - ref, 80.f)));
    base[(size_t)i * NC + O_BF] = f2bf(kin * __expf(fminf(ref - cum, 80.f)));
    base[(size_t)i * NC + O_BI] = f2bf(qv * __expf(cum));
    kt8[i / 8].s[i % 8] = f2bf(kin * __expf(last - cum));
    it8[i / 8].s[i % 8] = iv;
  }
  bf16* hgx = (bf16*)(p.ws + W_HGX) + (size_t)item * 2 * 8192;
#pragma unroll
  for (int q = 0; q < 4; q++) { *(uint4*)(hgx + k * 64 + th * 32 + q * 8) = kt8[q].u; *(uint4*)(hgx + 8192 + k * 64 + th * 32 + q * 8) = it8[q].u; }
  if (th == 0) ((float*)(p.ws + W_DL))[(size_t)item * 128 + k] = __expf(last);
  __syncthreads();
}
__device__ void prep_rwkv(const Params& p, int l, int ti, char* smem) {
  const int tid = TID(), lane = tid % 64, w = tid / 64, lr = lane % 32, lh = lane / 32;
  const int tok0 = ti * 32;
  const ChunkInfo ci = chunk_info(tok0 / 64);
  const int seqt0 = seq_tok0(ci.seq);
  const bf16* proj = (const bf16*)(p.ws + W_PROJ);
  const bf16* hn = (const bf16*)(p.ws + W_HN);
  const float* mu = p.in[I_MU] + (size_t)l * CSH;
  const float* shp = (ci.seq >= NB) ? p.in[I_SS] + ((size_t)l * NSB + (ci.seq - NB)) * CSH : nullptr;
  bf16* twb = (bf16*)smem;
  bf16* alb = twb + 32 * 72;
  bf16* hvb = alb + 32 * 72;
  float* part = (float*)(hvb + 32 * 40);
  __syncthreads();
  {
    const int t = tid / 8, j8 = (tid % 8) * 8; const int tok = tok0 + t;
#pragma unroll
    for (int which = 0; which < 2; which++) {
      const int col = (which == 0 ? CP_WLO : CP_ALO) + j8;
      float cur[8], prv[8];
      ld8(proj + (size_t)tok * NC + O_CP + col, cur);
      if (tok == seqt0) {
#pragma unroll
        for (int i = 0; i < 8; i++) prv[i] = shp ? shp[col + i] : 0.f;
      } else ld8(proj + (size_t)(tok - 1) * NC + O_CP + col, prv);
      V8 o;
#pragma unroll
      for (int i = 0; i < 8; i++) { const float v = cur[i] + (prv[i] - cur[i]) * mu[col + i]; o.s[i] = f2bf(which == 0 ? tanhf(v) : v); }
      *(uint4*)((which == 0 ? twb : alb) + t * 72 + j8) = o.u;
    }
  }
  if (l > 0) {
    f32x16 acc = zero16();
    const bf16* w1t = (const bf16*)(p.ws + W_W1T);
    const bf16* ap = hn + (size_t)(tok0 + lr) * D + w * (D / 4) + lh * 8;
    const bf16* bp = w1t + (size_t)lr * D + w * (D / 4) + lh * 8;
#pragma unroll 4
    for (int ks = 0; ks < D / 64; ks++) acc = MFMA32(ldfrag16(ap + ks * 16), ldfrag16(bp + ks * 16), acc);
#pragma unroll
    for (int r = 0; r < 16; r++) part[(w * 32 + crow(r, lh)) * 33 + lr] = acc[r];
    __syncthreads();
    { const int t = tid / 8, j4 = (tid % 8) * 4;
#pragma unroll
      for (int jj = 0; jj < 4; jj++) { const float sv = part[t * 33 + j4 + jj] + part[(32 + t) * 33 + j4 + jj] + part[(64 + t) * 33 + j4 + jj] + part[(96 + t) * 33 + j4 + jj];
        hvb[t * 40 + j4 + jj] = f2bf(sv); } }
  }
  __syncthreads();
  const bf16* w2t = (const bf16*)(p.ws + W_W2T) + (size_t)l * CW * 64;
  const bf16* a2t = (const bf16*)(p.ws + W_A2T) + (size_t)l * CW * 64;
  const bf16* vw2t = (const bf16*)(p.ws + W_VW2T);
  float* rww = (float*)(p.ws + W_RWW);
  bf16* rwr = (bf16*)(p.ws + W_RWR); bf16* rwk = (bf16*)(p.ws + W_RWK); bf16* rwa = (bf16*)(p.ws + W_RWA); bf16* rwb = (bf16*)(p.ws + W_RWB);
  bf16* rwv = (bf16*)(p.ws + (l == 0 ? W_RWV0 : W_RWV1)); const bf16* vfirst = (const bf16*)(p.ws + W_RWV0);
#pragma unroll 1
  for (int head = w; head < CH; head += 4) {
    f32x16 aw[2], aa[2], vm[2];
#pragma unroll
    for (int ct = 0; ct < 2; ct++) { aw[ct] = zero16(); aa[ct] = zero16(); vm[ct] = zero16(); }
    const int chb = head * 64 + lr;
#pragma unroll
    for (int ks = 0; ks < 4; ks++) {
      SCHED_BARRIER();
      const bf16x8 twf = ldfrag16(twb + lr * 72 + ks * 16 + lh * 8), alf = ldfrag16(alb + lr * 72 + ks * 16 + lh * 8);
#pragma unroll
      for (int ct = 0; ct < 2; ct++) {
        aw[ct] = MFMA32(twf, ldfrag16(w2t + (size_t)(chb + ct * 32) * 64 + ks * 16 + lh * 8), aw[ct]);
        aa[ct] = MFMA32(alf, ldfrag16(a2t + (size_t)(chb + ct * 32) * 64 + ks * 16 + lh * 8), aa[ct]);
      }
    }
    if (l > 0) {
#pragma unroll
      for (int ks = 0; ks < 2; ks++) {
        SCHED_BARRIER();
        const bf16x8 hvf = ldfrag16(hvb + lr * 40 + ks * 16 + lh * 8);
#pragma unroll
        for (int ct = 0; ct < 2; ct++) vm[ct] = MFMA32(hvf, ldfrag16(vw2t + (size_t)(chb + ct * 32) * 32 + ks * 16 + lh * 8), vm[ct]);
      }
    }
    SCHED_BARRIER();
    float w0c[2], a0c[2], kkc[2], kac[2], v0c[2], mur[2], muk[2], muv[2];
#pragma unroll
    for (int ct = 0; ct < 2; ct++) { const int ch = chb + ct * 32;
      w0c[ct] = p.in[I_W0][(size_t)l * CW + ch]; a0c[ct] = p.in[I_A0][(size_t)l * CW + ch]; kkc[ct] = p.in[I_KK][(size_t)l * CW + ch]; kac[ct] = p.in[I_KA][(size_t)l * CW + ch];
      v0c[ct] = l > 0 ? p.in[I_V0][(size_t)(l - 1) * CW + ch] : 0.f;
      mur[ct] = mu[CP_R + ch]; muk[ct] = mu[CP_K + ch]; muv[ct] = mu[CP_V + ch]; }
#pragma unroll
    for (int rg = 0; rg < 16; rg++) {
      SCHED_BARRIER();
      float cr[1][2], ck[1][2], cv[1][2], pr[1][2], pk[1][2], pv[1][2], vf[1][2];
#pragma unroll
      for (int q = 0; q < 1; q++) {
        const int t = crow(rg + q, lh), tok = tok0 + t;
#pragma unroll
        for (int ct = 0; ct < 2; ct++) { const int ch = chb + ct * 32;
          const bf16* cp = proj + (size_t)tok * NC + O_CP + ch;
          cr[q][ct] = bf2f(cp[CP_R]); ck[q][ct] = bf2f(cp[CP_K]); cv[q][ct] = bf2f(cp[CP_V]);
          if (tok == seqt0) { pr[q][ct] = shp ? shp[CP_R + ch] : 0.f; pk[q][ct] = shp ? shp[CP_K + ch] : 0.f; pv[q][ct] = shp ? shp[CP_V + ch] : 0.f; }
          else { pr[q][ct] = bf2f(cp[CP_R - NC]); pk[q][ct] = bf2f(cp[CP_K - NC]); pv[q][ct] = bf2f(cp[CP_V - NC]); }
          vf[q][ct] = l > 0 ? bf2f(vfirst[(size_t)tok * CW + ch]) : 0.f; }
      }
#pragma unroll
      for (int q = 0; q < 1; q++) {
        const int r = rg + q, t = crow(r, lh), tok = tok0 + t;
        float rr[2], kk[2], vv[2], ww[2], a[2], kt[2];
        float ss = 0.f;
#pragma unroll
        for (int ct = 0; ct < 2; ct++) {
          rr[ct] = cr[q][ct] + (pr[q][ct] - cr[q][ct]) * mur[ct];
          const float kx = ck[q][ct] + (pk[q][ct] - ck[q][ct]) * muk[ct];
          float vx = cv[q][ct] + (pv[q][ct] - cv[q][ct]) * muv[ct];
          const float u = w0c[ct] + aw[ct][r];
          const float sp = fmaxf(-u, 0.f) + log1pf(__expf(-fabsf(u)));
          ww[ct] = __expf(-__expf(-sp - 0.5f));
          a[ct] = sigm(a0c[ct] + aa[ct][r]);
          if (l > 0) vx = vx + (vf[q][ct] - vx) * sigm(v0c[ct] + vm[ct][r]);
          vv[ct] = vx;
          kk[ct] = kx * kkc[ct];
          ss += kk[ct] * kk[ct];
          kt[ct] = kx * (1.f + (a[ct] - 1.f) * kac[ct]);
        }
        ss = red16(ss); ss += SHFL_XOR(ss, 16);
        const float inv = 1.f / fmaxf(sqrtf(ss), 1e-12f);
#pragma unroll
        for (int ct = 0; ct < 2; ct++) { const size_t o = (size_t)tok * CW + chb + ct * 32;
          const float kn = kk[ct] * inv;
          rww[o] = ww[ct]; rwr[o] = f2bf(rr[ct]); rwk[o] = f2bf(kt[ct]); rwv[o] = f2bf(vv[ct]); rwa[o] = f2bf(-kn); rwb[o] = f2bf(kn * a[ct]); }
      }
    }
  }
  __syncthreads();
}
__device__ void phase_prep(const Params& p, int l, char* smem) {
#ifndef SUBMASK
#define SUBMASK 15
#endif
  if (SUBMASK & 1) for (int gc = BID(); gc < NCHK; gc += gridDim.x) prep_attn_chunk(p, l, gc, smem);
  if (SUBMASK & 2) for (int it = BID(); it < NSB * AH * (PAST / 64); it += gridDim.x) prep_past_tile(p, l, it, smem);
  if (SUBMASK & 4) for (int it = BID(); it < NCHK * BH; it += gridDim.x) prep_hgrn(p, l, it, smem);
  if (SUBMASK & 8) for (int ti = BID(); ti < M / 32; ti += gridDim.x) prep_rwkv(p, l, ti, smem);
  const bf16* proj = (const bf16*)(p.ws + W_PROJ);
  for (int i = BID() * blockDim.x + TID(); i < NSEQ * CSH; i += gridDim.x * blockDim.x) {
    const int seq = i / CSH, c = i % CSH; const int tok = seq_tok0(seq) + seq_len(seq) - 1;
    const float v = bf2f(proj[(size_t)tok * NC + O_CP + c]);
    if (seq < NB) p.out[OO_SP + ((size_t)l * NB + seq) * CSH + c] = v; else p.out[OO_SS + ((size_t)l * NSB + (seq - NB)) * CSH + c] = v;
  }
}

constexpr int KLD = 136, VLD = 72;
__device__ void attn_item(const Params& p, int l, int gc, int h, float lam, float lam_init, char* smem) {
  const int tid = TID(), lane = tid % 64, w = tid / 64, rh = w / 2, n = w % 2, lr = lane % 32, lh = lane / 32;
  const ChunkInfo ci = chunk_info(gc);
  bf16* proj = (bf16*)(p.ws + W_PROJ);
  const bool samp = ci.seq >= NB; const int sb = ci.seq - NB;
  const bf16* Kg; size_t ldk; const bf16* Vg; size_t ldv; int ntiles;
  if (!samp) { Kg = proj + (size_t)(ci.seq * T) * NC + O_AK + h * 128; ldk = NC; Vg = (const bf16*)(p.ws + W_VTP) + (size_t)(ci.seq * AH + h) * 128 * T; ldv = T; ntiles = ci.lc + 1; }
  else { Kg = (const bf16*)(p.ws + W_KBS) + (size_t)(sb * AH + h) * KS * 128; ldk = 128; Vg = (const bf16*)(p.ws + W_VTS) + (size_t)(sb * AH + h) * 128 * KS; ldv = KS; ntiles = PAST / 64 + ci.lc + 1; }
  constexpr int ASTAGE = 64 * KLD + 128 * VLD;
  bf16* sbase = (bf16*)smem;
  bf16x8 qf[4];
  { const bf16* qp = proj + (size_t)(ci.tok0 + rh * 32 + lr) * NC + O_AQ + h * 128 + n * 64 + lh * 8;
#pragma unroll
    for (int ks = 0; ks < 4; ks++) qf[ks] = ldfrag16(qp + ks * 16); }
  f32x16 o[4];
#pragma unroll
  for (int i = 0; i < 4; i++) o[i] = zero16();
  float mrun = -1e30f, lrun = 0.f;
  const int kr0 = tid / 16, kc8 = (tid % 16) * 8, vr0 = tid / 8, vc8 = (tid % 8) * 8;
  const bf16* Kp = Kg + (size_t)kr0 * ldk + kc8;
  const bf16* Vp = Vg + (size_t)vr0 * ldv + vc8;
  typedef unsigned int u32x4 __attribute__((ext_vector_type(4)));
  u32x4 rk0, rk1, rk2, rk3, rv0, rv1, rv2, rv3;
  __syncthreads();
  rk0 = *(const u32x4*)(Kp); rk1 = *(const u32x4*)(Kp + (size_t)16 * ldk); rk2 = *(const u32x4*)(Kp + (size_t)32 * ldk); rk3 = *(const u32x4*)(Kp + (size_t)48 * ldk);
  rv0 = *(const u32x4*)(Vp); rv1 = *(const u32x4*)(Vp + (size_t)32 * ldv); rv2 = *(const u32x4*)(Vp + (size_t)64 * ldv); rv3 = *(const u32x4*)(Vp + (size_t)96 * ldv);
  *(u32x4*)(sbase + (kr0) * KLD + kc8) = rk0; *(u32x4*)(sbase + (kr0 + 16) * KLD + kc8) = rk1; *(u32x4*)(sbase + (kr0 + 32) * KLD + kc8) = rk2; *(u32x4*)(sbase + (kr0 + 48) * KLD + kc8) = rk3;
  *(u32x4*)(sbase + 64 * KLD + (vr0) * VLD + vc8) = rv0; *(u32x4*)(sbase + 64 * KLD + (vr0 + 32) * VLD + vc8) = rv1;
  *(u32x4*)(sbase + 64 * KLD + (vr0 + 64) * VLD + vc8) = rv2; *(u32x4*)(sbase + 64 * KLD + (vr0 + 96) * VLD + vc8) = rv3;
  __syncthreads();
  for (int j = 0; j < ntiles; j++) {
    const bf16* sK = sbase + (j & 1) * ASTAGE; const bf16* sV = sK + 64 * KLD;
    bf16* nK = sbase + ((j & 1) ^ 1) * ASTAGE; bf16* nV = nK + 64 * KLD;
    const bool more = j + 1 < ntiles;
    if (more) {
      const bf16* kq = Kp + (size_t)((j + 1) * 64) * ldk;
      rk0 = *(const u32x4*)(kq); rk1 = *(const u32x4*)(kq + (size_t)16 * ldk); rk2 = *(const u32x4*)(kq + (size_t)32 * ldk); rk3 = *(const u32x4*)(kq + (size_t)48 * ldk);
    }
    f32x16 s[2];
#pragma unroll
    for (int mt = 0; mt < 2; mt++) { s[mt] = zero16();
#pragma unroll
      for (int ks = 0; ks < 4; ks++) s[mt] = MFMA32(ldfrag16(sK + (mt * 32 + lr) * KLD + n * 64 + ks * 16 + lh * 8), qf[ks], s[mt]); }
    if (more) {
      *(u32x4*)(nK + (kr0) * KLD + kc8) = rk0; *(u32x4*)(nK + (kr0 + 16) * KLD + kc8) = rk1; *(u32x4*)(nK + (kr0 + 32) * KLD + kc8) = rk2; *(u32x4*)(nK + (kr0 + 48) * KLD + kc8) = rk3;
      const bf16* vq = Vp + (j + 1) * 64;
      rv0 = *(const u32x4*)(vq); rv1 = *(const u32x4*)(vq + (size_t)32 * ldv); rv2 = *(const u32x4*)(vq + (size_t)64 * ldv); rv3 = *(const u32x4*)(vq + (size_t)96 * ldv);
    }
    float mx = -1e30f;
#pragma unroll
    for (int mt = 0; mt < 2; mt++)
#pragma unroll
      for (int r = 0; r < 16; r++) mx = fmaxf(mx, s[mt][r]);
    mx = fmaxf(mx, SHFL_XOR(mx, 32));
    const float mnew = fmaxf(mrun, mx);
    const float alpha = EXP2(mrun - mnew);
    float rs = 0.f;
#pragma unroll
    for (int mt = 0; mt < 2; mt++)
#pragma unroll
      for (int r = 0; r < 16; r++) { const float e = EXP2(s[mt][r] - mnew); s[mt][r] = e; rs += e; }
    rs += SHFL_XOR(rs, 32);
    lrun = lrun * alpha + rs; mrun = mnew;
    if (__any(alpha != 1.0f)) {
#pragma unroll
      for (int i = 0; i < 4; i++)
#pragma unroll
        for (int r = 0; r < 16; r++) o[i][r] *= alpha;
    }
    bf16x8 pf[2][2];
#pragma unroll
    for (int mt = 0; mt < 2; mt++)
#pragma unroll
      for (int s2 = 0; s2 < 2; s2++) pf[mt][s2] = pack8(s[mt], s2);
#pragma unroll
    for (int mt = 0; mt < 2; mt++)
#pragma unroll
      for (int s2 = 0; s2 < 2; s2++) {
#pragma unroll
        for (int dt = 0; dt < 4; dt++) {
          o[dt] = MFMA32(ldfrag16(sV + (dt * 32 + lr) * VLD + mt * 32 + 16 * s2 + 8 * lh), pf[mt][s2], o[dt]);
        }
      }
    if (more) {
      *(u32x4*)(nV + (vr0) * VLD + vc8) = rv0; *(u32x4*)(nV + (vr0 + 32) * VLD + vc8) = rv1; *(u32x4*)(nV + (vr0 + 64) * VLD + vc8) = rv2; *(u32x4*)(nV + (vr0 + 96) * VLD + vc8) = rv3;
    }
    __syncthreads();
  }
  __syncthreads();
  float* comb = (float*)smem;
  const float invl = 1.f / lrun;
  if (n == 1) {
#pragma unroll
    for (int dt = 0; dt < 4; dt++)
#pragma unroll
      for (int r = 0; r < 16; r++) comb[(rh * 32 + lr) * 129 + dt * 32 + crow(r, lh)] = o[dt][r] * invl;
  }
  __syncthreads();
  if (n == 0) {
    float ss = 0.f;
#pragma unroll
    for (int dt = 0; dt < 4; dt++)
#pragma unroll
      for (int r = 0; r < 16; r++) { const float v = o[dt][r] * invl - lam * comb[(rh * 32 + lr) * 129 + dt * 32 + crow(r, lh)]; o[dt][r] = v; ss += v * v; }
    ss += SHFL_XOR(ss, 32);
    const float rstd = rsqrtf(ss / 128.f + EPS) * (1.f - lam_init);
    const float* sg = p.in[I_SUBG] + l * 128;
    const int tok = ci.tok0 + rh * 32 + lr;
#pragma unroll
    for (int dt = 0; dt < 4; dt++)
#pragma unroll
      for (int g = 0; g < 4; g++) {
        const int dv = dt * 32 + 8 * g + 4 * lh;
        float gate[4]; ld4(proj + (size_t)tok * NC + O_AG + h * 128 + dv, gate);
        V4 ov;
#pragma unroll
        for (int r = 0; r < 4; r++) ov.s[r] = f2bf(o[dt][4 * g + r] * rstd * sg[dv + r] * siluf(gate[r]));
        *(uint2*)(proj + (size_t)tok * NC + O_AQ + h * 128 + dv) = ov.u;
      }
  }
  __syncthreads();
}

constexpr int HLD = 136, TLD = 72;
__device__ void hgrn_item(const Params& p, int l, int seq, int h, char* smem) {
  const int tid = TID(), lane = tid % 64, w = tid / 64, lr = lane % 32, lh = lane / 32;
  bf16* proj = (bf16*)(p.ws + W_PROJ);
  const int nch = seq < NB ? PCH : SCH;
  const int gc0 = seq < NB ? seq * PCH : NB * PCH + (seq - NB) * SCH;
  bf16* X0 = (bf16*)smem;
  bf16* X1 = X0 + 9216;
  float* red = (float*)(X1 + 9216);
  f32x16 S[4];
  if (seq < NB) {
#pragma unroll
    for (int kt = 0; kt < 4; kt++) S[kt] = zero16();
  } else {
    const float* s0 = p.in[I_SH] + (((size_t)l * NSB + (seq - NB)) * BH + h) * 16384;
#pragma unroll
    for (int kt = 0; kt < 4; kt++) {
      const float* sp = s0 + (size_t)(kt * 32 + 4 * lh) * 128 + w * 32 + lr;
#pragma unroll
      for (int r = 0; r < 16; r++) S[kt][r] = sp[((r & 3) + 8 * (r >> 2)) * 128];
      SCHED_BARRIER();
    }
  }
  const float* ng = p.in[I_BNG] + l * 128;
  for (int c = 0; c < nch; c++) {
    const int gc = gc0 + c, tok0 = gc * 64;
    const size_t item = (size_t)gc * BH + h;
    const bf16* hgx = (const bf16*)(p.ws + W_HGX) + item * 2 * 8192;
    const float* dl = (const float*)(p.ws + W_DL) + item * 128;
    __syncthreads();
    for (int i = 0; i < 4; i++) { const int cc = tid + i * 256, r = cc / 16, c8 = (cc % 16) * 8;
      *(uint4*)(X0 + r * HLD + c8) = *(const uint4*)(proj + (size_t)(tok0 + r) * NC + O_BF + h * 128 + c8);
      *(uint4*)(X1 + r * HLD + c8) = *(const uint4*)(proj + (size_t)(tok0 + r) * NC + O_BQ + h * 128 + c8); }
    __syncthreads();
    f32x16 x00 = zero16(), x01 = zero16(), x11 = zero16();
#pragma unroll
    for (int ks = 0; ks < 8; ks++) {
      const bf16x8 b0 = ldfrag16(X0 + (lr) * HLD + ks * 16 + lh * 8), b1 = ldfrag16(X0 + (32 + lr) * HLD + ks * 16 + lh * 8);
      const bf16x8 a0 = ldfrag16(X1 + (lr) * HLD + ks * 16 + lh * 8), a1 = ldfrag16(X1 + (32 + lr) * HLD + ks * 16 + lh * 8);
      x00 = MFMA32(b0, a0, x00); x01 = MFMA32(b0, a1, x01); x11 = MFMA32(b1, a1, x11);
      if (ks & 1) SCHED_BARRIER();
    }
#pragma unroll
    for (int r = 0; r < 16; r++) { if (crow(r, lh) > lr) { x00[r] = 0.f; x11[r] = 0.f; } }
    bf16x8 xp00[2], xp01[2], xp11[2];
#pragma unroll
    for (int s2 = 0; s2 < 2; s2++) { xp00[s2] = pack8(x00, s2); xp01[s2] = pack8(x01, s2); xp11[s2] = pack8(x11, s2); }
    SCHED_BARRIER();
    bf16x8 itf[2][2];
#pragma unroll
    for (int st = 0; st < 2; st++)
#pragma unroll
      for (int s2 = 0; s2 < 2; s2++) { const bf16* ip = hgx + 8192 + (size_t)(w * 32 + lr) * 64 + st * 32 + 16 * s2 + 4 * lh; itf[st][s2] = ldfrag8x2(ip, ip + 8); }
    __syncthreads();
    for (int i = 0; i < 4; i++) { const int cc = tid + i * 256;
      { const int r = cc / 16, c8 = (cc % 16) * 8; *(uint4*)(X0 + r * HLD + c8) = *(const uint4*)(proj + (size_t)(tok0 + r) * NC + O_BI + h * 128 + c8); }
      { const int r = cc / 8, c8 = (cc % 8) * 8; *(uint4*)(X1 + r * TLD + c8) = *(const uint4*)(hgx + (size_t)r * 64 + c8); } }
    __syncthreads();
    f32x16 o0 = zero16(), o1 = zero16();
#pragma unroll
    for (int s2 = 0; s2 < 2; s2++) {
      o0 = MFMA32(itf[0][s2], xp00[s2], o0);
      o1 = MFMA32(itf[0][s2], xp01[s2], o1);
      o1 = MFMA32(itf[1][s2], xp11[s2], o1);
    }
    SCHED_BARRIER();
#pragma unroll
    for (int kt = 0; kt < 4; kt++)
#pragma unroll
      for (int s2 = 0; s2 < 2; s2++) {
        const bf16x8 sp = pack8(S[kt], s2);
        const bf16* q0 = X0 + (lr) * HLD + kt * 32 + 16 * s2 + 4 * lh; const bf16* q1 = X0 + (32 + lr) * HLD + kt * 32 + 16 * s2 + 4 * lh;
        o0 = MFMA32(sp, ldfrag8x2(q0, q0 + 8), o0);
        o1 = MFMA32(sp, ldfrag8x2(q1, q1 + 8), o1);
        if (s2) SCHED_BARRIER();
      }
    SCHED_BARRIER();
#pragma unroll
    for (int kt = 0; kt < 4; kt++) {
      SCHED_BARRIER();
#pragma unroll
      for (int g = 0; g < 4; g++) { const float4 dv = *(const float4*)(dl + kt * 32 + 8 * g + 4 * lh);
        S[kt][4 * g] *= dv.x; S[kt][4 * g + 1] *= dv.y; S[kt][4 * g + 2] *= dv.z; S[kt][4 * g + 3] *= dv.w; }
#pragma unroll
      for (int st = 0; st < 2; st++)
#pragma unroll
        for (int s2 = 0; s2 < 2; s2++) { const bf16* kp = X1 + (kt * 32 + lr) * TLD + st * 32 + 16 * s2 + 4 * lh;
          S[kt] = MFMA32(ldfrag8x2(kp, kp + 8), itf[st][s2], S[kt]); }
    }
    SCHED_BARRIER();
    float ss0 = 0.f, ss1 = 0.f;
#pragma unroll
    for (int r = 0; r < 16; r++) { ss0 += o0[r] * o0[r]; ss1 += o1[r] * o1[r]; }
    ss0 += SHFL_XOR(ss0, 32); ss1 += SHFL_XOR(ss1, 32);
    if (lh == 0) { red[w * 64 + lr] = ss0; red[w * 64 + 32 + lr] = ss1; }
    __syncthreads();
#pragma unroll
    for (int tt = 0; tt < 2; tt++) {
      const int t = tt * 32 + lr;
      const float tot = red[t] + red[64 + t] + red[128 + t] + red[192 + t];
      const float rstd = rsqrtf(tot / 128.f + EPS);
      const int tok = tok0 + t;
#pragma unroll
      for (int g = 0; g < 4; g++) {
        const int v = w * 32 + 8 * g + 4 * lh;
        float gate[4]; ld4(proj + (size_t)tok * NC + O_BG + h * 128 + v, gate);
        V4 ov;
#pragma unroll
        for (int r = 0; r < 4; r++) { const float ovv = (tt == 0 ? o0[4 * g + r] : o1[4 * g + r]); ov.s[r] = f2bf(ovv * rstd * ng[v + r] * siluf(gate[r])); }
        *(uint2*)(proj + (size_t)tok * NC + O_BQ + h * 128 + v) = ov.u;
      }
    }
  }
  float* so = p.out + (seq < NB ? OO_HP + (((size_t)l * NB + seq) * BH + h) * 16384 : OO_HS + (((size_t)l * NSB + (seq - NB)) * BH + h) * 16384);
#pragma unroll
  for (int kt = 0; kt < 4; kt++) {
    float* sp = so + (size_t)(kt * 32 + 4 * lh) * 128 + w * 32 + lr;
#pragma unroll
    for (int r = 0; r < 16; r++) sp[((r & 3) + 8 * (r >> 2)) * 128] = S[kt][r];
    SCHED_BARRIER();
  }
  __syncthreads();
}

__device__ void rwkv_item(const Params& p, int l, int seq, int h, char* smem) {
  const int tid = TID(), ri = tid / 4, sub = tid % 4;
  bf16* proj = (bf16*)(p.ws + W_PROJ);
  const float* rww = (const float*)(p.ws + W_RWW);
  const bf16* rwr = (const bf16*)(p.ws + W_RWR); const bf16* rwk = (const bf16*)(p.ws + W_RWK); const bf16* rwa = (const bf16*)(p.ws + W_RWA);
  const bf16* rwb = (const bf16*)(p.ws + W_RWB); const bf16* rwv = (const bf16*)(p.ws + (l == 0 ? W_RWV0 : W_RWV1));
  float* sw = (float*)smem; float* sr = sw + 2048; float* sk = sr + 2048; float* sv = sk + 2048; float* sa = sv + 2048; float* sbb = sa + 2048; float* sy = sbb + 2048;
  const int len = seq_len(seq), t0 = seq_tok0(seq);
  float S[16];
  if (seq < NB) {
#pragma unroll
    for (int j = 0; j < 16; j++) S[j] = 0.f;
  } else {
    const float* s0 = p.in[I_SR] + ((((size_t)l * NSB + (seq - NB)) * CH + h) * 64 + ri) * 64 + sub * 16;
#pragma unroll
    for (int j = 0; j < 16; j++) S[j] = s0[j];
  }
  const float* lnw = p.in[I_LNW] + (size_t)l * CW + h * 64; const float* lnb = p.in[I_LNB] + (size_t)l * CW + h * 64;
  const float* rk = p.in[I_RK] + (size_t)l * CW + h * 64;
  const int st = tid / 8, sc8 = (tid % 8) * 8;
  typedef unsigned int u32x4 __attribute__((ext_vector_type(4)));
  typedef float f32x4v __attribute__((ext_vector_type(4)));
  f32x4v pw0, pw1; u32x4 pr_, pk_, pv_, pa_, pb_, pg_next, pg_cur;
  float lnw8[8], lnb8[8], rk8[8];
#pragma unroll
  for (int i = 0; i < 8; i++) { lnw8[i] = lnw[sc8 + i]; lnb8[i] = lnb[sc8 + i]; rk8[i] = rk[sc8 + i]; }
  pg_next = *(const u32x4*)(proj + (size_t)(t0 + st) * NC + O_CG + h * 64 + sc8);
  { const size_t g = (size_t)(t0 + st) * CW + h * 64 + sc8;
    pw0 = *(const f32x4v*)(rww + g); pw1 = *(const f32x4v*)(rww + g + 4);
    pr_ = *(const u32x4*)(rwr + g); pk_ = *(const u32x4*)(rwk + g); pv_ = *(const u32x4*)(rwv + g); pa_ = *(const u32x4*)(rwa + g); pb_ = *(const u32x4*)(rwb + g); }
  for (int tb = 0; tb < len; tb += 32) {
    __syncthreads();
    { float* d = sw + st * 64 + sc8; *(f32x4v*)d = pw0; *(f32x4v*)(d + 4) = pw1;
#define UNPK(dst, v) { float* q = dst + st * 64 + sc8; _Pragma("unroll") for (int i = 0; i < 4; i++) { q[2 * i] = __uint_as_float(v[i] << 16); q[2 * i + 1] = __uint_as_float(v[i] & 0xffff0000u); } }
      UNPK(sr, pr_) UNPK(sk, pk_) UNPK(sv, pv_) UNPK(sa, pa_) UNPK(sbb, pb_)
      pg_cur = pg_next;
    }
    __syncthreads();
    if (tb + 32 < len) { pg_next = *(const u32x4*)(proj + (size_t)(t0 + tb + 32 + st) * NC + O_CG + h * 64 + sc8);
      const size_t g = (size_t)(t0 + tb + 32 + st) * CW + h * 64 + sc8;
      pw0 = *(const f32x4v*)(rww + g); pw1 = *(const f32x4v*)(rww + g + 4);
      pr_ = *(const u32x4*)(rwr + g); pk_ = *(const u32x4*)(rwk + g); pv_ = *(const u32x4*)(rwv + g); pa_ = *(const u32x4*)(rwa + g); pb_ = *(const u32x4*)(rwb + g); }
#pragma unroll 2
    for (int t = 0; t < 32; t++) {
      const float* pa = sa + t * 64 + sub * 16; const float* pw = sw + t * 64 + sub * 16; const float* pb = sbb + t * 64 + sub * 16;
      const float* pk = sk + t * 64 + sub * 16; const float* pr = sr + t * 64 + sub * 16;
      float dot = 0.f, dotb = 0.f;
#pragma unroll
      for (int j = 0; j < 8; j++) { dot += S[j] * pa[j]; dotb += S[j + 8] * pa[j + 8]; }
      dot = red4(dot + dotb);
      const float vi = sv[t * 64 + ri];
      float y = 0.f, yb = 0.f;
#pragma unroll
      for (int j = 0; j < 8; j++) { S[j] = S[j] * pw[j] + dot * pb[j] + vi * pk[j]; y += S[j] * pr[j];
                                    S[j + 8] = S[j + 8] * pw[j + 8] + dot * pb[j + 8] + vi * pk[j + 8]; yb += S[j + 8] * pr[j + 8]; }
      y = red4(y + yb);
      if (sub == 0) sy[t * 64 + ri] = y;
    }
    __syncthreads();
    {
      const int t = tid / 8, c8 = (tid % 8) * 8; const int tok = t0 + tb + t;
      float y[8]; float s1 = 0.f, bon = 0.f;
#pragma unroll
      for (int i = 0; i < 8; i++) { y[i] = sy[t * 64 + c8 + i]; s1 += y[i]; bon += sr[t * 64 + c8 + i] * sk[t * 64 + c8 + i] * rk8[i]; }
      s1 = red8(s1); bon = red8(bon);
      const float mu = s1 / 64.f; float s2 = 0.f;
#pragma unroll
      for (int i = 0; i < 8; i++) { const float d = y[i] - mu; s2 += d * d; }
      s2 = red8(s2);
      const float rstd = rsqrtf(s2 / 64.f + 64e-5f);
      float gate[8];
#pragma unroll
      for (int i = 0; i < 4; i++) { gate[2 * i] = __uint_as_float(pg_cur[i] << 16); gate[2 * i + 1] = __uint_as_float(pg_cur[i] & 0xffff0000u); }
      V8 ov;
#pragma unroll
      for (int i = 0; i < 8; i++) { const float o = (y[i] - mu) * rstd * lnw8[i] + lnb8[i] + bon * sv[t * 64 + c8 + i]; ov.s[i] = f2bf(o * siluf(gate[i])); }
      *(uint4*)(proj + (size_t)tok * NC + O_CP + h * 64 + c8) = ov.u;
    }
  }
  float* so = p.out + (seq < NB ? OO_RP + ((((size_t)l * NB + seq) * CH + h) * 64 + ri) * 64 : OO_RS + ((((size_t)l * NSB + (seq - NB)) * CH + h) * 64 + ri) * 64) + sub * 16;
#pragma unroll
  for (int j = 0; j < 16; j++) so[j] = S[j];
  __syncthreads();
}

__device__ void phase_mixers(const Params& p, int l, char* smem) {
  __shared__ int s_item;
  int* cnt = (int*)(p.ws + W_CNT) + l;
  const float* lp = p.in[I_LAM] + (size_t)l * 256;
  float d1 = 0.f, d2 = 0.f;
  for (int i = 0; i < 64; i++) { d1 += lp[i] * lp[64 + i]; d2 += lp[128 + i] * lp[192 + i]; }
  const float lam_init = 0.8f - 0.6f * expf(-0.3f * (float)l);
  const float lam = expf(d1) - expf(d2) + lam_init;
  constexpr int N_RWP = NB * CH, N_HGP = NB * BH, N_ATP = NB * PCH * AH, N_RWS = NSB * CH, N_HGS = NSB * BH, N_ATS = NSB * SCH * AH;
  constexpr int NTOT = N_RWP + N_HGP + N_ATP + N_RWS + N_HGS + N_ATS;
  for (;;) {
    __syncthreads();
    if (TID() == 0) s_item = atomicAdd(cnt, 1);
    __syncthreads();
    int it = s_item;
    if (it >= NTOT) break;
    if (it < N_RWP) { SETPRIO(3); if (SUBMASK & 1) rwkv_item(p, l, it / CH, it % CH, smem); SETPRIO(0); continue; }
    it -= N_RWP;
    if (it < N_HGP) { SETPRIO(2); if (SUBMASK & 2) hgrn_item(p, l, it / BH, it % BH, smem); SETPRIO(0); continue; }
    it -= N_HGP;
    if (it < N_ATP) {
      const int lc = PCH - 1 - it / (NB * AH), r = it % (NB * AH); if (SUBMASK & 4) attn_item(p, l, (r / AH) * PCH + lc, r % AH, lam, lam_init, smem); continue; }
    it -= N_ATP;
    if (it < N_RWS) { if (SUBMASK & 1) rwkv_item(p, l, NB + it / CH, it % CH, smem); continue; }
    it -= N_RWS;
    if (it < N_HGS) { if (SUBMASK & 2) hgrn_item(p, l, NB + it / BH, it % BH, smem); continue; }
    it -= N_HGS;
    { const int gc = NB * PCH + it / AH; if (SUBMASK & 4) attn_item(p, l, gc, it % AH, lam, lam_init, smem); }
  }
}

constexpr int SMEM_BYTES = 73728;
#ifdef EMU
__device__ void run_phase(const Params& p, int ph, char* smem) {
  const int l = ph / 6, s = ph % 6;
  switch (s) {
#ifndef PHMASK
#define PHMASK 63
#endif
    case 0: if (PHMASK & 1) { if (l == 0) phase_wprep(p, smem); phase_rmsnorm(p, l); } break;
    case 1: if (PHMASK & 2) phase_proj(p, l, smem); break;
    case 2: if (PHMASK & 4) phase_prep(p, l, smem); break;
    case 3: if (PHMASK & 8) phase_mixers(p, l, smem); break;
    case 4: if (PHMASK & 16) phase_merge(p, l, smem); break;
    case 5: if (PHMASK & 32) phase_yout(p, l, smem); break;
  }
}
#endif
#ifndef EMU
__global__ void __launch_bounds__(256, 2) mega(Params p) {
  __shared__ __attribute__((aligned(16))) char smem[SMEM_BYTES];
  cg::grid_group grid = cg::this_grid();
  phase_wprep(p, smem);
#ifdef PROBE
  long long tmix = 0, tproj = 0;
#endif
#pragma unroll 1
  for (int l = 0; l < DEPTH; l++) {
    phase_rmsnorm(p, l); grid.sync();
#ifdef PROBE
    long long t0 = wall_clock64();
#endif
    phase_proj(p, l, smem); grid.sync();
#ifdef PROBE
    if (l == 0) tproj = wall_clock64() - t0;
#endif
    phase_prep(p, l, smem); grid.sync();
#ifdef PROBE
    t0 = wall_clock64();
#endif
    phase_mixers(p, l, smem); grid.sync();
#ifdef PROBE
    if (l == 0) tmix = wall_clock64() - t0;
#endif
    phase_merge(p, l, smem); grid.sync();
    phase_yout(p, l, smem); grid.sync();
  }
#ifdef PROBE
  long long* pr = (long long*)(p.ws + W_CNT + 64);
  if (blockIdx.x == 0 && threadIdx.x == 0) { pr[0] = tmix; pr[1] = tproj; }
  grid.sync();
  { const long long a = pr[0], b = pr[1];
    const long long q = (b + 25000) / 50000;
    const long long delay = a + 2000000LL * q + 40000000LL * (p.percu - 1);
    const long long te = wall_clock64() + delay;
    while (wall_clock64() < te) __builtin_amdgcn_s_sleep(20);
  }
#endif
}
extern "C" void kernel_launch(void* const* d_in, const int* in_sizes, int n_in, void* d_out, int out_size, void* d_ws, size_t ws_size, hipStream_t stream) {
  Params p{};
  for (int i = 0; i < 32; i++) p.in[i] = (const float*)d_in[i];
  p.out = (float*)d_out; p.ws = (char*)d_ws;
  if (ws_size < WS_TOTAL) { fprintf(stderr, "workspace too small: %zu < %zu\n", ws_size, (size_t)WS_TOTAL); return; }
  hipMemsetAsync((char*)d_ws + W_CNT, 0, 256, stream);
  static int grid_blocks = 0;
  if (!grid_blocks) {
    int dev = 0, cus = 0, per_cu = 0;
    hipGetDevice(&dev);
    hipDeviceGetAttribute(&cus, hipDeviceAttributeMultiprocessorCount, dev);
    hipOccupancyMaxActiveBlocksPerMultiprocessor(&per_cu, mega, 256, 0);
    if (per_cu > 2) per_cu = 2;
    grid_blocks = cus * per_cu;
  }
#ifdef PROBE
  p.percu = grid_blocks / 256;
#endif
  void* args[] = { &p };
  hipError_t e = hipLaunchCooperativeKernel((void*)mega, dim3(grid_blocks), dim3(256), args, 0, stream);
  if (e != hipSuccess) fprintf(stderr, "cooperative launch failed: %s (grid %d)\n", hipGetErrorString(e), grid_blocks);
}
#endif
```

```cpp
#ifdef EMU
#include "emu.h"
#define MFMA32(a, b, c) emu_mfma32(a, b, c)
#else
#include <hip/hip_runtime.h>
#include <hip/hip_cooperative_groups.h>
#include <cstdio>
namespace cg = cooperative_groups;
typedef short bf16x8 __attribute__((ext_vector_type(8)));
typedef float f32x16 __attribute__((ext_vector_type(16)));
#define MFMA32(a, b, c) __builtin_amdgcn_mfma_f32_32x32x16_bf16(a, b, c, 0, 0, 0)
#endif

#ifdef EMU
#define TID() ((int)threadIdx.x)
#define BID() ((int)blockIdx.x)
#else
static __device__ __forceinline__ int TID() { int t = threadIdx.x; asm volatile("" : "+v"(t)); return t; }
static __device__ __forceinline__ int BID() { int t = blockIdx.x; asm volatile("" : "+s"(t)); return t; }
#endif
#define DI __device__ __forceinline__
#if defined(__HIP_DEVICE_COMPILE__)
#define SETPRIO(n) __builtin_amdgcn_s_setprio(n)
#else
#define SETPRIO(n)
#endif
#ifdef EMU
#define DPP_XOR1(x) emu_lane_perm(x, 0)
#define DPP_XOR2(x) emu_lane_perm(x, 1)
#define DPP_HMIR(x) emu_lane_perm(x, 2)
#define DPP_RMIR(x) emu_lane_perm(x, 3)
#else
#define DPP_F(x, c) __builtin_bit_cast(float, __builtin_amdgcn_update_dpp(0, __builtin_bit_cast(int, (float)(x)), c, 0xF, 0xF, true))
#define DPP_XOR1(x) DPP_F(x, 0xB1)
#define DPP_XOR2(x) DPP_F(x, 0x4E)
#define DPP_HMIR(x) DPP_F(x, 0x141)
#define DPP_RMIR(x) DPP_F(x, 0x140)
#endif
#ifdef EMU
#define EXP2(x) exp2f(x)
#else
#define EXP2(x) __builtin_amdgcn_exp2f(x)
#endif
#ifdef EMU
#define SCHED_BARRIER()
#else
#define SCHED_BARRIER() __builtin_amdgcn_sched_barrier(0)
#endif
typedef unsigned short bf16;

#ifdef SMALL
constexpr int D = 128, NB = 2, T = 256, NSB = 2, TS = 64, PAST = 128, AH = 2, BH = 1, CH = 2;
#else
constexpr int D = 1024, NB = 8, T = 8192, NSB = 16, TS = 64, PAST = 1024, AH = 8, BH = 8, CH = 16;
#endif
constexpr int DEPTH = 2;
constexpr int AQK = AH * 128, AW = AH * 128, BQK = BH * 128, BW = BH * 128, CW = CH * 64;
constexpr int CSH = 3 * CW + 128;
constexpr int O_AQ = 0, O_AK = AQK, O_AV = 2 * AQK, O_AG = O_AV + AW, O_BQ = O_AG + AW, O_BF = O_BQ + BQK, O_BI = O_BF + BQK,
              O_BG = O_BI + BW, O_CP = O_BG + BW, O_CG = O_CP + CSH, O_MA = O_CG + CW, O_MB = O_MA + D, O_MC = O_MB + D, NC = O_MC + D;
constexpr int CP_R = 0, CP_WLO = CW, CP_K = CW + 64, CP_V = 2 * CW + 64, CP_ALO = 3 * CW + 64;
constexpr int MP = NB * T, MS = NSB * TS, M = MP + MS, NSEQ = NB + NSB, KS = PAST + TS;
constexpr int NCHK = M / 64, PCH = T / 64, SCH = TS / 64;
constexpr int MAXPOS = (T > KS ? T : KS);
constexpr float EPS = 1e-6f;

constexpr size_t OO_Y = 0;
constexpr size_t OO_KP = (size_t)M * D;
constexpr size_t OO_VP = OO_KP + (size_t)DEPTH * MP * AQK;
constexpr size_t OO_HP = OO_VP + (size_t)DEPTH * MP * AW;
constexpr size_t OO_RP = OO_HP + (size_t)DEPTH * NB * BH * 16384;
constexpr size_t OO_SP = OO_RP + (size_t)DEPTH * NB * CH * 4096;
constexpr size_t OO_KS = OO_SP + (size_t)DEPTH * NB * CSH;
constexpr size_t OO_VS = OO_KS + (size_t)DEPTH * MS * AQK;
constexpr size_t OO_HS = OO_VS + (size_t)DEPTH * MS * AW;
constexpr size_t OO_RS = OO_HS + (size_t)DEPTH * NSB * BH * 16384;
constexpr size_t OO_SS = OO_RS + (size_t)DEPTH * NSB * CH * 4096;
constexpr size_t OUT_TOTAL = OO_SS + (size_t)DEPTH * NSB * CSH;

constexpr size_t al256(size_t x) { return (x + 255) & ~(size_t)255; }
constexpr size_t W_PROJ = 0;
constexpr size_t W_HN = al256(W_PROJ + (size_t)M * NC * 2);
constexpr size_t W_HGX = al256(W_HN + (size_t)M * D * 2);
constexpr size_t W_DL = al256(W_HGX + (size_t)NCHK * BH * 2 * 8192 * 2);
constexpr size_t W_RWW = al256(W_DL + (size_t)NCHK * BH * 128 * 4);
constexpr size_t W_RWR = al256(W_RWW + (size_t)M * CW * 4);
constexpr size_t W_RWK = al256(W_RWR + (size_t)M * CW * 2);
constexpr size_t W_RWA = al256(W_RWK + (size_t)M * CW * 2);
constexpr size_t W_RWB = al256(W_RWA + (size_t)M * CW * 2);
constexpr size_t W_RWV0 = al256(W_RWB + (size_t)M * CW * 2);
constexpr size_t W_RWV1 = al256(W_RWV0 + (size_t)M * CW * 2);
constexpr size_t W_VTP = al256(W_RWV1 + (size_t)M * CW * 2);
constexpr size_t W_KBS = al256(W_VTP + (size_t)NB * AH * 128 * T * 2);
constexpr size_t W_VTS = al256(W_KBS + (size_t)NSB * AH * KS * 128 * 2);
constexpr size_t W_WT = al256(W_VTS + (size_t)NSB * AH * 128 * KS * 2);
constexpr size_t WT_IN = 0, WT_OA = (size_t)NC * D, WT_OB = WT_OA + (size_t)D * AW, WT_OC = WT_OB + (size_t)D * BW, WT_OO = WT_OC + (size_t)D * CW,
                 WT_LAYER = WT_OO + (size_t)D * D;
constexpr size_t W_ROPE = al256(W_WT + (size_t)DEPTH * WT_LAYER * 2);
constexpr size_t W_CNT = al256(W_ROPE + (size_t)MAXPOS * 16 * 4);
constexpr size_t W_W2T = al256(W_CNT + 256);
constexpr size_t W_A2T = al256(W_W2T + (size_t)DEPTH * CW * 64 * 2);
constexpr size_t W_VW2T = al256(W_A2T + (size_t)DEPTH * CW * 64 * 2);
constexpr size_t W_W1T = al256(W_VW2T + (size_t)CW * 32 * 2);
constexpr size_t WS_TOTAL = W_W1T + (size_t)32 * D * 2;

struct Params { const float* in[32]; float* out; char* ws; long long percu; };

enum { I_XP, I_XS, I_CK, I_CV, I_SH, I_SR, I_SS, I_NG, I_WIN, I_QNG, I_KNG, I_LAM, I_SUBG, I_BLOW, I_BNG, I_MU, I_W0, I_W2, I_A0, I_A2,
       I_KK, I_KA, I_RK, I_LNW, I_LNB, I_VW1, I_VW2, I_V0, I_WOA, I_WOB, I_WOC, I_WO };

#ifdef EMU
DI bf16 f2bf(float x) { unsigned u = __float_as_uint(x); u += 0x7fffu + ((u >> 16) & 1u); return (bf16)(u >> 16); }
#else
DI bf16 f2bf(float x) { __bf16 b = (__bf16)x; return __builtin_bit_cast(unsigned short, b); }
#endif
DI float bf2f(bf16 s) { return __uint_as_float(((unsigned)s) << 16); }
DI float sigm(float x) { return 1.0f / (1.0f + __expf(-x)); }
DI float siluf(float x) { return x / (1.0f + __expf(-x)); }
union V8 { bf16x8 v; uint4 u; uint2 h[2]; bf16 s[8]; };
union V4 { uint2 u; bf16 s[4]; };
DI void ld8(const bf16* p, float* o) { V8 t; t.u = *(const uint4*)p;
#pragma unroll
  for (int i = 0; i < 8; i++) o[i] = bf2f(t.s[i]); }
DI void ld4(const bf16* p, float* o) { V4 t; t.u = *(const uint2*)p;
#pragma unroll
  for (int i = 0; i < 4; i++) o[i] = bf2f(t.s[i]); }
DI bf16x8 ldfrag16(const bf16* p) { V8 t; t.u = *(const uint4*)p; return t.v; }
DI bf16x8 ldfrag8x2(const bf16* p0, const bf16* p1) { V8 t; t.h[0] = *(const uint2*)p0; t.h[1] = *(const uint2*)p1; return t.v; }
DI bf16x8 pack8(const f32x16& x, int s) { V8 t;
#pragma unroll
  for (int j = 0; j < 8; j++) t.s[j] = f2bf(x[8 * s + j]); return t.v; }
DI f32x16 zero16() { f32x16 z;
#pragma unroll
  for (int i = 0; i < 16; i++) z[i] = 0.f; return z; }
#ifdef EMU
#define SHFL_XOR(v, m) __shfl_xor(v, m)
#else
static __device__ __forceinline__ float SHFL_XOR(float v, int m) { const int lane = TID() & 63; return __builtin_bit_cast(float, __builtin_amdgcn_ds_bpermute((lane ^ m) << 2, __builtin_bit_cast(int, v))); }
#endif
DI float red4(float x) { x += DPP_XOR1(x); x += DPP_XOR2(x); return x; }
DI float red8(float x) { x = red4(x); x += DPP_HMIR(x); return x; }
DI float red16(float x) { x = red8(x); x += DPP_RMIR(x); return x; }
DI int crow(int reg, int h) { return (reg & 3) + 8 * (reg >> 2) + 4 * h; }

struct ChunkInfo { int seq, lc, tok0, pos0; };
DI ChunkInfo chunk_info(int gc) { ChunkInfo c; c.tok0 = gc * 64;
  if (gc < NB * PCH) { c.seq = gc / PCH; c.lc = gc % PCH; c.pos0 = c.lc * 64; }
  else { int r = gc - NB * PCH; c.seq = NB + r / SCH; c.lc = r % SCH; c.pos0 = PAST + c.lc * 64; }
  return c; }
DI int seq_tok0(int seq) { return seq < NB ? seq * T : MP + (seq - NB) * TS; }
DI int seq_len(int seq) { return seq < NB ? T : TS; }

__device__ void transpose_w(const float* src, bf16* dst, int K, int N, float* tile  ) {
  const int tid = TID(); const int nkt = K / 64, nnt = N / 64;
  for (int t = BID(); t < nkt * nnt; t += gridDim.x) {
    const int k0 = (t / nnt) * 64, n0 = (t % nnt) * 64;
    for (int i = 0; i < 16; i++) { int r = i * 4 + tid / 64, c = tid % 64; tile[r * 65 + c] = src[(size_t)(k0 + r) * N + n0 + c]; }
    __syncthreads();
    for (int i = 0; i < 16; i++) { int n = i * 4 + tid / 64, k = tid % 64; dst[(size_t)(n0 + n) * K + k0 + k] = f2bf(tile[k * 65 + n]); }
    __syncthreads();
  }
}
__device__ void phase_wprep(const Params& p, char* smem) {
  float* tile = (float*)smem;
  for (int l = 0; l < DEPTH; l++) {
    bf16* wt = (bf16*)(p.ws + W_WT) + (size_t)l * WT_LAYER;
    transpose_w(p.in[I_WIN] + (size_t)l * D * NC, wt + WT_IN, D, NC, tile);
    transpose_w(p.in[I_WOA] + (size_t)l * AW * D, wt + WT_OA, AW, D, tile);
    transpose_w(p.in[I_WOB] + (size_t)l * BW * D, wt + WT_OB, BW, D, tile);
    transpose_w(p.in[I_WOC] + (size_t)l * CW * D, wt + WT_OC, CW, D, tile);
    transpose_w(p.in[I_WO] + (size_t)l * D * D, wt + WT_OO, D, D, tile);
  }
  for (int l = 0; l < DEPTH; l++) {
    transpose_w(p.in[I_W2] + (size_t)l * 64 * CW, (bf16*)(p.ws + W_W2T) + (size_t)l * CW * 64, 64, CW, tile);
    transpose_w(p.in[I_A2] + (size_t)l * 64 * CW, (bf16*)(p.ws + W_A2T) + (size_t)l * CW * 64, 64, CW, tile);
  }
  for (int i = BID() * blockDim.x + TID(); i < 32 * CW; i += gridDim.x * blockDim.x) {
    const int k = i / CW, n = i % CW; ((bf16*)(p.ws + W_VW2T))[n * 32 + k] = f2bf(p.in[I_VW2][i]); }
  for (int i = BID() * blockDim.x + TID(); i < D * 32; i += gridDim.x * blockDim.x) {
    const int k = i / 32, n = i % 32; ((bf16*)(p.ws + W_W1T))[(size_t)n * D + k] = f2bf(p.in[I_VW1][i]); }
  float* rope = (float*)(p.ws + W_ROPE);
  for (int i = BID() * blockDim.x + TID(); i < MAXPOS * 8; i += gridDim.x * blockDim.x) {
    int pos = i / 8, j = i % 8;
    double inv = pow(500000.0, -(double)j / 8.0);
    double ang = (double)pos * inv;
    rope[pos * 16 + j] = (float)cos(ang); rope[pos * 16 + 8 + j] = (float)sin(ang);
  }
}

DI const float* x_row(const Params& p, int l, int m) {
  if (l == 0) return m < MP ? p.in[I_XP] + (size_t)m * D : p.in[I_XS] + (size_t)(m - MP) * D;
  return p.out + OO_Y + (size_t)m * D;
}
__device__ void phase_rmsnorm(const Params& p, int l) {
  const int lane = TID() % 64, w = TID() / 64;
  bf16* hn = (bf16*)(p.ws + W_HN);
  const float* g = p.in[I_NG] + (size_t)l * D;
  for (int m = BID() * 4 + w; m < M; m += gridDim.x * 4) {
    const float* x = x_row(p, l, m);
    float ss = 0.f;
    for (int c = lane * 4; c < D; c += 256) { float4 v = *(const float4*)(x + c); ss += v.x * v.x + v.y * v.y + v.z * v.z + v.w * v.w; }
    for (int o = 32; o >= 1; o >>= 1) ss += SHFL_XOR(ss, o);
    const float rs = rsqrtf(ss / D + EPS);
    for (int c = lane * 4; c < D; c += 256) { float4 v = *(const float4*)(x + c); float4 gg = *(const float4*)(g + c);
      V4 o; o.s[0] = f2bf(v.x * rs * gg.x); o.s[1] = f2bf(v.y * rs * gg.y); o.s[2] = f2bf(v.z * rs * gg.z); o.s[3] = f2bf(v.w * rs * gg.w);
      *(uint2*)(hn + (size_t)m * D + c) = o.u; }
  }
}

constexpr int GLD = 40;
constexpr int GSTAGE = 2 * 128 * GLD;
template <int NJ> DI void gemm_mainloop(const bf16* A, size_t lda, const bf16* Bt, size_t ldb, int K, int m0, int n0, bf16* lds, f32x16 acc[2][NJ]) {
  const int tid = TID(), lane = tid % 64, w = tid / 64, wm = w / 2, wn = w % 2, lr = lane % 32, lh = lane / 32;
  const int nk = K / 32;
  typedef unsigned int u32x4 __attribute__((ext_vector_type(4)));
  u32x4 a00, a01, b00, b01, a10, a11, b10, b11;
  const int r0 = tid / 4, kc = (tid % 4) * 8;
  const bf16* Ap = A + (size_t)(m0 + r0) * lda + kc;
  const bf16* Bp = Bt + (size_t)(n0 + r0) * ldb + kc;
  const int so = r0 * GLD + kc;
#define G_LOAD0(kt) { a00 = *(const u32x4*)(Ap + (kt) * 32); a01 = *(const u32x4*)(Ap + (size_t)64 * lda + (kt) * 32); b00 = *(const u32x4*)(Bp + (kt) * 32); if (NJ == 2) b01 = *(const u32x4*)(Bp + (size_t)64 * ldb + (kt) * 32); }
#define G_LOAD1(kt) { a10 = *(const u32x4*)(Ap + (kt) * 32); a11 = *(const u32x4*)(Ap + (size_t)64 * lda + (kt) * 32); b10 = *(const u32x4*)(Bp + (kt) * 32); if (NJ == 2) b11 = *(const u32x4*)(Bp + (size_t)64 * ldb + (kt) * 32); }
#define G_STORE0(st) { bf16* q = lds + (st) * GSTAGE + so; *(u32x4*)q = a00; *(u32x4*)(q + 64 * GLD) = a01; *(u32x4*)(q + 128 * GLD) = b00; if (NJ == 2) *(u32x4*)(q + 192 * GLD) = b01; }
#define G_STORE1(st) { bf16* q = lds + (st) * GSTAGE + so; *(u32x4*)q = a10; *(u32x4*)(q + 64 * GLD) = a11; *(u32x4*)(q + 128 * GLD) = b10; if (NJ == 2) *(u32x4*)(q + 192 * GLD) = b11; }
#define G_COMPUTE(st) { const bf16* sAc = lds + (st) * GSTAGE; const bf16* sBc = sAc + 128 * GLD; \
    _Pragma("unroll") for (int ks = 0; ks < 2; ks++) { bf16x8 fa[2], fb[NJ]; \
      _Pragma("unroll") for (int i = 0; i < 2; i++) { fa[i] = ldfrag16(sAc + (wm * 64 + i * 32 + lr) * GLD + ks * 16 + lh * 8); \
        if (i < NJ) fb[i] = ldfrag16(sBc + (wn * 32 * NJ + i * 32 + lr) * GLD + ks * 16 + lh * 8); } \
      _Pragma("unroll") for (int i = 0; i < 2; i++) _Pragma("unroll") for (int j = 0; j < NJ; j++) acc[i][j] = MFMA32(fa[i], fb[j], acc[i][j]); } }
  G_LOAD0(0)
  G_LOAD1(1)
  G_STORE0(0)
  __syncthreads();
  int st = 0;
  for (int kt = 0; kt < nk; kt += 2) {
    const int st1 = st == 2 ? 0 : st + 1, st2 = st1 == 2 ? 0 : st1 + 1;
    if (kt + 2 < nk) G_LOAD0(kt + 2)
    G_COMPUTE(st)
    G_STORE1(st1)
    __syncthreads();
    if (kt + 3 < nk) G_LOAD1(kt + 3)
    G_COMPUTE(st1)
    if (kt + 2 < nk) G_STORE0(st2)
    __syncthreads();
    st = st2;
  }
#undef G_LOAD0
#undef G_LOAD1
#undef G_STORE0
#undef G_STORE1
#undef G_COMPUTE
}

__device__ void phase_proj(const Params& p, int l, char* smem) {
  const bf16* hn = (const bf16*)(p.ws + W_HN);
  const bf16* wt = (const bf16*)(p.ws + W_WT) + (size_t)l * WT_LAYER + WT_IN;
  bf16* proj = (bf16*)(p.ws + W_PROJ);
  const int lane = TID() % 64, w = TID() / 64, wm = w / 2, wn = w % 2, lr = lane % 32, lh = lane / 32;
  constexpr int NT = NC / 128, MT = M / 128;
  constexpr int MG = 4, NGRP = (MT + MG - 1) / MG;
  const int bid = BID(), xcd = bid % 8, lb = bid / 8, nlb = ((int)gridDim.x + 7 - xcd) / 8;
  const int ngx = (NGRP - xcd + 7) / 8;
  for (int it = lb; it < ngx * NT * MG; it += nlb) {
    const int g = xcd + 8 * (it / (NT * MG)), r = it % (NT * MG);
    const int mt = g * MG + r % MG, nt = r / MG;
    if (mt >= MT) continue;
    const int m0 = mt * 128, n0 = nt * 128;
    f32x16 acc[2][2];
#pragma unroll
    for (int i = 0; i < 2; i++)
#pragma unroll
      for (int j = 0; j < 2; j++) acc[i][j] = zero16();
    gemm_mainloop<2>(hn, D, wt, D, D, m0, n0, (bf16*)smem, acc);
#pragma unroll
    for (int i = 0; i < 2; i++)
#pragma unroll
      for (int j = 0; j < 2; j++)
#pragma unroll
        for (int r = 0; r < 16; r++) {
          const int row = m0 + wm * 64 + i * 32 + crow(r, lh), col = n0 + wn * 64 + j * 32 + lr;
          proj[(size_t)row * NC + col] = f2bf(acc[i][j][r]);
        }
  }
}

__device__ void phase_merge(const Params& p, int l, char* smem) {
  const bf16* proj = (const bf16*)(p.ws + W_PROJ);
  const bf16* wt = (const bf16*)(p.ws + W_WT) + (size_t)l * WT_LAYER;
  bf16* mrg = (bf16*)(p.ws + W_HN);
  const int lane = TID() % 64, w = TID() / 64, wm = w / 2, wn = w % 2, lr = lane % 32, lh = lane / 32;
  constexpr int NT = D / 64, MT = M / 128;
  for (int t = BID(); t < MT * NT; t += gridDim.x) {
    const int m0 = (t / NT) * 128, n0 = (t % NT) * 64;
    f32x16 tot[2];
    tot[0] = zero16(); tot[1] = zero16();
#pragma unroll 1
    for (int mx = 0; mx < 3; mx++) {
      f32x16 acc[2][1];
      acc[0][0] = zero16(); acc[1][0] = zero16();
      const int acol = mx == 0 ? O_AQ : (mx == 1 ? O_BQ : O_CP);
      const int Kx = mx == 0 ? AW : (mx == 1 ? BW : CW);
      const size_t woff = mx == 0 ? WT_OA : (mx == 1 ? WT_OB : WT_OC);
      const int gcol = O_MA + mx * D;
      gemm_mainloop<1>(proj + acol, NC, wt + woff, Kx, Kx, m0, n0, (bf16*)smem, acc);
#pragma unroll
      for (int i = 0; i < 2; i++)
#pragma unroll
        for (int r = 0; r < 16; r++) {
          const int row = m0 + wm * 64 + i * 32 + crow(r, lh), col = n0 + wn * 32 + lr;
          tot[i][r] += sigm(bf2f(proj[(size_t)row * NC + gcol + col])) * acc[i][0][r];
        }
    }
#pragma unroll
    for (int i = 0; i < 2; i++)
#pragma unroll
      for (int r = 0; r < 16; r++) {
        const int row = m0 + wm * 64 + i * 32 + crow(r, lh), col = n0 + wn * 32 + lr;
        mrg[(size_t)row * D + col] = f2bf(tot[i][r]);
      }
  }
}

__device__ void phase_yout(const Params& p, int l, char* smem) {
  const bf16* mrg = (const bf16*)(p.ws + W_HN);
  const bf16* wt = (const bf16*)(p.ws + W_WT) + (size_t)l * WT_LAYER + WT_OO;
  const int lane = TID() % 64, w = TID() / 64, wm = w / 2, wn = w % 2, lr = lane % 32, lh = lane / 32;
  constexpr int NT = D / 128, MT = M / 128;
  for (int t = BID(); t < MT * NT; t += gridDim.x) {
    const int m0 = (t / NT) * 128, n0 = (t % NT) * 128;
    f32x16 acc[2][2];
#pragma unroll
    for (int i = 0; i < 2; i++)
#pragma unroll
      for (int j = 0; j < 2; j++) acc[i][j] = zero16();
    gemm_mainloop<2>(mrg, D, wt, D, D, m0, n0, (bf16*)smem, acc);
#pragma unroll
    for (int i = 0; i < 2; i++)
#pragma unroll
      for (int j = 0; j < 2; j++)
#pragma unroll
        for (int r = 0; r < 16; r++) {
          const int row = m0 + wm * 64 + i * 32 + crow(r, lh), col = n0 + wn * 64 + j * 32 + lr;
          const float xv = x_row(p, l, row)[col];
          p.out[OO_Y + (size_t)row * D + col] = xv + acc[i][j][r];
        }
  }
}

__device__ void prep_attn_chunk(const Params& p, int l, int gc, char* smem) {
  const int tid = TID();
  const ChunkInfo ci = chunk_info(gc);
  bf16* proj = (bf16*)(p.ws + W_PROJ);
  const float* rope = (const float*)(p.ws + W_ROPE);
  const float* qg = p.in[I_QNG] + l * 64; const float* kg = p.in[I_KNG] + l * 64;
  const bool samp = ci.seq >= NB; const int sb = ci.seq - NB;
  const int sub = tid % 8;
  constexpr int NVEC = 64 * 2 * AH * 2;
  for (int v0 = 0; v0 < NVEC; v0 += 128) {
    float xx[4][8];
#pragma unroll
    for (int u = 0; u < 4; u++) {
      const int vi = v0 + u * 32 + tid / 8;
      const int t = vi / (4 * AH), rem = vi % (4 * AH), isk = rem / (2 * AH), hn2 = rem % (2 * AH);
      ld8(proj + (size_t)(ci.tok0 + t) * NC + (isk ? O_AK : O_AQ) + hn2 * 64 + sub * 8, xx[u]);
    }
#pragma unroll
    for (int u = 0; u < 4; u++) {
      const int vi = v0 + u * 32 + tid / 8;
      const int t = vi / (4 * AH), rem = vi % (4 * AH), isk = rem / (2 * AH), hn2 = rem % (2 * AH);
      const int tok = ci.tok0 + t, pos = ci.pos0 + t;
      bf16* src = proj + (size_t)tok * NC + (isk ? O_AK : O_AQ) + hn2 * 64 + sub * 8;
      float* x = xx[u];
      float ss = 0.f;
#pragma unroll
      for (int i = 0; i < 8; i++) ss += x[i] * x[i];
      ss = red8(ss);
      const float rs = rsqrtf(ss / 64.f + EPS);
      const float* g = isk ? kg : qg;
#pragma unroll
      for (int i = 0; i < 8; i++) x[i] = x[i] * rs * g[sub * 8 + i];
      float y[8];
#pragma unroll
      for (int i = 0; i < 8; i++) y[i] = DPP_XOR1(x[i]);
      if (sub < 2) {
#pragma unroll
        for (int i = 0; i < 8; i++) { const float c = rope[pos * 16 + i], sn = rope[pos * 16 + 8 + i];
          x[i] = (sub == 0) ? (x[i] * c - y[i] * sn) : (x[i] * c + y[i] * sn); }
      }
      if (isk) {
        float* ko = p.out + (samp ? OO_KS + ((size_t)l * MS + (tok - MP)) * AQK : OO_KP + ((size_t)l * MP + tok) * AQK) + hn2 * 64 + sub * 8;
        *(float4*)ko = make_float4(x[0], x[1], x[2], x[3]); *(float4*)(ko + 4) = make_float4(x[4], x[5], x[6], x[7]);
        V8 o;
#pragma unroll
        for (int i = 0; i < 8; i++) o.s[i] = f2bf(x[i]);
        if (samp) { bf16* kb = (bf16*)(p.ws + W_KBS) + ((size_t)(sb * AH + hn2 / 2) * KS + PAST + ci.lc * 64 + t) * 128 + (hn2 % 2) * 64 + sub * 8; *(uint4*)kb = o.u; }
        else *(uint4*)src = o.u;
      } else {
        V8 o;
#pragma unroll
        for (int i = 0; i < 8; i++) o.s[i] = f2bf(x[i] * (0.125f * 1.44269504088896f));
        *(uint4*)src = o.u;
      }
    }
  }
  bf16* tile = (bf16*)smem;
  for (int h = 0; h < AH; h++) {
    __syncthreads();
    for (int i = 0; i < 4; i++) { const int c = tid + i * 256, t = c / 16, d8 = (c % 16) * 8; const int tok = ci.tok0 + t;
      const bf16* src = proj + (size_t)tok * NC + O_AV + h * 128 + d8;
      V8 u; u.u = *(const uint4*)src;
      *(uint4*)(tile + t * 136 + d8) = u.u;
      float* vo = p.out + (samp ? OO_VS + ((size_t)l * MS + (tok - MP)) * AW : OO_VP + ((size_t)l * MP + tok) * AW) + h * 128 + d8;
      *(float4*)vo = make_float4(bf2f(u.s[0]), bf2f(u.s[1]), bf2f(u.s[2]), bf2f(u.s[3]));
      *(float4*)(vo + 4) = make_float4(bf2f(u.s[4]), bf2f(u.s[5]), bf2f(u.s[6]), bf2f(u.s[7])); }
    __syncthreads();
    { const int dv = tid / 2, th = tid % 2;
      bf16* dst = samp ? (bf16*)(p.ws + W_VTS) + ((size_t)(sb * AH + h) * 128 + dv) * KS + PAST + ci.lc * 64 + th * 32
                       : (bf16*)(p.ws + W_VTP) + ((size_t)(ci.seq * AH + h) * 128 + dv) * T + ci.lc * 64 + th * 32;
#pragma unroll
      for (int q = 0; q < 4; q++) { V8 o;
#pragma unroll
        for (int i = 0; i < 8; i++) o.s[i] = tile[(th * 32 + (q >> 1) * 16 + (q & 1) * 4 + (i >> 2) * 8 + (i & 3)) * 136 + dv];
        *(uint4*)(dst + q * 8) = o.u; } }
  }
  __syncthreads();
}
__device__ void prep_past_tile(const Params& p, int l, int item, char* smem) {
  const int tid = TID();
  constexpr int NKT = PAST / 64;
  const int kt = item % NKT, h = (item / NKT) % AH, sb = item / (NKT * AH);
  const float* ck = p.in[I_CK] + (((size_t)l * NSB + sb) * PAST + kt * 64) * AQK + h * 128;
  const float* cv = p.in[I_CV] + (((size_t)l * NSB + sb) * PAST + kt * 64) * AW + h * 128;
  bf16* kb = (bf16*)(p.ws + W_KBS) + ((size_t)(sb * AH + h) * KS + kt * 64) * 128;
  bf16* tile = (bf16*)smem;
  __syncthreads();
  for (int i = 0; i < 4; i++) { const int c = tid + i * 256, t = c / 16, d8 = (c % 16) * 8;
    float4 a = *(const float4*)(ck + (size_t)t * AQK + d8), b = *(const float4*)(ck + (size_t)t * AQK + d8 + 4);
    V8 o; o.s[0] = f2bf(a.x); o.s[1] = f2bf(a.y); o.s[2] = f2bf(a.z); o.s[3] = f2bf(a.w); o.s[4] = f2bf(b.x); o.s[5] = f2bf(b.y); o.s[6] = f2bf(b.z); o.s[7] = f2bf(b.w);
    *(uint4*)(kb + (size_t)t * 128 + d8) = o.u;
    a = *(const float4*)(cv + (size_t)t * AW + d8); b = *(const float4*)(cv + (size_t)t * AW + d8 + 4);
    o.s[0] = f2bf(a.x); o.s[1] = f2bf(a.y); o.s[2] = f2bf(a.z); o.s[3] = f2bf(a.w); o.s[4] = f2bf(b.x); o.s[5] = f2bf(b.y); o.s[6] = f2bf(b.z); o.s[7] = f2bf(b.w);
    *(uint4*)(tile + t * 136 + d8) = o.u; }
  __syncthreads();
  { const int dv = tid / 2, th = tid % 2;
    bf16* dst = (bf16*)(p.ws + W_VTS) + ((size_t)(sb * AH + h) * 128 + dv) * KS + kt * 64 + th * 32;
#pragma unroll
    for (int q = 0; q < 4; q++) { V8 o;
#pragma unroll
      for (int i = 0; i < 8; i++) o.s[i] = tile[(th * 32 + (q >> 1) * 16 + (q & 1) * 4 + (i >> 2) * 8 + (i & 3)) * 136 + dv];
      *(uint4*)(dst + q * 8) = o.u; } }
  __syncthreads();
}
__device__ void prep_hgrn(const Params& p, int l, int item, char* smem) {
  const int tid = TID(), k = tid % 128, th = tid / 128;
  const int gc = item / BH, h = item % BH;
  const ChunkInfo ci = chunk_info(gc);
  bf16* proj = (bf16*)(p.ws + W_PROJ);
  float* tot = (float*)smem;
  float lb = 0.f;
  if (l == 1) { const float b0 = p.in[I_BLOW][h * 128 + k], b1 = p.in[I_BLOW][BQK + h * 128 + k]; lb = 1.f / (1.f + __expf(b0 - b1)); }
  float zs[32], cs[32];
  bf16* base = proj + (size_t)(ci.tok0 + th * 32) * NC + h * 128 + k;
  float run = 0.f;
#pragma unroll
  for (int i = 0; i < 32; i++) { const float z = bf2f(base[(size_t)i * NC + O_BF]); zs[i] = z; const float f = lb + (1.f - lb) * sigm(z); run += __logf(f); cs[i] = run; }
  __syncthreads();
  tot[th * 128 + k] = run;
  __syncthreads();
  const float t0 = tot[k], t1 = tot[128 + k];
  const float ref = t0, last = t0 + t1, off = th ? t0 : 0.f;
  V8 kt8[4], it8[4];
#pragma unroll
  for (int i = 0; i < 32; i++) {
    const float cum = cs[i] + off, z = zs[i];
    const float kin = (1.f - lb) * sigm(-z);
    const float qv = siluf(bf2f(base[(size_t)i * NC + O_BQ]));
    const bf16 iv = base[(size_t)i * NC + O_BI];
    base[(size_t)i * NC + O_BQ] = f2bf(qv * __expf(fminf(cum - ref, 80.f)));
    base[(size_t)i * NC + O_BF] = f2bf(kin * __expf(fminf(ref - cum, 80.f)));
    base[(size_t)i * NC + O_BI] = f2bf(qv * __expf(cum));
    kt8[i / 8].s[i % 8] = f2bf(kin * __expf(last - cum));
    it8[i / 8].s[i % 8] = iv;
  }
  bf16* hgx = (bf16*)(p.ws + W_HGX) + (size_t)item * 2 * 8192;
#pragma unroll
  for (int q = 0; q < 4; q++) { *(uint4*)(hgx + k * 64 + th * 32 + q * 8) = kt8[q].u; *(uint4*)(hgx + 8192 + k * 64 + th * 32 + q * 8) = it8[q].u; }
  if (th == 0) ((float*)(p.ws + W_DL))[(size_t)item * 128 + k] = __expf(last);
  __syncthreads();
}
__device__ void prep_rwkv(const Params& p, int l, int ti, char* smem) {
  const int tid = TID(), lane = tid % 64, w = tid / 64, lr = lane % 32, lh = lane / 32;
  const int tok0 = ti * 32;
  const ChunkInfo ci = chunk_info(tok0 / 64);
  const int seqt0 = seq_tok0(ci.seq);
  const bf16* proj = (const bf16*)(p.ws + W_PROJ);
  const bf16* hn = (const bf16*)(p.ws + W_HN);
  const float* mu = p.in[I_MU] + (size_t)l * CSH;
  const float* shp = (ci.seq >= NB) ? p.in[I_SS] + ((size_t)l * NSB + (ci.seq - NB)) * CSH : nullptr;
  bf16* twb = (bf16*)smem;
  bf16* alb = twb + 32 * 72;
  bf16* hvb = alb + 32 * 72;
  float* part = (float*)(hvb + 32 * 40);
  __syncthreads();
  {
    const int t = tid / 8, j8 = (tid % 8) * 8; const int tok = tok0 + t;
#pragma unroll
    for (int which = 0; which < 2; which++) {
      const int col = (which == 0 ? CP_WLO : CP_ALO) + j8;
      float cur[8], prv[8];
      ld8(proj + (size_t)tok * NC + O_CP + col, cur);
      if (tok == seqt0) {
#pragma unroll
        for (int i = 0; i < 8; i++) prv[i] = shp ? shp[col + i] : 0.f;
      } else ld8(proj + (size_t)(tok - 1) * NC + O_CP + col, prv);
      V8 o;
#pragma unroll
      for (int i = 0; i < 8; i++) { const float v = cur[i] + (prv[i] - cur[i]) * mu[col + i]; o.s[i] = f2bf(which == 0 ? tanhf(v) : v); }
      *(uint4*)((which == 0 ? twb : alb) + t * 72 + j8) = o.u;
    }
  }
  if (l > 0) {
    f32x16 acc = zero16();
    const bf16* w1t = (const bf16*)(p.ws + W_W1T);
    const bf16* ap = hn + (size_t)(tok0 + lr) * D + w * (D / 4) + lh * 8;
    const bf16* bp = w1t + (size_t)lr * D + w * (D / 4) + lh * 8;
#pragma unroll 4
    for (int ks = 0; ks < D / 64; ks++) acc = MFMA32(ldfrag16(ap + ks * 16), ldfrag16(bp + ks * 16), acc);
#pragma unroll
    for (int r = 0; r < 16; r++) part[(w * 32 + crow(r, lh)) * 33 + lr] = acc[r];
    __syncthreads();
    { const int t = tid / 8, j4 = (tid % 8) * 4;
#pragma unroll
      for (int jj = 0; jj < 4; jj++) { const float sv = part[t * 33 + j4 + jj] + part[(32 + t) * 33 + j4 + jj] + part[(64 + t) * 33 + j4 + jj] + part[(96 + t) * 33 + j4 + jj];
        hvb[t * 40 + j4 + jj] = f2bf(sv); } }
  }
  __syncthreads();
  const bf16* w2t = (const bf16*)(p.ws + W_W2T) + (size_t)l * CW * 64;
  const bf16* a2t = (const bf16*)(p.ws + W_A2T) + (size_t)l * CW * 64;
  const bf16* vw2t = (const bf16*)(p.ws + W_VW2T);
  float* rww = (float*)(p.ws + W_RWW);
  bf16* rwr = (bf16*)(p.ws + W_RWR); bf16* rwk = (bf16*)(p.ws + W_RWK); bf16* rwa = (bf16*)(p.ws + W_RWA); bf16* rwb = (bf16*)(p.ws + W_RWB);
  bf16* rwv = (bf16*)(p.ws + (l == 0 ? W_RWV0 : W_RWV1)); const bf16* vfirst = (const bf16*)(p.ws + W_RWV0);
#pragma unroll 1
  for (int head = w; head < CH; head += 4) {
    f32x16 aw[2], aa[2], vm[2];
#pragma unroll
    for (int ct = 0; ct < 2; ct++) { aw[ct] = zero16(); aa[ct] = zero16(); vm[ct] = zero16(); }
    const int chb = head * 64 + lr;
#pragma unroll
    for (int ks = 0; ks < 4; ks++) {
      SCHED_BARRIER();
      const bf16x8 twf = ldfrag16(twb + lr * 72 + ks * 16 + lh * 8), alf = ldfrag16(alb + lr * 72 + ks * 16 + lh * 8);
#pragma unroll
      for (int ct = 0; ct < 2; ct++) {
        aw[ct] = MFMA32(twf, ldfrag16(w2t + (size_t)(chb + ct * 32) * 64 + ks * 16 + lh * 8), aw[ct]);
        aa[ct] = MFMA32(alf, ldfrag16(a2t + (size_t)(chb + ct * 32) * 64 + ks * 16 + lh * 8), aa[ct]);
      }
    }
    if (l > 0) {
#pragma unroll
      for (int ks = 0; ks < 2; ks++) {
        SCHED_BARRIER();
        const bf16x8 hvf = ldfrag16(hvb + lr * 40 + ks * 16 + lh * 8);
#pragma unroll
        for (int ct = 0; ct < 2; ct++) vm[ct] = MFMA32(hvf, ldfrag16(vw2t + (size_t)(chb + ct * 32) * 32 + ks * 16 + lh * 8), vm[ct]);
      }
    }
    SCHED_BARRIER();
    float w0c[2], a0c[2], kkc[2], kac[2], v0c[2], mur[2], muk[2], muv[2];
#pragma unroll
    for (int ct = 0; ct < 2; ct++) { const int ch = chb + ct * 32;
      w0c[ct] = p.in[I_W0][(size_t)l * CW + ch]; a0c[ct] = p.in[I_A0][(size_t)l * CW + ch]; kkc[ct] = p.in[I_KK][(size_t)l * CW + ch]; kac[ct] = p.in[I_KA][(size_t)l * CW + ch];
      v0c[ct] = l > 0 ? p.in[I_V0][(size_t)(l - 1) * CW + ch] : 0.f;
      mur[ct] = mu[CP_R + ch]; muk[ct] = mu[CP_K + ch]; muv[ct] = mu[CP_V + ch]; }
#pragma unroll
    for (int rg = 0; rg < 16; rg++) {
      SCHED_BARRIER();
      float cr[1][2], ck[1][2], cv[1][2], pr[1][2], pk[1][2], pv[1][2], vf[1][2];
#pragma unroll
      for (int q = 0; q < 1; q++) {
        const int t = crow(rg + q, lh), tok = tok0 + t;
#pragma unroll
        for (int ct = 0; ct < 2; ct++) { const int ch = chb + ct * 32;
          const bf16* cp = proj + (size_t)tok * NC + O_CP + ch;
          cr[q][ct] = bf2f(cp[CP_R]); ck[q][ct] = bf2f(cp[CP_K]); cv[q][ct] = bf2f(cp[CP_V]);
          if (tok == seqt0) { pr[q][ct] = shp ? shp[CP_R + ch] : 0.f; pk[q][ct] = shp ? shp[CP_K + ch] : 0.f; pv[q][ct] = shp ? shp[CP_V + ch] : 0.f; }
          else { pr[q][ct] = bf2f(cp[CP_R - NC]); pk[q][ct] = bf2f(cp[CP_K - NC]); pv[q][ct] = bf2f(cp[CP_V - NC]); }
          vf[q][ct] = l > 0 ? bf2f(vfirst[(size_t)tok * CW + ch]) : 0.f; }
      }
#pragma unroll
      for (int q = 0; q < 1; q++) {
        const int r = rg + q, t = crow(r, lh), tok = tok0 + t;
        float rr[2], kk[2], vv[2], ww[2], a[2], kt[2];
        float ss = 0.f;
#pragma unroll
        for (int ct = 0; ct < 2; ct++) {
          rr[ct] = cr[q][ct] + (pr[q][ct] - cr[q][ct]) * mur[ct];
          const float kx = ck[q][ct] + (pk[q][ct] - ck[q][ct]) * muk[ct];
          float vx = cv[q][ct] + (pv[q][ct] - cv[q][ct]) * muv[ct];
          const float u = w0c[ct] + aw[ct][r];
          const float sp = fmaxf(-u, 0.f) + log1pf(__expf(-fabsf(u)));
          ww[ct] = __expf(-__expf(-sp - 0.5f));
          a[ct] = sigm(a0c[ct] + aa[ct][r]);
          if (l > 0) vx = vx + (vf[q][ct] - vx) * sigm(v0c[ct] + vm[ct][r]);
          vv[ct] = vx;
          kk[ct] = kx * kkc[ct];
          ss += kk[ct] * kk[ct];
          kt[ct] = kx * (1.f + (a[ct] - 1.f) * kac[ct]);
        }
        ss = red16(ss); ss += SHFL_XOR(ss, 16);
        const float inv = 1.f / fmaxf(sqrtf(ss), 1e-12f);
#pragma unroll
        for (int ct = 0; ct < 2; ct++) { const size_t o = (size_t)tok * CW + chb + ct * 32;
          const float kn = kk[ct] * inv;
          rww[o] = ww[ct]; rwr[o] = f2bf(rr[ct]); rwk[o] = f2bf(kt[ct]); rwv[o] = f2bf(vv[ct]); rwa[o] = f2bf(-kn); rwb[o] = f2bf(kn * a[ct]); }
      }
    }
  }
  __syncthreads();
}
__device__ void phase_prep(const Params& p, int l, char* smem) {
#ifndef SUBMASK
#define SUBMASK 15
#endif
  if (SUBMASK & 1) for (int gc = BID(); gc < NCHK; gc += gridDim.x) prep_attn_chunk(p, l, gc, smem);
  if (SUBMASK & 2) for (int it = BID(); it < NSB * AH * (PAST / 64); it += gridDim.x) prep_past_tile(p, l, it, smem);
  if (SUBMASK & 4) for (int it = BID(); it < NCHK * BH; it += gridDim.x) prep_hgrn(p, l, it, smem);
  if (SUBMASK & 8) for (int ti = BID(); ti < M / 32; ti += gridDim.x) prep_rwkv(p, l, ti, smem);
  const bf16* proj = (const bf16*)(p.ws + W_PROJ);
  for (int i = BID() * blockDim.x + TID(); i < NSEQ * CSH; i += gridDim.x * blockDim.x) {
    const int seq = i / CSH, c = i % CSH; const int tok = seq_tok0(seq) + seq_len(seq) - 1;
    const float v = bf2f(proj[(size_t)tok * NC + O_CP + c]);
    if (seq < NB) p.out[OO_SP + ((size_t)l * NB + seq) * CSH + c] = v; else p.out[OO_SS + ((size_t)l * NSB + (seq - NB)) * CSH + c] = v;
  }
}

constexpr int KLD = 136, VLD = 72;
__device__ void attn_item(const Params& p, int l, int gc, int h, float lam, float lam_init, char* smem) {
  const int tid = TID(), lane = tid % 64, w = tid / 64, rh = w / 2, n = w % 2, lr = lane % 32, lh = lane / 32;
  const ChunkInfo ci = chunk_info(gc);
  bf16* proj = (bf16*)(p.ws + W_PROJ);
  const bool samp = ci.seq >= NB; const int sb = ci.seq - NB;
  const bf16* Kg; size_t ldk; const bf16* Vg; size_t ldv; int ntiles;
  if (!samp) { Kg = proj + (size_t)(ci.seq * T) * NC + O_AK + h * 128; ldk = NC; Vg = (const bf16*)(p.ws + W_VTP) + (size_t)(ci.seq * AH + h) * 128 * T; ldv = T; ntiles = ci.lc + 1; }
  else { Kg = (const bf16*)(p.ws + W_KBS) + (size_t)(sb * AH + h) * KS * 128; ldk = 128; Vg = (const bf16*)(p.ws + W_VTS) + (size_t)(sb * AH + h) * 128 * KS; ldv = KS; ntiles = PAST / 64 + ci.lc + 1; }
  constexpr int ASTAGE = 64 * KLD + 128 * VLD;
  bf16* sbase = (bf16*)smem;
  bf16x8 qf[4];
  { const bf16* qp = proj + (size_t)(ci.tok0 + rh * 32 + lr) * NC + O_AQ + h * 128 + n * 64 + lh * 8;
#pragma unroll
    for (int ks = 0; ks < 4; ks++) qf[ks] = ldfrag16(qp + ks * 16); }
  f32x16 o[4];
#pragma unroll
  for (int i = 0; i < 4; i++) o[i] = zero16();
  float mrun = -1e30f, lrun = 0.f;
  const int kr0 = tid / 16, kc8 = (tid % 16) * 8, vr0 = tid / 8, vc8 = (tid % 8) * 8;
  const bf16* Kp = Kg + (size_t)kr0 * ldk + kc8;
  const bf16* Vp = Vg + (size_t)vr0 * ldv + vc8;
  typedef unsigned int u32x4 __attribute__((ext_vector_type(4)));
  u32x4 rk0, rk1, rk2, rk3, rv0, rv1, rv2, rv3;
  __syncthreads();
  rk0 = *(const u32x4*)(Kp); rk1 = *(const u32x4*)(Kp + (size_t)16 * ldk); rk2 = *(const u32x4*)(Kp + (size_t)32 * ldk); rk3 = *(const u32x4*)(Kp + (size_t)48 * ldk);
  rv0 = *(const u32x4*)(Vp); rv1 = *(const u32x4*)(Vp + (size_t)32 * ldv); rv2 = *(const u32x4*)(Vp + (size_t)64 * ldv); rv3 = *(const u32x4*)(Vp + (size_t)96 * ldv);
  *(u32x4*)(sbase + (kr0) * KLD + kc8) = rk0; *(u32x4*)(sbase + (kr0 + 16) * KLD + kc8) = rk1; *(u32x4*)(sbase + (kr0 + 32) * KLD + kc8) = rk2; *(u32x4*)(sbase + (kr0 + 48) * KLD + kc8) = rk3;
  *(u32x4*)(sbase + 64 * KLD + (vr0) * VLD + vc8) = rv0; *(u32x4*)(sbase + 64 * KLD + (vr0 + 32) * VLD + vc8) = rv1;
  *(u32x4*)(sbase + 64 * KLD + (vr0 + 64) * VLD + vc8) = rv2; *(u32x4*)(sbase + 64 * KLD + (vr0 + 96) * VLD + vc8) = rv3;
  __syncthreads();
  for (int j = 0; j < ntiles; j++) {
    const bf16* sK = sbase + (j & 1) * ASTAGE; const bf16* sV = sK + 64 * KLD;
    bf16* nK = sbase + ((j & 1) ^ 1) * ASTAGE; bf16* nV = nK + 64 * KLD;
    const bool more = j + 1 < ntiles;
    if (more) {
      const bf16* kq = Kp + (size_t)((j + 1) * 64) * ldk;
      rk0 = *(const u32x4*)(kq); rk1 = *(const u32x4*)(kq + (size_t)16 * ldk); rk2 = *(const u32x4*)(kq + (size_t)32 * ldk); rk3 = *(const u32x4*)(kq + (size_t)48 * ldk);
    }
    f32x16 s[2];
#pragma unroll
    for (int mt = 0; mt < 2; mt++) { s[mt] = zero16();
#pragma unroll
      for (int ks = 0; ks < 4; ks++) s[mt] = MFMA32(ldfrag16(sK + (mt * 32 + lr) * KLD + n * 64 + ks * 16 + lh * 8), qf[ks], s[mt]); }
    if (more) {
      *(u32x4*)(nK + (kr0) * KLD + kc8) = rk0; *(u32x4*)(nK + (kr0 + 16) * KLD + kc8) = rk1; *(u32x4*)(nK + (kr0 + 32) * KLD + kc8) = rk2; *(u32x4*)(nK + (kr0 + 48) * KLD + kc8) = rk3;
      const bf16* vq = Vp + (j + 1) * 64;
      rv0 = *(const u32x4*)(vq); rv1 = *(const u32x4*)(vq + (size_t)32 * ldv); rv2 = *(const u32x4*)(vq + (size_t)64 * ldv); rv3 = *(const u32x4*)(vq + (size_t)96 * ldv);
    }
    float mx = -1e30f;
#pragma unroll
    for (int mt = 0; mt < 2; mt++)
#pragma unroll
      for (int r = 0; r < 16; r++) mx = fmaxf(mx, s[mt][r]);
    mx = fmaxf(mx, SHFL_XOR(mx, 32));
    const float mnew = fmaxf(mrun, mx);
    const float alpha = EXP2(mrun - mnew);
    float rs = 0.f;
#pragma unroll
    for (int mt = 0; mt < 2; mt++)
#pragma unroll
      for (int r = 0; r < 16; r++) { const float e = EXP2(s[mt][r] - mnew); s[mt][r] = e; rs += e; }
    rs += SHFL_XOR(rs, 32);
    lrun = lrun * alpha + rs; mrun = mnew;
    if (__any(alpha != 1.0f)) {
#pragma unroll
      for (int i = 0; i < 4; i++)
#pragma unroll
        for (int r = 0; r < 16; r++) o[i][r] *= alpha;
    }
    bf16x8 pf[2][2];
#pragma unroll
    for (int mt = 0; mt < 2; mt++)
#pragma unroll
      for (int s2 = 0; s2 < 2; s2++) pf[mt][s2] = pack8(s[mt], s2);
#pragma unroll
    for (int mt = 0; mt < 2; mt++)
#pragma unroll
      for (int s2 = 0; s2 < 2; s2++) {
#pragma unroll
        for (int dt = 0; dt < 4; dt++) {
          o[dt] = MFMA32(ldfrag16(sV + (dt * 32 + lr) * VLD + mt * 32 + 16 * s2 + 8 * lh), pf[mt][s2], o[dt]);
        }
      }
    if (more) {
      *(u32x4*)(nV + (vr0) * VLD + vc8) = rv0; *(u32x4*)(nV + (vr0 + 32) * VLD + vc8) = rv1; *(u32x4*)(nV + (vr0 + 64) * VLD + vc8) = rv2; *(u32x4*)(nV + (vr0 + 96) * VLD + vc8) = rv3;
    }
    __syncthreads();
  }
  __syncthreads();
  float* comb = (float*)smem;
  const float invl = 1.f / lrun;
  if (n == 1) {
#pragma unroll
    for (int dt = 0; dt < 4; dt++)
#pragma unroll
      for (int r = 0; r < 16; r++) comb[(rh * 32 + lr) * 129 + dt * 32 + crow(r, lh)] = o[dt][r] * invl;
  }
  __syncthreads();
  if (n == 0) {
    float ss = 0.f;
#pragma unroll
    for (int dt = 0; dt < 4; dt++)
#pragma unroll
      for (int r = 0; r < 16; r++) { const float v = o[dt][r] * invl - lam * comb[(rh * 32 + lr) * 129 + dt * 32 + crow(r, lh)]; o[dt][r] = v; ss += v * v; }
    ss += SHFL_XOR(ss, 32);
    const float rstd = rsqrtf(ss / 128.f + EPS) * (1.f - lam_init);
    const float* sg = p.in[I_SUBG] + l * 128;
    const int tok = ci.tok0 + rh * 32 + lr;
#pragma unroll
    for (int dt = 0; dt < 4; dt++)
#pragma unroll
      for (int g = 0; g < 4; g++) {
        const int dv = dt * 32 + 8 * g + 4 * lh;
        float gate[4]; ld4(proj + (size_t)tok * NC + O_AG + h * 128 + dv, gate);
        V4 ov;
#pragma unroll
        for (int r = 0; r < 4; r++) ov.s[r] = f2bf(o[dt][4 * g + r] * rstd * sg[dv + r] * siluf(gate[r]));
        *(uint2*)(proj + (size_t)tok * NC + O_AQ + h * 128 + dv) = ov.u;
      }
  }
  __syncthreads();
}

constexpr int HLD = 136, TLD = 72;
__device__ void hgrn_item(const Params& p, int l, int seq, int h, char* smem) {
  const int tid = TID(), lane = tid % 64, w = tid / 64, lr = lane % 32, lh = lane / 32;
  bf16* proj = (bf16*)(p.ws + W_PROJ);
  const int nch = seq < NB ? PCH : SCH;
  const int gc0 = seq < NB ? seq * PCH : NB * PCH + (seq - NB) * SCH;
  bf16* X0 = (bf16*)smem;
  bf16* X1 = X0 + 9216;
  float* red = (float*)(X1 + 9216);
  f32x16 S[4];
  if (seq < NB) {
#pragma unroll
    for (int kt = 0; kt < 4; kt++) S[kt] = zero16();
  } else {
    const float* s0 = p.in[I_SH] + (((size_t)l * NSB + (seq - NB)) * BH + h) * 16384;
#pragma unroll
    for (int kt = 0; kt < 4; kt++) {
      const float* sp = s0 + (size_t)(kt * 32 + 4 * lh) * 128 + w * 32 + lr;
#pragma unroll
      for (int r = 0; r < 16; r++) S[kt][r] = sp[((r & 3) + 8 * (r >> 2)) * 128];
      SCHED_BARRIER();
    }
  }
  const float* ng = p.in[I_BNG] + l * 128;
  for (int c = 0; c < nch; c++) {
    const int gc = gc0 + c, tok0 = gc * 64;
    const size_t item = (size_t)gc * BH + h;
    const bf16* hgx = (const bf16*)(p.ws + W_HGX) + item * 2 * 8192;
    const float* dl = (const float*)(p.ws + W_DL) + item * 128;
    __syncthreads();
    for (int i = 0; i < 4; i++) { const int cc = tid + i * 256, r = cc / 16, c8 = (cc % 16) * 8;
      *(uint4*)(X0 + r * HLD + c8) = *(const uint4*)(proj + (size_t)(tok0 + r) * NC + O_BF + h * 128 + c8);
      *(uint4*)(X1 + r * HLD + c8) = *(const uint4*)(proj + (size_t)(tok0 + r) * NC + O_BQ + h * 128 + c8); }
    __syncthreads();
    f32x16 x00 = zero16(), x01 = zero16(), x11 = zero16();
#pragma unroll
    for (int ks = 0; ks < 8; ks++) {
      const bf16x8 b0 = ldfrag16(X0 + (lr) * HLD + ks * 16 + lh * 8), b1 = ldfrag16(X0 + (32 + lr) * HLD + ks * 16 + lh * 8);
      const bf16x8 a0 = ldfrag16(X1 + (lr) * HLD + ks * 16 + lh * 8), a1 = ldfrag16(X1 + (32 + lr) * HLD + ks * 16 + lh * 8);
      x00 = MFMA32(b0, a0, x00); x01 = MFMA32(b0, a1, x01); x11 = MFMA32(b1, a1, x11);
      if (ks & 1) SCHED_BARRIER();
    }
#pragma unroll
    for (int r = 0; r < 16; r++) { if (crow(r, lh) > lr) { x00[r] = 0.f; x11[r] = 0.f; } }
    bf16x8 xp00[2], xp01[2], xp11[2];
#pragma unroll
    for (int s2 = 0; s2 < 2; s2++) { xp00[s2] = pack8(x00, s2); xp01[s2] = pack8(x01, s2); xp11[s2] = pack8(x11, s2); }
    SCHED_BARRIER();
    bf16x8 itf[2][2];
#pragma unroll
    for (int st = 0; st < 2; st++)
#pragma unroll
      for (int s2 = 0; s2 < 2; s2++) { const bf16* ip = hgx + 8192 + (size_t)(w * 32 + lr) * 64 + st * 32 + 16 * s2 + 4 * lh; itf[st][s2] = ldfrag8x2(ip, ip + 8); }
    __syncthreads();
    for (int i = 0; i < 4; i++) { const int cc = tid + i * 256;
      { const int r = cc / 16, c8 = (cc % 16) * 8; *(uint4*)(X0 + r * HLD + c8) = *(const uint4*)(proj + (size_t)(tok0 + r) * NC + O_BI + h * 128 + c8); }
      { const int r = cc / 8, c8 = (cc % 8) * 8; *(uint4*)(X1 + r * TLD + c8) = *(const uint4*)(hgx + (size_t)r * 64 + c8); } }
    __syncthreads();
    f32x16 o0 = zero16(), o1 = zero16();
#pragma unroll
    for (int s2 = 0; s2 < 2; s2++) {
      o0 = MFMA32(itf[0][s2], xp00[s2], o0);
      o1 = MFMA32(itf[0][s2], xp01[s2], o1);
      o1 = MFMA32(itf[1][s2], xp11[s2], o1);
    }
    SCHED_BARRIER();
#pragma unroll
    for (int kt = 0; kt < 4; kt++)
#pragma unroll
      for (int s2 = 0; s2 < 2; s2++) {
        const bf16x8 sp = pack8(S[kt], s2);
        const bf16* q0 = X0 + (lr) * HLD + kt * 32 + 16 * s2 + 4 * lh; const bf16* q1 = X0 + (32 + lr) * HLD + kt * 32 + 16 * s2 + 4 * lh;
        o0 = MFMA32(sp, ldfrag8x2(q0, q0 + 8), o0);
        o1 = MFMA32(sp, ldfrag8x2(q1, q1 + 8), o1);
        if (s2) SCHED_BARRIER();
      }
    SCHED_BARRIER();
#pragma unroll
    for (int kt = 0; kt < 4; kt++) {
      SCHED_BARRIER();
#pragma unroll
      for (int g = 0; g < 4; g++) { const float4 dv = *(const float4*)(dl + kt * 32 + 8 * g + 4 * lh);
        S[kt][4 * g] *= dv.x; S[kt][4 * g + 1] *= dv.y; S[kt][4 * g + 2] *= dv.z; S[kt][4 * g + 3] *= dv.w; }
#pragma unroll
      for (int st = 0; st < 2; st++)
#pragma unroll
        for (int s2 = 0; s2 < 2; s2++) { const bf16* kp = X1 + (kt * 32 + lr) * TLD + st * 32 + 16 * s2 + 4 * lh;
          S[kt] = MFMA32(ldfrag8x2(kp, kp + 8), itf[st][s2], S[kt]); }
    }
    SCHED_BARRIER();
    float ss0 = 0.f, ss1 = 0.f;
#pragma unroll
    for (int r = 0; r < 16; r++) { ss0 += o0[r] * o0[r]; ss1 += o1[r] * o1[r]; }
    ss0 += SHFL_XOR(ss0, 32); ss1 += SHFL_XOR(ss1, 32);
    if (lh == 0) { red[w * 64 + lr] = ss0; red[w * 64 + 32 + lr] = ss1; }
    __syncthreads();
#pragma unroll
    for (int tt = 0; tt < 2; tt++) {
      const int t = tt * 32 + lr;
      const float tot = red[t] + red[64 + t] + red[128 + t] + red[192 + t];
      const float rstd = rsqrtf(tot / 128.f + EPS);
      const int tok = tok0 + t;
#pragma unroll
      for (int g = 0; g < 4; g++) {
        const int v = w * 32 + 8 * g + 4 * lh;
        float gate[4]; ld4(proj + (size_t)tok * NC + O_BG + h * 128 + v, gate);
        V4 ov;
#pragma unroll
        for (int r = 0; r < 4; r++) { const float ovv = (tt == 0 ? o0[4 * g + r] : o1[4 * g + r]); ov.s[r] = f2bf(ovv * rstd * ng[v + r] * siluf(gate[r])); }
        *(uint2*)(proj + (size_t)tok * NC + O_BQ + h * 128 + v) = ov.u;
      }
    }
  }
  float* so = p.out + (seq < NB ? OO_HP + (((size_t)l * NB + seq) * BH + h) * 16384 : OO_HS + (((size_t)l * NSB + (seq - NB)) * BH + h) * 16384);
#pragma unroll
  for (int kt = 0; kt < 4; kt++) {
    float* sp = so + (size_t)(kt * 32 + 4 * lh) * 128 + w * 32 + lr;
#pragma unroll
    for (int r = 0; r < 16; r++) sp[((r & 3) + 8 * (r >> 2)) * 128] = S[kt][r];
    SCHED_BARRIER();
  }
  __syncthreads();
}

__device__ void rwkv_item(const Params& p, int l, int seq, int h, char* smem) {
  const int tid = TID(), ri = tid / 4, sub = tid % 4;
  bf16* proj = (bf16*)(p.ws + W_PROJ);
  const float* rww = (const float*)(p.ws + W_RWW);
  const bf16* rwr = (const bf16*)(p.ws + W_RWR); const bf16* rwk = (const bf16*)(p.ws + W_RWK); const bf16* rwa = (const bf16*)(p.ws + W_RWA);
  const bf16* rwb = (const bf16*)(p.ws + W_RWB); const bf16* rwv = (const bf16*)(p.ws + (l == 0 ? W_RWV0 : W_RWV1));
  float* sw = (float*)smem; float* sr = sw + 2048; float* sk = sr + 2048; float* sv = sk + 2048; float* sa = sv + 2048; float* sbb = sa + 2048; float* sy = sbb + 2048;
  const int len = seq_len(seq), t0 = seq_tok0(seq);
  float S[16];
  if (seq < NB) {
#pragma unroll
    for (int j = 0; j < 16; j++) S[j] = 0.f;
  } else {
    const float* s0 = p.in[I_SR] + ((((size_t)l * NSB + (seq - NB)) * CH + h) * 64 + ri) * 64 + sub * 16;
#pragma unroll
    for (int j = 0; j < 16; j++) S[j] = s0[j];
  }
  const float* lnw = p.in[I_LNW] + (size_t)l * CW + h * 64; const float* lnb = p.in[I_LNB] + (size_t)l * CW + h * 64;
  const float* rk = p.in[I_RK] + (size_t)l * CW + h * 64;
  const int st = tid / 8, sc8 = (tid % 8) * 8;
  typedef unsigned int u32x4 __attribute__((ext_vector_type(4)));
  typedef float f32x4v __attribute__((ext_vector_type(4)));
  f32x4v pw0, pw1; u32x4 pr_, pk_, pv_, pa_, pb_, pg_next, pg_cur;
  float lnw8[8], lnb8[8], rk8[8];
#pragma unroll
  for (int i = 0; i < 8; i++) { lnw8[i] = lnw[sc8 + i]; lnb8[i] = lnb[sc8 + i]; rk8[i] = rk[sc8 + i]; }
  pg_next = *(const u32x4*)(proj + (size_t)(t0 + st) * NC + O_CG + h * 64 + sc8);
  { const size_t g = (size_t)(t0 + st) * CW + h * 64 + sc8;
    pw0 = *(const f32x4v*)(rww + g); pw1 = *(const f32x4v*)(rww + g + 4);
    pr_ = *(const u32x4*)(rwr + g); pk_ = *(const u32x4*)(rwk + g); pv_ = *(const u32x4*)(rwv + g); pa_ = *(const u32x4*)(rwa + g); pb_ = *(const u32x4*)(rwb + g); }
  for (int tb = 0; tb < len; tb += 32) {
    __syncthreads();
    { float* d = sw + st * 64 + sc8; *(f32x4v*)d = pw0; *(f32x4v*)(d + 4) = pw1;
#define UNPK(dst, v) { float* q = dst + st * 64 + sc8; _Pragma("unroll") for (int i = 0; i < 4; i++) { q[2 * i] = __uint_as_float(v[i] << 16); q[2 * i + 1] = __uint_as_float(v[i] & 0xffff0000u); } }
      UNPK(sr, pr_) UNPK(sk, pk_) UNPK(sv, pv_) UNPK(sa, pa_) UNPK(sbb, pb_)
      pg_cur = pg_next;
    }
    __syncthreads();
    if (tb + 32 < len) { pg_next = *(const u32x4*)(proj + (size_t)(t0 + tb + 32 + st) * NC + O_CG + h * 64 + sc8);
      const size_t g = (size_t)(t0 + tb + 32 + st) * CW + h * 64 + sc8;
      pw0 = *(const f32x4v*)(rww + g); pw1 = *(const f32x4v*)(rww + g + 4);
      pr_ = *(const u32x4*)(rwr + g); pk_ = *(const u32x4*)(rwk + g); pv_ = *(const u32x4*)(rwv + g); pa_ = *(const u32x4*)(rwa + g); pb_ = *(const u32x4*)(rwb + g); }
#define RW_LOADA(T, A, V) { \
      _Pragma("unroll") for (int q = 0; q < 4; q++) { const f32x4v xa = *(const f32x4v*)(sa + (T) * 64 + sub * 16 + 4 * q); \
        _Pragma("unroll") for (int e = 0; e < 4; e++) A[4 * q + e] = xa[e]; } \
      V = sv[(T) * 64 + ri]; }
#define RW_STEP(T, A, V) { \
      float W[16], B[16], K[16], R[16]; \
      _Pragma("unroll") for (int q = 0; q < 4; q++) { \
        const f32x4v xw = *(const f32x4v*)(sw + (T) * 64 + sub * 16 + 4 * q), xb = *(const f32x4v*)(sbb + (T) * 64 + sub * 16 + 4 * q), \
                     xk = *(const f32x4v*)(sk + (T) * 64 + sub * 16 + 4 * q), xr = *(const f32x4v*)(sr + (T) * 64 + sub * 16 + 4 * q); \
        _Pragma("unroll") for (int e = 0; e < 4; e++) { W[4 * q + e] = xw[e]; B[4 * q + e] = xb[e]; K[4 * q + e] = xk[e]; R[4 * q + e] = xr[e]; } } \
      float dot = 0.f, dotb = 0.f; \
      _Pragma("unroll") for (int j = 0; j < 8; j++) { dot += S[j] * A[j]; dotb += S[j + 8] * A[j + 8]; } \
      dot = red4(dot + dotb); \
      float y = 0.f, yb = 0.f; \
      _Pragma("unroll") for (int j = 0; j < 8; j++) { S[j] = S[j] * W[j] + dot * B[j] + V * K[j]; y += S[j] * R[j]; \
                                    S[j + 8] = S[j + 8] * W[j + 8] + dot * B[j + 8] + V * K[j + 8]; yb += S[j + 8] * R[j + 8]; } \
      y = red4(y + yb); \
      if (sub == 0) sy[(T) * 64 + ri] = y; }
    {
      float a0[16], v0, a1[16], v1;
      RW_LOADA(0, a0, v0)
#pragma unroll 1
      for (int t = 0; t < 32; t += 2) {
        RW_LOADA(t + 1, a1, v1)
        RW_STEP(t, a0, v0)
        if (t + 2 < 32) RW_LOADA(t + 2, a0, v0)
        RW_STEP(t + 1, a1, v1)
      }
    }
#undef RW_LOADA
#undef RW_STEP
    __syncthreads();
    {
      const int t = tid / 8, c8 = (tid % 8) * 8; const int tok = t0 + tb + t;
      float y[8]; float s1 = 0.f, bon = 0.f;
#pragma unroll
      for (int i = 0; i < 8; i++) { y[i] = sy[t * 64 + c8 + i]; s1 += y[i]; bon += sr[t * 64 + c8 + i] * sk[t * 64 + c8 + i] * rk8[i]; }
      s1 = red8(s1); bon = red8(bon);
      const float mu = s1 / 64.f; float s2 = 0.f;
#pragma unroll
      for (int i = 0; i < 8; i++) { const float d = y[i] - mu; s2 += d * d; }
      s2 = red8(s2);
      const float rstd = rsqrtf(s2 / 64.f + 64e-5f);
      float gate[8];
#pragma unroll
      for (int i = 0; i < 4; i++) { gate[2 * i] = __uint_as_float(pg_cur[i] << 16); gate[2 * i + 1] = __uint_as_float(pg_cur[i] & 0xffff0000u); }
      V8 ov;
#pragma unroll
      for (int i = 0; i < 8; i++) { const float o = (y[i] - mu) * rstd * lnw8[i] + lnb8[i] + bon * sv[t * 64 + c8 + i]; ov.s[i] = f2bf(o * siluf(gate[i])); }
      *(uint4*)(proj + (size_t)tok * NC + O_CP + h * 64 + c8) = ov.u;
    }
  }
  float* so = p.out + (seq < NB ? OO_RP + ((((size_t)l * NB + seq) * CH + h) * 64 + ri) * 64 : OO_RS + ((((size_t)l * NSB + (seq - NB)) * CH + h) * 64 + ri) * 64) + sub * 16;
#pragma unroll
  for (int j = 0; j < 16; j++) so[j] = S[j];
  __syncthreads();
}

__device__ void phase_mixers(const Params& p, int l, char* smem) {
  __shared__ int s_item;
  int* cnt = (int*)(p.ws + W_CNT) + l;
  const float* lp = p.in[I_LAM] + (size_t)l * 256;
  float d1 = 0.f, d2 = 0.f;
  for (int i = 0; i < 64; i++) { d1 += lp[i] * lp[64 + i]; d2 += lp[128 + i] * lp[192 + i]; }
  const float lam_init = 0.8f - 0.6f * expf(-0.3f * (float)l);
  const float lam = expf(d1) - expf(d2) + lam_init;
  constexpr int N_RWP = NB * CH, N_HGP = NB * BH, N_ATP = NB * PCH * AH, N_RWS = NSB * CH, N_HGS = NSB * BH, N_ATS = NSB * SCH * AH;
  constexpr int NTOT = N_RWP + N_HGP + N_ATP + N_RWS + N_HGS + N_ATS;
  for (;;) {
    __syncthreads();
    if (TID() == 0) s_item = atomicAdd(cnt, 1);
    __syncthreads();
    int it = s_item;
    if (it >= NTOT) break;
    if (it < N_RWP) { SETPRIO(3); if (SUBMASK & 1) rwkv_item(p, l, it / CH, it % CH, smem); SETPRIO(0); continue; }
    it -= N_RWP;
    if (it < N_HGP) { SETPRIO(2); if (SUBMASK & 2) hgrn_item(p, l, it / BH, it % BH, smem); SETPRIO(0); continue; }
    it -= N_HGP;
    if (it < N_ATP) {
      const int lc = PCH - 1 - it / (NB * AH), r = it % (NB * AH); if (SUBMASK & 4) attn_item(p, l, (r / AH) * PCH + lc, r % AH, lam, lam_init, smem); continue; }
    it -= N_ATP;
    if (it < N_RWS) { if (SUBMASK & 1) rwkv_item(p, l, NB + it / CH, it % CH, smem); continue; }
    it -= N_RWS;
    if (it < N_HGS) { if (SUBMASK & 2) hgrn_item(p, l, NB + it / BH, it % BH, smem); continue; }
    it -= N_HGS;
    { const int gc = NB * PCH + it / AH; if (SUBMASK & 4) attn_item(p, l, gc, it % AH, lam, lam_init, smem); }
  }
}

constexpr int SMEM_BYTES = 73728;
#ifdef EMU
__device__ void run_phase(const Params& p, int ph, char* smem) {
  const int l = ph / 6, s = ph % 6;
  switch (s) {
#ifndef PHMASK
#define PHMASK 63
#endif
    case 0: if (PHMASK & 1) { if (l == 0) phase_wprep(p, smem); phase_rmsnorm(p, l); } break;
    case 1: if (PHMASK & 2) phase_proj(p, l, smem); break;
    case 2: if (PHMASK & 4) phase_prep(p, l, smem); break;
    case 3: if (PHMASK & 8) phase_mixers(p, l, smem); break;
    case 4: if (PHMASK & 16) phase_merge(p, l, smem); break;
    case 5: if (PHMASK & 32) phase_yout(p, l, smem); break;
  }
}
#endif
#ifndef EMU
__global__ void __launch_bounds__(256, 2) mega(Params p) {
  __shared__ __attribute__((aligned(16))) char smem[SMEM_BYTES];
  cg::grid_group grid = cg::this_grid();
  phase_wprep(p, smem);
#ifdef PROBE
  long long tmix = 0, tproj = 0;
#endif
#pragma unroll 1
  for (int l = 0; l < DEPTH; l++) {
    phase_rmsnorm(p, l); grid.sync();
#ifdef PROBE
    long long t0 = wall_clock64();
#endif
    phase_proj(p, l, smem); grid.sync();
#ifdef PROBE
    if (l == 0) tproj = wall_clock64() - t0;
#endif
    phase_prep(p, l, smem); grid.sync();
#ifdef PROBE
    t0 = wall_clock64();
#endif
    phase_mixers(p, l, smem); grid.sync();
#ifdef PROBE
    if (l == 0) tmix = wall_clock64() - t0;
#endif
    phase_merge(p, l, smem); grid.sync();
    phase_yout(p, l, smem); grid.sync();
  }
#ifdef PROBE
  long long* pr = (long long*)(p.ws + W_CNT + 64);
  if (blockIdx.x == 0 && threadIdx.x == 0) { pr[0] = tmix; pr[1] = tproj; }
  grid.sync();
  { const long long a = pr[0], b = pr[1];
    const long long q = (b + 25000) / 50000;
    const long long delay = a + 2000000LL * q + 40000000LL * (p.percu - 1);
    const long long te = wall_clock64() + delay;
    while (wall_clock64() < te) __builtin_amdgcn_s_sleep(20);
  }
#endif
}
extern "C" void kernel_launch(void* const* d_in, const int* in_sizes, int n_in, void* d_out, int out_size, void* d_ws, size_t ws_size, hipStream_t stream) {
  Params p{};
  for (int i = 0; i < 32; i++) p.in[i] = (const float*)d_in[i];
  p.out = (float*)d_out; p.ws = (char*)d_ws;
  if (ws_size < WS_TOTAL) { fprintf(stderr, "workspace too small: %zu < %zu\n", ws_size, (size_t)WS_TOTAL); return; }
  hipMemsetAsync((char*)d_ws + W_CNT, 0, 256, stream);
  static int grid_blocks = 0;
  if (!grid_blocks) {
    int dev = 0, cus = 0, per_cu = 0;
    hipGetDevice(&dev);
    hipDeviceGetAttribute(&cus, hipDeviceAttributeMultiprocessorCount, dev);
    hipOccupancyMaxActiveBlocksPerMultiprocessor(&per_cu, mega, 256, 0);
    if (per_cu > 2) per_cu = 2;
    grid_blocks = cus * per_cu;
  }
#ifdef PROBE
  p.percu = grid_blocks / 256;
#endif
  void* args[] = { &p };
  hipError_t e = hipLaunchCooperativeKernel((void*)mega, dim3(grid_blocks), dim3(256), args, 0, stream);
  if (e != hipSuccess) fprintf(stderr, "cooperative launch failed: %s (grid %d)\n", hipGetErrorString(e), grid_blocks);
}
#endif
```
